# Optimizing an MI355X kernel written in HIP

```python
import math
import jax, jax.numpy as jnp
from jax import lax
import numpy as np

D_MODEL = 2048
BATCH = 1
SEQ = 8192
DEPTH = 1
DEC_BATCH = 16
DEC_SEQ = 2048
PAST_LEN = 128

MIX_WIDTH = D_MODEL
MLA_HEADS = 8
MLA_V_DIM = 128
MLA_NOPE_DIM = 128
MLA_ROPE_DIM = 64
Q_LORA = 512
KV_LORA = 512
MLA_WIDTH = MLA_HEADS * MLA_V_DIM
GMLP_GROUPS = 8
GMLP_GROUP_DIM = 128
GMLP_WIDTH = GMLP_GROUPS * GMLP_GROUP_DIM
CHUNK = 128
IN_WIDTH = Q_LORA + KV_LORA + MLA_ROPE_DIM + 2 * GMLP_WIDTH
D_FF = 5632
Q_BLOCK = 128
ROPE_THETA = 10000.0
EPS = 1e-6

kernel_name = "hybrid_mla_gmlp_macaron_encoder"


def rms_norm(x, g):
    xf = x.astype(jnp.float32)
    y = xf * lax.rsqrt(jnp.mean(xf * xf, axis=-1, keepdims=True) + EPS)
    return (y * g.astype(jnp.float32)).astype(x.dtype)


def swiglu(h, w_gate, w_up, w_down):
    return (jax.nn.silu(h @ w_gate) * (h @ w_up)) @ w_down


def rope_tables(seq):
    inv = 1.0 / (ROPE_THETA ** (jnp.arange(0, MLA_ROPE_DIM, 2, dtype=jnp.float32) / MLA_ROPE_DIM))
    ang = jnp.arange(seq, dtype=jnp.float32)[:, None] * inv[None, :]
    return jnp.cos(ang), jnp.sin(ang)


def apply_rope(x, cos, sin):
    half = x.shape[-1] // 2
    x1 = x[..., :half].astype(jnp.float32)
    x2 = x[..., half:].astype(jnp.float32)
    out = jnp.concatenate([x1 * cos - x2 * sin, x1 * sin + x2 * cos], axis=-1)
    return out.astype(x.dtype)


def mla_attention(q_nope, q_rope, k_nope, k_rope, v):
    B, S, H, _ = q_nope.shape
    nblk = S // Q_BLOCK
    scale = 1.0 / math.sqrt(MLA_NOPE_DIM + MLA_ROPE_DIM)
    qn = jnp.moveaxis(q_nope.reshape(B, nblk, Q_BLOCK, H, MLA_NOPE_DIM), 1, 0)
    qr = jnp.moveaxis(q_rope.reshape(B, nblk, Q_BLOCK, H, MLA_ROPE_DIM), 1, 0)

    def block(args):
        qn_b, qr_b = args
        s = (jnp.einsum('bqhd,bkhd->bhqk', qn_b, k_nope, preferred_element_type=jnp.float32)
             + jnp.einsum('bqhd,bkd->bhqk', qr_b, k_rope, preferred_element_type=jnp.float32))
        p = jax.nn.softmax(s * scale, axis=-1).astype(v.dtype)
        return jnp.einsum('bhqk,bkhd->bqhd', p, v)

    o = lax.map(block, (qn, qr))
    return jnp.moveaxis(o, 0, 1).reshape(B, S, H * MLA_V_DIM)


def chunked_spatial_gating(u, v, g_v, w_s, b_s):
    B, S, _ = u.shape
    n = S // CHUNK
    vn = rms_norm(v.reshape(B, S, GMLP_GROUPS, GMLP_GROUP_DIM),
                  g_v.reshape(GMLP_GROUPS, GMLP_GROUP_DIM))
    vn = vn.reshape(B, n, CHUNK, GMLP_GROUPS, GMLP_GROUP_DIM)
    s = jnp.einsum('gij,bnjgc->bnigc', w_s, vn) + jnp.transpose(b_s)[None, None, :, :, None]
    return u * s.reshape(B, S, GMLP_WIDTH)


def encoder_layer(x, g_ffn1, w1_gate, w1_up, w1_down, g_mix, w_in, g_q, w_q_b, g_kv, w_kv_b,
                  g_v, w_s, b_s, g_out_attn, g_out_gmlp, w_out, g_ffn2, w2_gate, w2_up, w2_down):
    B, S, _ = x.shape
    x = x + 0.5 * swiglu(rms_norm(x, g_ffn1), w1_gate, w1_up, w1_down)

    z = rms_norm(x, g_mix) @ w_in
    o1 = Q_LORA
    o2 = o1 + KV_LORA
    o3 = o2 + MLA_ROPE_DIM
    o4 = o3 + GMLP_WIDTH
    c_q, c_kv, k_rope, u, v = z[..., :o1], z[..., o1:o2], z[..., o2:o3], z[..., o3:o4], z[..., o4:]

    cos, sin = rope_tables(S)
    q = (rms_norm(c_q, g_q) @ w_q_b).reshape(B, S, MLA_HEADS, MLA_NOPE_DIM + MLA_ROPE_DIM)
    q_nope = q[..., :MLA_NOPE_DIM]
    q_rope = apply_rope(q[..., MLA_NOPE_DIM:], cos[None, :, None, :], sin[None, :, None, :])
    kv = (rms_norm(c_kv, g_kv) @ w_kv_b).reshape(B, S, MLA_HEADS, MLA_NOPE_DIM + MLA_V_DIM)
    k_nope = kv[..., :MLA_NOPE_DIM]
    v_att = kv[..., MLA_NOPE_DIM:]
    k_rope = apply_rope(k_rope, cos[None], sin[None])
    o_attn = mla_attention(q_nope, q_rope, k_nope, k_rope, v_att)

    o_gmlp = chunked_spatial_gating(jax.nn.gelu(u), jax.nn.gelu(v), g_v, w_s, b_s)

    o = jnp.concatenate([rms_norm(o_attn, g_out_attn), rms_norm(o_gmlp, g_out_gmlp)], axis=-1)
    x = x + o @ w_out

    x = x + 0.5 * swiglu(rms_norm(x, g_ffn2), w2_gate, w2_up, w2_down)
    return x


def setup_inputs(seed: int = 0) -> dict:
    key = jax.random.key(seed)
    ks = iter(jax.random.split(key, 32))
    f32 = jnp.float32

    def nrm(shape, fan_in):
        return jax.random.normal(next(ks), shape, f32) * (fan_in ** -0.5)

    def gain(shape):
        return 1.0 + 0.01 * jax.random.normal(next(ks), shape, f32)

    L = DEPTH
    H = MLA_HEADS
    return {
        "x_prompt": jax.random.normal(next(ks), (BATCH, SEQ, D_MODEL), f32),
        "x_sample": jax.random.normal(next(ks), (DEC_BATCH, DEC_SEQ, D_MODEL), f32),
        "g_ffn1": gain((L, D_MODEL)),
        "w1_gate": nrm((L, D_MODEL, D_FF), D_MODEL),
        "w1_up": nrm((L, D_MODEL, D_FF), D_MODEL),
        "w1_down": nrm((L, D_FF, D_MODEL), D_FF),
        "g_mix": gain((L, D_MODEL)),
        "w_in": nrm((L, D_MODEL, IN_WIDTH), D_MODEL),
        "g_q": gain((L, Q_LORA)),
        "w_q_b": nrm((L, Q_LORA, H * (MLA_NOPE_DIM + MLA_ROPE_DIM)), Q_LORA),
        "g_kv": gain((L, KV_LORA)),
        "w_kv_b": nrm((L, KV_LORA, H * (MLA_NOPE_DIM + MLA_V_DIM)), KV_LORA),
        "g_v": gain((L, GMLP_WIDTH)),
        "w_s": nrm((L, GMLP_GROUPS, CHUNK, CHUNK), CHUNK),
        "b_s": 1.0 + 0.01 * jax.random.normal(next(ks), (L, GMLP_GROUPS, CHUNK), f32),
        "g_out_attn": gain((L, MLA_WIDTH)),
        "g_out_gmlp": gain((L, GMLP_WIDTH)),
        "w_out": nrm((L, MIX_WIDTH, D_MODEL), MIX_WIDTH),
        "g_ffn2": gain((L, D_MODEL)),
        "w2_gate": nrm((L, D_MODEL, D_FF), D_MODEL),
        "w2_up": nrm((L, D_MODEL, D_FF), D_MODEL),
        "w2_down": nrm((L, D_FF, D_MODEL), D_FF),
        "g_final": gain((D_MODEL,)),
    }


def _trunk(x, g_ffn1, w1_gate, w1_up, w1_down, g_mix, w_in, g_q, w_q_b, g_kv, w_kv_b,
           g_v, w_s, b_s, g_out_attn, g_out_gmlp, w_out, g_ffn2, w2_gate, w2_up, w2_down, g_final):
    for l in range(DEPTH):
        x = encoder_layer(x, g_ffn1[l], w1_gate[l], w1_up[l], w1_down[l], g_mix[l], w_in[l],
                          g_q[l], w_q_b[l], g_kv[l], w_kv_b[l], g_v[l], w_s[l], b_s[l],
                          g_out_attn[l], g_out_gmlp[l], w_out[l], g_ffn2[l],
                          w2_gate[l], w2_up[l], w2_down[l])
    return rms_norm(x, g_final)


def reference(x_prompt, x_sample, g_ffn1, w1_gate, w1_up, w1_down, g_mix, w_in, g_q, w_q_b,
              g_kv, w_kv_b, g_v, w_s, b_s, g_out_attn, g_out_gmlp, w_out, g_ffn2,
              w2_gate, w2_up, w2_down, g_final):
    y_prompt = _trunk(x_prompt, g_ffn1, w1_gate, w1_up, w1_down, g_mix, w_in, g_q, w_q_b,
                      g_kv, w_kv_b, g_v, w_s, b_s, g_out_attn, g_out_gmlp, w_out, g_ffn2,
                      w2_gate, w2_up, w2_down, g_final)
    y_sample = _trunk(x_sample, g_ffn1, w1_gate, w1_up, w1_down, g_mix, w_in, g_q, w_q_b,
                      g_kv, w_kv_b, g_v, w_s, b_s, g_out_attn, g_out_gmlp, w_out, g_ffn2,
                      w2_gate, w2_up, w2_down, g_final)
    return (y_prompt, y_sample)
```

```cpp
#include <hip/hip_runtime.h>
#include <hip/hip_cooperative_groups.h>
#include <cstdio>
#include <cstdint>
namespace cg = cooperative_groups;

#ifndef FP8_FFN1
#define FP8_FFN1 0
#endif
#ifndef FP8_FFN2
#define FP8_FFN2 1
#endif
constexpr float W8SCALE = 32.f;
#ifndef FP8_DOWN2
#define FP8_DOWN2 1
#endif
constexpr float ACT8SCALE = 8.f, W8MAX = 256.f;
#ifndef MK_ONE_LAUNCH
#define MK_ONE_LAUNCH 1
#endif

__device__ __forceinline__ int tid_of(int wv) { int l; asm volatile("v_mbcnt_lo_u32_b32 %0, -1, 0\n\tv_mbcnt_hi_u32_b32 %0, -1, %0" : "=v"(l)); return wv * 64 + l; }
template <int MASK> __device__ __forceinline__ float xor_get(float v) { return __int_as_float(__builtin_amdgcn_ds_swizzle(__float_as_int(v), 0x1F | (MASK << 10))); }
__device__ __forceinline__ float xor32_sum(float v) { auto rr = __builtin_amdgcn_permlane32_swap(__float_as_uint(v), __float_as_uint(v), false, false); return __uint_as_float(rr[0]) + __uint_as_float(rr[1]); }
namespace pg8 {
#define PG8_LAS __attribute__((address_space(3)))
typedef unsigned short bf16_t;
typedef short bf16x8 __attribute__((ext_vector_type(8)));
typedef float f32x4 __attribute__((ext_vector_type(4)));
typedef unsigned u32x4 __attribute__((ext_vector_type(4)));
constexpr int BM = 256, BK = 64, HALF = 128, HTB = HALF * BK * 2, STAGE_BYTES = 8 * HTB, NXCD = 8, WGM = 4;

__host__ __device__ __forceinline__ int lds_byte(int r, int c) { const int st = (r >> 4) * 2 + (c >> 5), rr = r & 15, cc = c & 31, ob = rr * 64 + cc * 2; return st * 1024 + (ob ^ (((ob >> 9) & 1) << 5)); }
__host__ __device__ __forceinline__ void stage_rc(int b, int& R, int& C) { const int st = b / 1024, sb = b % 1024, swz = sb ^ (((sb >> 9) & 1) << 5); R = (st >> 1) * 16 + swz / 64; C = (st & 1) * 32 + (swz % 64) / 2; }
__host__ __device__ __forceinline__ int perm32(int rho) { const int n = rho >> 4, i = rho & 15; return 8 * (i >> 2) + 4 * n + (i & 3); }

typedef unsigned long long u64;
constexpr float SSFIX = 1048576.f;
__device__ __forceinline__ float ss_get(const u64* p) { return (float)(*p) * (1.f / SSFIX); }
__device__ __forceinline__ void ss_add(u64* p, float v) { atomicAdd(p, (u64)(v * SSFIX)); }
struct Unit { int pm, pn; };
struct Gemm { const void* A; const void* Bt; int M, N, K, lda, ldb; };
typedef int i32x4 __attribute__((ext_vector_type(4)));
typedef int i32x8 __attribute__((ext_vector_type(8)));
__device__ __forceinline__ i32x8 cat8(bf16x8 lo, bf16x8 hi) { return __builtin_shufflevector(__builtin_bit_cast(i32x4, lo), __builtin_bit_cast(i32x4, hi), 0, 1, 2, 3, 4, 5, 6, 7); }

struct StaticOrder {
    int nM, nN, nwg, G, c;
    __host__ __device__ void init(int M, int N, int G_, int c_) { nM = M / BM; nN = N / BM; nwg = nM * nN; G = G_; c = c_; }
    __host__ __device__ bool next(int i, Unit& u) const {
        const long L = (long)i * G + c; if (L >= nwg) return false;
        int wgid = (int)L; { const int q = nwg / NXCD, r = nwg % NXCD, xcd = wgid % NXCD, off = wgid / NXCD; wgid = (xcd < r ? xcd * (q + 1) : r * (q + 1) + (xcd - r) * q) + off; }
        const int nig = WGM * nN, gid = wgid / nig, fm = gid * WGM, gsz = (nM - fm) < WGM ? (nM - fm) : WGM;
        u.pm = fm + ((wgid % nig) % gsz); u.pn = (wgid % nig) / gsz; return true;
    }
    __device__ __forceinline__ void a_ready(const Unit&) const {}
    __device__ __forceinline__ void done(const Unit&) const {}
};

__device__ __forceinline__ unsigned cvt_pk_bf16(float lo, float hi) { unsigned r; asm volatile("v_cvt_pk_bf16_f32 %0, %1, %2" : "=v"(r) : "v"(lo), "v"(hi)); return r; }

struct EpiBf16 {
    static constexpr bool PERM = true, AFTER_DRAIN = false;
    bf16_t* O; int ldc; const u64* ss; float inv_n;
    __device__ __forceinline__ void operator()(const f32x4 (&acc)[2][2][4][2], const Unit& u, int wr, int wc, int fr, int fq) const {
        const int row0 = u.pm * BM + wr * 64 + fr; const int col0 = u.pn * BM + wc * 32 + 8 * fq;
#pragma unroll
        for (int ai = 0; ai < 2; ++ai)
#pragma unroll
            for (int m = 0; m < 4; ++m) { const int row = row0 + ai * HALF + m * 16; bf16_t* rowp = O + (size_t)row * ldc + col0;
                const float rs = ss ? __builtin_amdgcn_rsqf(ss_get(ss + row) * inv_n + 1e-6f) : 1.f;
#pragma unroll
                for (int bj = 0; bj < 2; ++bj) { const f32x4 v0 = acc[ai][bj][m][0] * rs, v1 = acc[ai][bj][m][1] * rs;
                    u32x4 w; w.x = cvt_pk_bf16(v0[0], v0[1]); w.y = cvt_pk_bf16(v0[2], v0[3]); w.z = cvt_pk_bf16(v1[0], v1[1]); w.w = cvt_pk_bf16(v1[2], v1[3]);
                    *(u32x4*)(rowp + bj * HALF) = w; } }
    }
};
__device__ __forceinline__ float gelu_t(float x) { const float t = -2.302208198f * (x + 0.044715f * x * x * x); return x * __builtin_amdgcn_rcpf(1.0f + __builtin_amdgcn_exp2f(t)); }
__device__ __forceinline__ void rope8(f32x4& v0, f32x4& v1, const float* rp, int i0) {
    const f32x4 cs = *(const f32x4*)(rp + i0), sn = *(const f32x4*)(rp + 32 + i0);
    f32x4 a, b; a[0] = v0[0] * cs[0] - v0[1] * sn[0]; a[1] = v0[0] * sn[0] + v0[1] * cs[0]; a[2] = v0[2] * cs[1] - v0[3] * sn[1]; a[3] = v0[2] * sn[1] + v0[3] * cs[1];
    b[0] = v1[0] * cs[2] - v1[1] * sn[2]; b[1] = v1[0] * sn[2] + v1[1] * cs[2]; b[2] = v1[2] * cs[3] - v1[3] * sn[3]; b[3] = v1[2] * sn[3] + v1[3] * cs[3]; v0 = a; v1 = b;
}
struct EpiZ {
    static constexpr bool PERM = true, AFTER_DRAIN = false;
    bf16_t* O; int ldc; const u64* ssx; u64* ssq; u64* sskv; const float* rope;
    __device__ __forceinline__ void operator()(const f32x4 (&acc)[2][2][4][2], const Unit& u, int wr, int wc, int fr, int fq) const {
        const int row0 = u.pm * BM + wr * 64 + fr; const int col0 = u.pn * BM + wc * 32 + 8 * fq; const int pn = u.pn;
#pragma unroll
        for (int ai = 0; ai < 2; ++ai)
#pragma unroll
            for (int m = 0; m < 4; ++m) { const int row = row0 + ai * HALF + m * 16; bf16_t* rowp = O + (size_t)row * ldc + col0;
                const float rs = __builtin_amdgcn_rsqf(ss_get(ssx + row) * (1.f / 2048.f) + 1e-6f); float sq = 0.f;
#pragma unroll
                for (int bj = 0; bj < 2; ++bj) { f32x4 v0 = acc[ai][bj][m][0] * rs, v1 = acc[ai][bj][m][1] * rs;
                    if (pn < 4) { sq += (v0[0] * v0[0] + v0[1] * v0[1]) + (v0[2] * v0[2] + v0[3] * v0[3]) + (v1[0] * v1[0] + v1[1] * v1[1]) + (v1[2] * v1[2] + v1[3] * v1[3]); }
                    else if (pn == 4) { if (bj == 0 && wc < 2) { const int pos = row < 8192 ? row : (row & 2047); rope8(v0, v1, rope + (size_t)pos * 64, (wc * 32 + 8 * fq) >> 1); } }
                    else {
#pragma unroll
                        for (int e = 0; e < 4; ++e) { v0[e] = gelu_t(v0[e]); v1[e] = gelu_t(v1[e]); } }
                    u32x4 w; w.x = cvt_pk_bf16(v0[0], v0[1]); w.y = cvt_pk_bf16(v0[2], v0[3]); w.z = cvt_pk_bf16(v1[0], v1[1]); w.w = cvt_pk_bf16(v1[2], v1[3]);
                    *(u32x4*)(rowp + bj * HALF) = w; }
                if (pn < 4) { sq += xor_get<16>(sq); sq = xor32_sum(sq); if (fq == 0) ss_add((pn < 2 ? ssq : sskv) + row, sq); } }
    }
};
struct EpiQRope {
    static constexpr bool PERM = true, AFTER_DRAIN = false;
    bf16_t* O; int ldc; const float* rope; const u64* ss;
    __device__ __forceinline__ void operator()(const f32x4 (&acc)[2][2][4][2], const Unit& u, int wr, int wc, int fr, int fq) const {
        const int row0 = u.pm * BM + wr * 64 + fr; const int col0 = u.pn * BM + wc * 32 + 8 * fq;
#pragma unroll
        for (int ai = 0; ai < 2; ++ai)
#pragma unroll
            for (int m = 0; m < 4; ++m) { const int row = row0 + ai * HALF + m * 16; bf16_t* rowp = O + (size_t)row * ldc + col0;
                const int pos = row < 8192 ? row : (row & 2047); const float rs = __builtin_amdgcn_rsqf(ss_get(ss + row) * (1.f / 512.f) + 1e-6f);
#pragma unroll
                for (int bj = 0; bj < 2; ++bj) { f32x4 v0 = acc[ai][bj][m][0] * rs, v1 = acc[ai][bj][m][1] * rs;
                    const int c = col0 + bj * HALF; const int d = c % 192;
                    if (d >= 128) rope8(v0, v1, rope + (size_t)pos * 64, (d - 128) >> 1);
                    u32x4 w; w.x = cvt_pk_bf16(v0[0], v0[1]); w.y = cvt_pk_bf16(v0[2], v0[3]); w.z = cvt_pk_bf16(v1[0], v1[1]); w.w = cvt_pk_bf16(v1[2], v1[3]);
                    *(u32x4*)(rowp + bj * HALF) = w; } }
    }
};
template <bool OUT8 = false> struct EpiSwiGLU {
    static constexpr bool PERM = true, AFTER_DRAIN = false;
    bf16_t* O; int ldc; const float* rsc; const float* cmg; const float* cmu; float cscale;
    __device__ __forceinline__ void operator()(const f32x4 (&acc)[2][2][4][2], const Unit& u, int wr, int wc, int fr, int fq) const {
        const int row0 = u.pm * BM + wr * 64 + fr; const int col0 = u.pn * HALF + wc * 32 + 8 * fq;
        f32x4 sg[2], su[2];
#pragma unroll
        for (int n = 0; n < 2; ++n) { sg[n] = cmg ? *(const f32x4*)(cmg + col0 + 4 * n) * cscale : (f32x4){1.f, 1.f, 1.f, 1.f}; su[n] = cmu ? *(const f32x4*)(cmu + col0 + 4 * n) * cscale : (f32x4){1.f, 1.f, 1.f, 1.f}; }
#pragma unroll
        for (int ai = 0; ai < 2; ++ai)
#pragma unroll
            for (int m = 0; m < 4; ++m) { const int row = row0 + ai * HALF + m * 16; bf16_t* rowp = O + (size_t)row * ldc + col0;
                const float rs = rsc ? rsc[row] : 1.f;
                f32x4 r[2];
#pragma unroll
                for (int n = 0; n < 2; ++n) { const f32x4 g = acc[ai][0][m][n] * sg[n] * rs, up = acc[ai][1][m][n] * su[n] * rs;
#pragma unroll
                    for (int e = 0; e < 4; ++e) { const float sgm = __builtin_amdgcn_rcpf(1.0f + __builtin_amdgcn_exp2f(-1.4426950408889634f * g[e])); r[n][e] = g[e] * sgm * up[e]; } }
                if constexpr (OUT8) { typedef unsigned u32x2v __attribute__((ext_vector_type(2))); _Pragma("unroll") for (int e = 0; e < 4; ++e) { r[0][e] = __builtin_amdgcn_fmed3f(r[0][e] * ACT8SCALE, -448.f, 448.f); r[1][e] = __builtin_amdgcn_fmed3f(r[1][e] * ACT8SCALE, -448.f, 448.f); }

                    int w0 = __builtin_amdgcn_cvt_pk_fp8_f32(r[0][0], r[0][1], 0, false); w0 = __builtin_amdgcn_cvt_pk_fp8_f32(r[0][2], r[0][3], w0, true);
                    int w1 = __builtin_amdgcn_cvt_pk_fp8_f32(r[1][0], r[1][1], 0, false); w1 = __builtin_amdgcn_cvt_pk_fp8_f32(r[1][2], r[1][3], w1, true);
                    *(u32x2v*)((unsigned char*)O + (size_t)row * ldc + col0) = (u32x2v){(unsigned)w0, (unsigned)w1}; }
                else { u32x4 w; w.x = cvt_pk_bf16(r[0][0], r[0][1]); w.y = cvt_pk_bf16(r[0][2], r[0][3]); w.z = cvt_pk_bf16(r[1][0], r[1][1]); w.w = cvt_pk_bf16(r[1][2], r[1][3]);
                    *(u32x4*)rowp = w; } }
    }
};
template <bool HAS_XB, bool HAS_X8, int ALPHA2, bool HAS_SS = true, bool HAS_CS = false, bool BASE16 = false, bool HAS_OUT = true> struct EpiResid {
    static constexpr bool PERM = false, AFTER_DRAIN = false; static constexpr float alpha = 0.5f * ALPHA2;
    const void* base; float* out; int ldc; bf16_t* xb; u64* ss; unsigned char* x8; const float* cs; float csmul;
    __device__ __forceinline__ void operator()(const f32x4 (&acc)[2][2][4][2], const Unit& u, int wr, int wc, int fr, int fq) const {
        typedef unsigned u32x2v __attribute__((ext_vector_type(2)));
        const int row0 = u.pm * BM + wr * 64 + fr; const int col0 = u.pn * BM + wc * 32 + 4 * fq;
        f32x4 csv[2][2];
#pragma unroll
        for (int bj = 0; bj < 2; ++bj)
#pragma unroll
            for (int n = 0; n < 2; ++n) csv[bj][n] = HAS_CS ? *(const f32x4*)(cs + col0 + bj * HALF + n * 16) * (csmul * alpha) : (f32x4){alpha, alpha, alpha, alpha};
#pragma unroll
        for (int ai = 0; ai < 2; ++ai)
#pragma unroll
            for (int m = 0; m < 4; ++m) { const int row = row0 + ai * HALF + m * 16; const size_t off = (size_t)row * ldc + col0; float sq = 0.f;
#pragma unroll
                for (int bj = 0; bj < 2; ++bj)
#pragma unroll
                    for (int n = 0; n < 2; ++n) { const size_t p = off + bj * HALF + n * 16; f32x4 b;
                        if constexpr (BASE16) { const u32x2v wb = *(const u32x2v*)((const bf16_t*)base + p); b = (f32x4){__uint_as_float(wb.x << 16), __uint_as_float(wb.x & 0xffff0000u), __uint_as_float(wb.y << 16), __uint_as_float(wb.y & 0xffff0000u)}; }
                        else b = *(const f32x4*)((const float*)base + p);
                        const f32x4 v = b + acc[ai][bj][m][n] * csv[bj][n]; if constexpr (HAS_OUT) *(f32x4*)(out + p) = v;
                        if constexpr (HAS_XB) { u32x2v w; w.x = cvt_pk_bf16(v[0], v[1]); w.y = cvt_pk_bf16(v[2], v[3]); *(u32x2v*)(xb + p) = w; }
                        if constexpr (HAS_X8) { int w8 = __builtin_amdgcn_cvt_pk_fp8_f32(v[0], v[1], 0, false); w8 = __builtin_amdgcn_cvt_pk_fp8_f32(v[2], v[3], w8, true); *(int*)(x8 + p) = w8; }
                        sq += (v[0] * v[0] + v[1] * v[1]) + (v[2] * v[2] + v[3] * v[3]); }
                if constexpr (HAS_SS) { sq += xor_get<16>(sq); sq = xor32_sum(sq); if (fq == 0) ss_add(ss + row, sq); } }
    }
};

template <class Epi, class Sched, bool ALIGN_EPI = false, bool SP2 = false, int MODE = 0>
__device__ __forceinline__ void gemm_phase(PG8_LAS unsigned char* lds, const Gemm g, const Sched S, const Epi E, const int wv) {
    const int tid = tid_of(wv), wid = __builtin_amdgcn_readfirstlane(tid >> 6), lane = tid & 63, wr = wid >> 2, wc = wid & 3, fr = lane & 15, fq = lane >> 4;
    constexpr bool FP8 = MODE == 1, BYTE_ELEMS = MODE != 0; constexpr int ES = BYTE_ELEMS ? 1 : 2;
    const int K = g.K, nt = K * ES / 128;
    unsigned voffA[2], voffB[2];
#pragma unroll
    for (int i = 0; i < 2; ++i) { int R, C; stage_rc(tid * 16 + i * 8192, R, C); const int Rb = Epi::PERM ? ((R & ~31) + perm32(R & 31)) : R;
        voffA[i] = (unsigned)(R * g.lda * ES + C * 2); voffB[i] = (unsigned)(Rb * g.ldb * ES + C * 2); }
    const size_t roffA = (size_t)64 * g.lda * ES, roffB = (size_t)64 * g.ldb * ES;
    const size_t kstep = (size_t)(BK * 2);
    const size_t hstepA = (size_t)HALF * g.lda * ES, hstepB = (size_t)HALF * g.ldb * ES;
    const size_t tstepA = 2 * hstepA, tstepB = 2 * hstepB;
    const unsigned ldsw = (unsigned)wid * 1024u;
    const int aoff = lds_byte(wr * 64 + fr, fq * 8), boff = lds_byte(wc * 32 + fr, fq * 8);
#define PG8_SA(b, h) (((b) * 2 + (h)) * HTB)
#define PG8_SB(b, h) ((4 + (b) * 2 + (h)) * HTB)
#define PG8_STAGE(bufoff, gbase, voff) do { _Pragma("unroll") for (int _i = 0; _i < 2; ++_i) \
        __builtin_amdgcn_global_load_lds((const unsigned*)((const char*)(gbase) + (BYTE_ELEMS ? _i * r##voff + (v##voff)[0] : (v##voff)[_i])), (PG8_LAS unsigned*)(lds + (bufoff) + ldsw + _i * 8192), 16, 0, 0); } while (0)
#define PG8_LDA(dst, b, h) do { _Pragma("unroll") for (int m = 0; m < 4; ++m) _Pragma("unroll") for (int k = 0; k < 2; ++k) dst[m][k] = *(const PG8_LAS bf16x8*)(lds + PG8_SA(b, h) + aoff + m * 2048 + k * 1024); } while (0)
#define PG8_LDB(dst, b, h) do { _Pragma("unroll") for (int n = 0; n < 2; ++n) _Pragma("unroll") for (int k = 0; k < 2; ++k) dst[n][k] = *(const PG8_LAS bf16x8*)(lds + PG8_SB(b, h) + boff + n * 2048 + k * 1024); } while (0)
#define PG8_MMA(ai, bj, At, Bt) do { __builtin_amdgcn_s_setprio(1); if constexpr (FP8) { _Pragma("unroll") for (int m = 0; m < 4; ++m) _Pragma("unroll") for (int n = 0; n < 2; ++n) \
        acc[ai][bj][m][n] = __builtin_amdgcn_mfma_scale_f32_16x16x128_f8f6f4(cat8(Bt[n][0], Bt[n][1]), cat8(At[m][0], At[m][1]), acc[ai][bj][m][n], 0, 0, 0, 0, 0, 0); } \
      else if constexpr (MODE == 2) { _Pragma("unroll") for (int m = 0; m < 4; ++m) _Pragma("unroll") for (int n = 0; n < 2; ++n) _Pragma("unroll") for (int k = 0; k < 2; ++k) \
        acc[ai][bj][m][n] = __builtin_bit_cast(f32x4, __builtin_amdgcn_mfma_i32_16x16x64_i8(__builtin_bit_cast(i32x4, Bt[n][k]), __builtin_bit_cast(i32x4, At[m][k]), __builtin_bit_cast(i32x4, acc[ai][bj][m][n]), 0, 0, 0)); } \
      else { _Pragma("unroll") for (int m = 0; m < 4; ++m) _Pragma("unroll") for (int n = 0; n < 2; ++n) _Pragma("unroll") for (int k = 0; k < 2; ++k) \
        acc[ai][bj][m][n] = __builtin_amdgcn_mfma_f32_16x16x32_bf16(Bt[n][k], At[m][k], acc[ai][bj][m][n], 0, 0, 0); } __builtin_amdgcn_s_setprio(0); } while (0)
#define PG8_WAIT_V(n) asm volatile("s_waitcnt vmcnt(" #n ")" ::: "memory")
#define PG8_WAIT_L(n) asm volatile("s_waitcnt lgkmcnt(" #n ")" ::: "memory")
#define PG8_BAR __builtin_amdgcn_s_barrier()
#define PG8_SCHED __builtin_amdgcn_sched_barrier(0)
    Unit cur, nxt; int ui = 0;
    if (!S.next(0, cur)) return;
    f32x4 acc[2][2][4][2];
#pragma unroll
    for (int a = 0; a < 2; ++a)
#pragma unroll
        for (int b = 0; b < 2; ++b)
#pragma unroll
            for (int m = 0; m < 4; ++m)
#pragma unroll
                for (int n = 0; n < 2; ++n) acc[a][b][m][n] = (f32x4){0.f, 0.f, 0.f, 0.f};
    bf16x8 At[4][2], B0[2][2], B1[2][2];
    const char* cA = (const char*)g.A + (size_t)cur.pm * tstepA; const char* cB = (const char*)g.Bt + (size_t)cur.pn * tstepB;
    S.a_ready(cur);
    if constexpr (SP2) {
        PG8_STAGE(PG8_SB(0, 0), cB, offB); PG8_STAGE(PG8_SB(0, 1), cB + hstepB, offB); PG8_STAGE(PG8_SA(0, 0), cA, offA); PG8_STAGE(PG8_SA(0, 1), cA + hstepA, offA);
        if (wr == 1) PG8_BAR;
        PG8_WAIT_V(2); PG8_BAR;
        PG8_STAGE(PG8_SB(1, 0), cB + kstep, offB); PG8_STAGE(PG8_SA(1, 0), cA + kstep, offA); PG8_STAGE(PG8_SB(1, 1), cB + hstepB + kstep, offB);
        PG8_WAIT_V(6); PG8_BAR;
    } else {
        PG8_STAGE(PG8_SB(0, 0), cB, offB); PG8_STAGE(PG8_SA(0, 0), cA, offA); PG8_STAGE(PG8_SB(0, 1), cB + hstepB, offB); PG8_STAGE(PG8_SA(0, 1), cA + hstepA, offA);
        if (wr == 1) PG8_BAR;
        PG8_WAIT_V(4); PG8_BAR;
        PG8_STAGE(PG8_SB(1, 0), cB + kstep, offB); PG8_STAGE(PG8_SA(1, 0), cA + kstep, offA); PG8_STAGE(PG8_SB(1, 1), cB + hstepB + kstep, offB);
        PG8_WAIT_V(6); PG8_BAR;
    }
    for (;;) {
        const bool has_next = S.next(ui + 1, nxt);
        const char* nA = has_next ? (const char*)g.A + (size_t)nxt.pm * tstepA : cA; const char* nB = has_next ? (const char*)g.Bt + (size_t)nxt.pn * tstepB : cB;
        for (int t = 0; t < nt; t += 2) {
            const bool last = (t == nt - 2);
            const char* a1 = cA + (size_t)(t + 1) * kstep;
            const char* a2 = last ? nA : cA + (size_t)(t + 2) * kstep; const char* b2 = last ? nB : cB + (size_t)(t + 2) * kstep;
            const char* a3 = a2 + kstep; const char* b3 = b2 + kstep;
            if (last && has_next) S.a_ready(nxt);
            if constexpr (SP2) {
            PG8_LDB(B0, 0, 0); PG8_LDB(B1, 0, 1); PG8_SCHED; PG8_LDA(At, 0, 0); PG8_STAGE(PG8_SA(1, 1), a1 + hstepA, offA);
            PG8_WAIT_V(8); PG8_WAIT_L(0); PG8_BAR; PG8_MMA(0, 0, At, B0); PG8_MMA(0, 1, At, B1); PG8_BAR; PG8_SCHED;
            PG8_LDA(At, 0, 1); PG8_STAGE(PG8_SB(0, 0), b2, offB); PG8_STAGE(PG8_SB(0, 1), b2 + hstepB, offB); PG8_STAGE(PG8_SA(0, 0), a2, offA);
            PG8_WAIT_V(8); PG8_WAIT_L(0); PG8_BAR; PG8_MMA(1, 0, At, B0); PG8_MMA(1, 1, At, B1); PG8_BAR; PG8_SCHED;
            PG8_LDB(B0, 1, 0); PG8_LDB(B1, 1, 1); PG8_SCHED; PG8_LDA(At, 1, 0); PG8_STAGE(PG8_SA(0, 1), a2 + hstepA, offA);
            PG8_WAIT_V(8); PG8_WAIT_L(0); PG8_BAR; PG8_MMA(0, 0, At, B0); PG8_MMA(0, 1, At, B1); PG8_BAR; PG8_SCHED;
            PG8_LDA(At, 1, 1); PG8_STAGE(PG8_SB(1, 0), b3, offB); PG8_STAGE(PG8_SB(1, 1), b3 + hstepB, offB); PG8_STAGE(PG8_SA(1, 0), a3, offA);
            PG8_WAIT_V(8); PG8_WAIT_L(0); PG8_BAR; PG8_MMA(1, 0, At, B0); PG8_MMA(1, 1, At, B1); PG8_BAR; PG8_SCHED;
            } else {
            PG8_LDB(B0, 0, 0); PG8_SCHED; PG8_LDA(At, 0, 0); PG8_STAGE(PG8_SA(1, 1), a1 + hstepA, offA);
            PG8_WAIT_L(8); PG8_BAR; PG8_WAIT_L(0); PG8_MMA(0, 0, At, B0); PG8_BAR; PG8_SCHED;
            PG8_LDB(B1, 0, 1); PG8_STAGE(PG8_SB(0, 0), b2, offB);
            PG8_BAR; PG8_WAIT_L(0); PG8_MMA(0, 1, At, B1); PG8_BAR;
            PG8_LDA(At, 0, 1); PG8_STAGE(PG8_SA(0, 0), a2, offA);
            PG8_BAR; PG8_WAIT_L(0); PG8_MMA(1, 0, At, B0); PG8_BAR; PG8_SCHED;
            PG8_STAGE(PG8_SB(0, 1), b2 + hstepB, offB);
            PG8_WAIT_V(6); PG8_BAR; PG8_MMA(1, 1, At, B1); PG8_BAR;
            PG8_LDB(B0, 1, 0); PG8_SCHED; PG8_LDA(At, 1, 0); PG8_STAGE(PG8_SA(0, 1), a2 + hstepA, offA);
            PG8_WAIT_L(8); PG8_BAR; PG8_WAIT_L(0); PG8_MMA(0, 0, At, B0); PG8_BAR; PG8_SCHED;
            PG8_LDB(B1, 1, 1); PG8_STAGE(PG8_SB(1, 0), b3, offB);
            PG8_BAR; PG8_WAIT_L(0); PG8_MMA(0, 1, At, B1); PG8_BAR;
            PG8_LDA(At, 1, 1); PG8_STAGE(PG8_SA(1, 0), a3, offA);
            PG8_BAR; PG8_WAIT_L(0); PG8_MMA(1, 0, At, B0); PG8_BAR; PG8_SCHED;
            PG8_STAGE(PG8_SB(1, 1), b3 + hstepB, offB);
            PG8_WAIT_V(6); PG8_BAR; PG8_MMA(1, 1, At, B1); PG8_BAR;
            }
        }
        if constexpr (ALIGN_EPI) { if (wr == 0) PG8_BAR; }
        if constexpr (MODE == 2) {
#pragma unroll
            for (int a = 0; a < 2; ++a)
#pragma unroll
                for (int b = 0; b < 2; ++b)
#pragma unroll
                    for (int m = 0; m < 4; ++m)
#pragma unroll
                        for (int n = 0; n < 2; ++n) { const i32x4 iv = __builtin_bit_cast(i32x4, acc[a][b][m][n]); acc[a][b][m][n] = (f32x4){(float)iv[0], (float)iv[1], (float)iv[2], (float)iv[3]}; } }
        if constexpr (!Epi::AFTER_DRAIN) { const int t2 = tid_of(wv), l2 = t2 & 63; E(acc, cur, wid >> 2, wid & 3, l2 & 15, l2 >> 4); S.done(cur); }
        if (!has_next) break;
#pragma unroll
        for (int a = 0; a < 2; ++a)
#pragma unroll
            for (int b = 0; b < 2; ++b)
#pragma unroll
                for (int m = 0; m < 4; ++m)
#pragma unroll
                    for (int n = 0; n < 2; ++n) acc[a][b][m][n] = (f32x4){0.f, 0.f, 0.f, 0.f};
        cur = nxt; cA = nA; cB = nB; ++ui;
        if constexpr (ALIGN_EPI) { if (wr == 1) PG8_BAR; }
    }
    PG8_WAIT_V(0);
    if constexpr (!ALIGN_EPI) { if (wr == 0) PG8_BAR; }
    PG8_BAR;
#undef PG8_SA
#undef PG8_SB
#undef PG8_STAGE
#undef PG8_LDA
#undef PG8_LDB
#undef PG8_MMA
#undef PG8_WAIT_V
#undef PG8_WAIT_L
#undef PG8_BAR
#undef PG8_SCHED
}
}

typedef unsigned short bf16;
typedef float f32x4 __attribute__((ext_vector_type(4)));
typedef unsigned u32x4 __attribute__((ext_vector_type(4)));
typedef unsigned u32x2 __attribute__((ext_vector_type(2)));
typedef short bf16x8 __attribute__((ext_vector_type(8)));
typedef short s16x4 __attribute__((ext_vector_type(4)));
typedef float f32x16 __attribute__((ext_vector_type(16)));
#define LAS __attribute__((address_space(3)))

constexpr int DM = 2048, DFF = 5632, TP = 8192, TS = 16 * 2048, T = TP + TS;
constexpr int ZW = 3328;
constexpr int Z_KR = 1024, Z_U = 1280, Z_V = 2304;
constexpr int QW = 1536, KVW = 2048;
constexpr float EPS = 1e-6f;
constexpr size_t MiB = 1u << 20;
constexpr size_t WS_ROPE = 1 * MiB;
constexpr size_t WS_W1U = 4 * MiB, WS_W1D = WS_W1U + 44 * MiB, WS_W2U = WS_W1D + 22 * MiB, WS_W2D = WS_W2U + 44 * MiB, WS_WIN = WS_W2D + 22 * MiB;
constexpr size_t WS_WQ = WS_WIN + 13 * MiB, WS_WKV = WS_WQ + 2 * MiB, WS_WOUT = WS_WKV + 2 * MiB, WS_WSP = WS_WOUT + 8 * MiB;
constexpr size_t WS_H = 162 * MiB;
constexpr size_t WS_ACT = 322 * MiB;
constexpr size_t WS_Z = 322 * MiB, WS_Q = 582 * MiB, WS_KV = 702 * MiB;
constexpr size_t WS_H2 = 762 * MiB, WS_SS = 922 * MiB, WS_END = 924 * MiB;
constexpr size_t WS_CM = 64 * 1024, CM_BYTES = (4 * 5632 + 2048) * 4;
constexpr size_t WS_RS = 256 * 1024;
static_assert(WS_WSP + 262144 <= WS_H, "weights fit");
constexpr int LDS_BYTES = 147456;
constexpr int NPHASE = 13;

__device__ __forceinline__ float bf_lo(unsigned w) { return __uint_as_float(w << 16); }
__device__ __forceinline__ float bf_hi(unsigned w) { return __uint_as_float(w & 0xffff0000u); }
__device__ __forceinline__ unsigned pk2(float lo, float hi) { return pg8::cvt_pk_bf16(lo, hi); }
__device__ __forceinline__ void unpack8(const u32x4 w, float (&f)[8]) { f[0] = bf_lo(w.x); f[1] = bf_hi(w.x); f[2] = bf_lo(w.y); f[3] = bf_hi(w.y); f[4] = bf_lo(w.z); f[5] = bf_hi(w.z); f[6] = bf_lo(w.w); f[7] = bf_hi(w.w); }
__device__ __forceinline__ u32x4 pack8(const float (&f)[8]) { u32x4 w; w.x = pk2(f[0], f[1]); w.y = pk2(f[2], f[3]); w.z = pk2(f[4], f[5]); w.w = pk2(f[6], f[7]); return w; }
__device__ __forceinline__ float wave_sum(float v) { v += xor_get<1>(v); v += xor_get<2>(v); v += xor_get<4>(v); v += xor_get<8>(v); v += xor_get<16>(v); return xor32_sum(v); }
__device__ __forceinline__ float gelu_tanh(float x) {
    const float t = -2.302208198f * (x + 0.044715f * x * x * x);
    return x * __builtin_amdgcn_rcpf(1.0f + __builtin_amdgcn_exp2f(t));
}

__constant__ double c_inv_rev[32] = {0.15915494309189535, 0.11934937021124886, 0.08949940160889101, 0.06711508300522726, 0.050329212104487035, 0.03774158471741977, 0.0283021958306234, 0.02122365276477766, 0.015915494309189534, 0.011934937021124886, 0.008949940160889102, 0.006711508300522725, 0.005032921210448704, 0.003774158471741977, 0.00283021958306234, 0.0021223652764777662, 0.0015915494309189536, 0.0011934937021124885, 0.0008949940160889102, 0.0006711508300522726, 0.0005032921210448703, 0.00037741584717419774, 0.00028302195830623395, 0.0002122365276477766, 0.00015915494309189535, 0.00011934937021124886, 8.949940160889102e-05, 6.711508300522725e-05, 5.0329212104487035e-05, 3.774158471741978e-05, 2.8302195830623396e-05, 2.122365276477766e-05};

__device__ __forceinline__ int dst_row(int mode, int n) {
    if (mode == 1) return ((n >> 7) << 8) + (n & 127);
    if (mode == 2) return ((n >> 7) << 8) + 128 + (n & 127);
    if (mode == 3) { if (n < 1024) return n; if (n < 1088) { const int j = n - 1024; return 1024 + (j < 32 ? 2 * j : 2 * (j - 32) + 1); } return n + 192; }
    if (mode == 4) { const int h = n / 192, d = n - h * 192; if (d < 128) return n; const int j = d - 128; return h * 192 + 128 + (j < 32 ? 2 * j : 2 * (j - 32) + 1); }
    return n;
}
__device__ __forceinline__ void p0_transpose_item(const float* W, int K, int N, bf16* WT, int mode, LAS float* scr, int item, int lane, const float* gk = nullptr) {
    const int nblk = N / 64, kb = item / nblk, nb = item % nblk, k0 = 64 * kb, n0 = 64 * nb;
    const int lr = lane >> 4, lc = (lane & 15) * 4;
#pragma unroll 4
    for (int i = 0; i < 16; ++i) { const int kk = 4 * i + lr; f32x4 v = *(const f32x4*)(W + (size_t)(k0 + kk) * N + n0 + lc); if (gk) v = v * gk[k0 + kk];
        LAS float* d = scr + kk * 65 + lc; d[0] = v.x; d[1] = v.y; d[2] = v.z; d[3] = v.w; }
    asm volatile("s_waitcnt lgkmcnt(0)" ::: "memory");
    const int c = lane & 7;
#pragma unroll
    for (int j = 0; j < 8; ++j) { const int n = (lane >> 3) + 8 * j; const LAS float* sp = scr + (8 * c) * 65 + n;
        u32x4 o; o.x = pk2(sp[0 * 65], sp[1 * 65]); o.y = pk2(sp[2 * 65], sp[3 * 65]); o.z = pk2(sp[4 * 65], sp[5 * 65]); o.w = pk2(sp[6 * 65], sp[7 * 65]);
        *(u32x4*)(WT + (size_t)dst_row(mode, n0 + n) * K + k0 + 8 * c) = o; }
    asm volatile("s_waitcnt lgkmcnt(0)" ::: "memory");
}

__device__ __forceinline__ void p0_transpose_item8(const float* W, int K, int N, unsigned char* WT, int mode, LAS float* scr, int item, int lane, const float* gk, float wscale, const float* cm = nullptr) {
    const int nblk = N / 64, kb = item / nblk, nb = item % nblk, k0 = 64 * kb, n0 = 64 * nb;
    const int lr = lane >> 4, lc = (lane & 15) * 4;
#pragma unroll 4
    for (int i = 0; i < 16; ++i) { const int kk = 4 * i + lr; f32x4 v = *(const f32x4*)(W + (size_t)(k0 + kk) * N + n0 + lc); v = v * (wscale * (gk ? gk[k0 + kk] : 1.f));
        LAS float* d = scr + kk * 65 + lc; d[0] = v.x; d[1] = v.y; d[2] = v.z; d[3] = v.w; }
    asm volatile("s_waitcnt lgkmcnt(0)" ::: "memory");
    unsigned char* orow = WT + (size_t)dst_row(mode, n0 + lane) * K + k0; const float ls = cm ? W8MAX / fmaxf(cm[n0 + lane], 1e-30f) : 1.f;
#pragma unroll
    for (int ch = 0; ch < 4; ++ch) { const LAS float* sp = scr + (16 * ch) * 65 + lane; int w[4];
#pragma unroll
        for (int q = 0; q < 4; ++q) { int t = __builtin_amdgcn_cvt_pk_fp8_f32(sp[(4 * q) * 65] * ls, sp[(4 * q + 1) * 65] * ls, 0, false); w[q] = __builtin_amdgcn_cvt_pk_fp8_f32(sp[(4 * q + 2) * 65] * ls, sp[(4 * q + 3) * 65] * ls, t, true); }
        *(u32x4*)(orow + 16 * ch) = (u32x4){(unsigned)w[0], (unsigned)w[1], (unsigned)w[2], (unsigned)w[3]}; }
    asm volatile("s_waitcnt lgkmcnt(0)" ::: "memory");
}
__device__ __forceinline__ void rms_row_to_fp8(const float* xrow, const float* g, unsigned char* orow, int lane) {
    const f32x4* xr = (const f32x4*)xrow + lane;
    f32x4 v[8]; float s = 0.f;
#pragma unroll
    for (int j = 0; j < 8; ++j) { v[j] = xr[64 * j]; s += (v[j].x * v[j].x + v[j].y * v[j].y) + (v[j].z * v[j].z + v[j].w * v[j].w); }
    const float rstd = __builtin_amdgcn_rsqf(wave_sum(s) * (1.f / DM) + EPS);
    int* o4 = (int*)orow + lane;
#pragma unroll
    for (int j = 0; j < 8; ++j) { const f32x4 gg = ((const f32x4*)g)[lane + 64 * j]; int w = __builtin_amdgcn_cvt_pk_fp8_f32(v[j].x * rstd * gg.x, v[j].y * rstd * gg.y, 0, false);
        w = __builtin_amdgcn_cvt_pk_fp8_f32(v[j].z * rstd * gg.z, v[j].w * rstd * gg.w, w, true); o4[64 * j] = w; }
}
__device__ __forceinline__ float wave_max(float v) {
    v = fmaxf(v, xor_get<1>(v)); v = fmaxf(v, xor_get<2>(v)); v = fmaxf(v, xor_get<4>(v)); v = fmaxf(v, xor_get<8>(v)); v = fmaxf(v, xor_get<16>(v));
    auto rr = __builtin_amdgcn_permlane32_swap(__float_as_uint(v), __float_as_uint(v), false, false); return fmaxf(__uint_as_float(rr[0]), __uint_as_float(rr[1]));
}
__device__ __forceinline__ unsigned q8(float v) { int q = (int)__builtin_rintf(v); q = q < -127 ? -127 : (q > 127 ? 127 : q); return (unsigned)q & 0xffu; }
__device__ __forceinline__ unsigned q8x4(float a, float b, float c, float d) { return q8(a) | (q8(b) << 8) | (q8(c) << 16) | (q8(d) << 24); }
__device__ __forceinline__ void p0_colmax_item(const float* W, int K, int N, float* cm, int item, int lane, const float* gk) {
    const int nblk = N / 64, kq = item / nblk, nb = item % nblk, n0 = 64 * nb, kbeg = kq * (K / 4);
    const int lr = lane >> 4, lc = (lane & 15) * 4; f32x4 mx = {0.f, 0.f, 0.f, 0.f};
#pragma unroll 8
    for (int i = 0; i < K / 16; ++i) { const int k = kbeg + 4 * i + lr; f32x4 v = *(const f32x4*)(W + (size_t)k * N + n0 + lc); if (gk) v = v * gk[k];
        mx.x = fmaxf(mx.x, fabsf(v.x)); mx.y = fmaxf(mx.y, fabsf(v.y)); mx.z = fmaxf(mx.z, fabsf(v.z)); mx.w = fmaxf(mx.w, fabsf(v.w)); }
#pragma unroll
    for (int e = 0; e < 4; ++e) { float m = mx[e]; m = fmaxf(m, xor_get<16>(m)); auto rr = __builtin_amdgcn_permlane32_swap(__float_as_uint(m), __float_as_uint(m), false, false); m = fmaxf(__uint_as_float(rr[0]), __uint_as_float(rr[1])); mx[e] = m; }
    if (lane < 16) {
#pragma unroll
        for (int e = 0; e < 4; ++e) atomicMax((unsigned*)cm + n0 + lc + e, __float_as_uint(mx[e])); }
}
__device__ __forceinline__ void p0_transpose_item_i8(const float* W, int K, int N, unsigned char* WT, int mode, LAS float* scr, int item, int lane, const float* gk, const float* cm) {
    const int nblk = N / 64, kb = item / nblk, nb = item % nblk, k0 = 64 * kb, n0 = 64 * nb;
    const int lr = lane >> 4, lc = (lane & 15) * 4;
#pragma unroll 4
    for (int i = 0; i < 16; ++i) { const int kk = 4 * i + lr; f32x4 v = *(const f32x4*)(W + (size_t)(k0 + kk) * N + n0 + lc); if (gk) v = v * gk[k0 + kk];
        LAS float* d = scr + kk * 65 + lc; d[0] = v.x; d[1] = v.y; d[2] = v.z; d[3] = v.w; }
    asm volatile("s_waitcnt lgkmcnt(0)" ::: "memory");
    const float inv = 127.f / fmaxf(cm[n0 + lane], 1e-30f);
    unsigned char* orow = WT + (size_t)dst_row(mode, n0 + lane) * K + k0;
#pragma unroll
    for (int ch = 0; ch < 4; ++ch) { const LAS float* sp = scr + (16 * ch) * 65 + lane; unsigned w[4];
#pragma unroll
        for (int q = 0; q < 4; ++q) w[q] = q8x4(sp[(4 * q) * 65] * inv, sp[(4 * q + 1) * 65] * inv, sp[(4 * q + 2) * 65] * inv, sp[(4 * q + 3) * 65] * inv);
        *(u32x4*)(orow + 16 * ch) = (u32x4){w[0], w[1], w[2], w[3]}; }
    asm volatile("s_waitcnt lgkmcnt(0)" ::: "memory");
}
__device__ __forceinline__ void rms_row_to_i8(const float* xrow, const float* g, unsigned char* orow, float* rsc, int lane) {
    const f32x4* xr = (const f32x4*)xrow + lane;
    f32x4 v[8]; float s = 0.f;
#pragma unroll
    for (int j = 0; j < 8; ++j) { v[j] = xr[64 * j]; s += (v[j].x * v[j].x + v[j].y * v[j].y) + (v[j].z * v[j].z + v[j].w * v[j].w); }
    const float rstd = __builtin_amdgcn_rsqf(wave_sum(s) * (1.f / DM) + EPS); float mx = 0.f;
#pragma unroll
    for (int j = 0; j < 8; ++j) { const f32x4 gg = ((const f32x4*)g)[lane + 64 * j]; v[j] = v[j] * rstd * gg; mx = fmaxf(fmaxf(mx, fmaxf(fabsf(v[j].x), fabsf(v[j].y))), fmaxf(fabsf(v[j].z), fabsf(v[j].w))); }
    mx = fmaxf(wave_max(mx), 1e-30f); const float inv = 127.f / mx;
    unsigned* o4 = (unsigned*)orow + lane;
#pragma unroll
    for (int j = 0; j < 8; ++j) o4[64 * j] = q8x4(v[j].x * inv, v[j].y * inv, v[j].z * inv, v[j].w * inv);
    if (lane == 0) *rsc = mx * (1.f / 127.f);
}
__device__ __forceinline__ void bf16_row_to_i8(const bf16* xrow, unsigned char* orow, float* rsc, int lane) {
    const u32x4* xr = (const u32x4*)xrow + lane; float f[4][8]; float s = 0.f, mx = 0.f;
#pragma unroll
    for (int j = 0; j < 4; ++j) { unpack8(xr[64 * j], f[j]);
#pragma unroll
        for (int e = 0; e < 8; ++e) { s += f[j][e] * f[j][e]; mx = fmaxf(mx, fabsf(f[j][e])); } }
    const float rstd = __builtin_amdgcn_rsqf(wave_sum(s) * (1.f / DM) + EPS); mx = fmaxf(wave_max(mx), 1e-30f); const float inv = 127.f / mx;
    u32x2* o8 = (u32x2*)orow + lane;
#pragma unroll
    for (int j = 0; j < 4; ++j) { u32x2 w; w.x = q8x4(f[j][0] * inv, f[j][1] * inv, f[j][2] * inv, f[j][3] * inv); w.y = q8x4(f[j][4] * inv, f[j][5] * inv, f[j][6] * inv, f[j][7] * inv); o8[64 * j] = w; }
    if (lane == 0) *rsc = mx * (1.f / 127.f) * rstd;
}
__device__ __forceinline__ void rms_row_to_bf16(const float* xrow, const float* g, bf16* orow, int lane) {
    const f32x4* xr = (const f32x4*)xrow + lane;
    f32x4 v[8]; float s = 0.f;
#pragma unroll
    for (int j = 0; j < 8; ++j) { v[j] = xr[64 * j]; s += (v[j].x * v[j].x + v[j].y * v[j].y) + (v[j].z * v[j].z + v[j].w * v[j].w); }
    const float rstd = __builtin_amdgcn_rsqf(wave_sum(s) * (1.f / DM) + EPS);
    u32x2* o8 = (u32x2*)orow + lane;
#pragma unroll
    for (int j = 0; j < 8; ++j) { const f32x4 gg = ((const f32x4*)g)[lane + 64 * j]; u32x2 w; w.x = pk2(v[j].x * rstd * gg.x, v[j].y * rstd * gg.y); w.y = pk2(v[j].z * rstd * gg.z, v[j].w * rstd * gg.w); o8[64 * j] = w; }
}
__device__ __forceinline__ void rms_row_inplace_f32(float* xrow, const float* g, int lane) {
    f32x4* xr = (f32x4*)xrow + lane;
    f32x4 v[8]; float s = 0.f;
#pragma unroll
    for (int j = 0; j < 8; ++j) { v[j] = xr[64 * j]; s += (v[j].x * v[j].x + v[j].y * v[j].y) + (v[j].z * v[j].z + v[j].w * v[j].w); }
    const float rstd = __builtin_amdgcn_rsqf(wave_sum(s) * (1.f / DM) + EPS);
#pragma unroll
    for (int j = 0; j < 8; ++j) { const f32x4 gg = ((const f32x4*)g)[lane + 64 * j]; xr[64 * j] = v[j] * rstd * gg; }
}


__device__ __forceinline__ void onorm_row(bf16* o, const float* g_a, const float* g_g, int lane) {
#pragma unroll
    for (int half = 0; half < 2; ++half) {
        u32x4* p = (u32x4*)(o + half * 1024) + lane; float f0[8], f1[8]; unpack8(p[0], f0); unpack8(p[64], f1); float s = 0.f;
#pragma unroll
        for (int e = 0; e < 8; ++e) s += f0[e] * f0[e] + f1[e] * f1[e];
        const float rstd = __builtin_amdgcn_rsqf(wave_sum(s) * (1.f / 1024.f) + EPS);
        const float* g = (half ? g_g : g_a) + 8 * lane;
#pragma unroll
        for (int e = 0; e < 8; ++e) { f0[e] *= rstd * g[e]; f1[e] *= rstd * g[512 + e]; }
        p[0] = pack8(f0); p[64] = pack8(f1);
    }
}

namespace att {
constexpr int NW = 8, QBLK = 32, KVBLK = 64;
constexpr int LDQ = QW, LDKV = KVW, LDKR = ZW, LDO = DM;
constexpr float SCALE = 0.07216878364870322f;
constexpr float THR = 8.f;
#ifndef ATT_SDEPTH
#define ATT_SDEPTH 1
#endif
constexpr int SDEPTH = ATT_SDEPTH;
constexpr int SHM_V = KVBLK * 128 * 2, SHM_K = KVBLK * 128 * 2, SHM_KR = KVBLK * 64 * 2;
#ifndef ATT_NQL
#define ATT_NQL 0
#endif
constexpr int NQL = ATT_NQL, NQR = 12 - NQL;
constexpr int OFF_V = 0, OFF_K = 2 * SHM_V, OFF_KR = OFF_K + 2 * SHM_K, OFF_WS = OFF_KR + 2 * SHM_KR, OFF_QL = OFF_WS + NW * 64 * 4, ATT_LDS = OFF_QL + NW * NQL * 1024;
static_assert(ATT_LDS <= 147456, "attention LDS");
#define KSWZ(row, colB) ((row) * 256 + ((colB) ^ (((row) & 7) << 4)))
#define KRSWZ(row, colB) ((row) * 128 + ((colB) ^ ((((row) >> 1) & 7) << 4)))
#define SBAR() __builtin_amdgcn_sched_barrier(0)
__device__ __forceinline__ int crow(int r, int hi) { return (r & 3) + 8 * (r >> 2) + 4 * hi; }
__device__ __forceinline__ unsigned cvtpk(float lo, float hi) { unsigned r; asm volatile("v_cvt_pk_bf16_f32 %0, %1, %2" : "=v"(r) : "v"(lo), "v"(hi)); return r; }

__device__ __forceinline__ void partialSM(f32x16& p0, f32x16& p1, float& m_reg, float& mn, float& alpha) {
  constexpr float C = SCALE * 1.4426950408889634f;
  float pmax = p0[0];
#pragma unroll
  for (int r = 1; r < 16; ++r) pmax = fmaxf(pmax, p0[r]);
#pragma unroll
  for (int r = 0; r < 16; ++r) pmax = fmaxf(pmax, p1[r]);
  { auto rr = __builtin_amdgcn_permlane32_swap(__float_as_uint(pmax), __float_as_uint(pmax), false, false);
    pmax = fmaxf(__uint_as_float(rr[0]), __uint_as_float(rr[1])); }
  if (__builtin_expect(__all(pmax - m_reg <= THR / SCALE), 1)) { mn = m_reg; alpha = 1.f; }
  else { mn = fmaxf(m_reg, pmax); alpha = __builtin_amdgcn_exp2f((m_reg - mn) * C); m_reg = mn; }
  float mnC = -mn * C;
#pragma unroll
  for (int r = 0; r < 16; ++r) p0[r] = fmaf(p0[r], C, mnC);
#pragma unroll
  for (int r = 0; r < 16; ++r) p1[r] = fmaf(p1[r], C, mnC);
#pragma unroll
  for (int r = 0; r < 16; ++r) p0[r] = __builtin_amdgcn_exp2f(p0[r]);
}
__device__ __forceinline__ void finishSM(f32x16& p0, f32x16& p1, float alpha, float& l_reg, bf16x8& pa0, bf16x8& pa1, bf16x8& pa2, bf16x8& pa3) {
#pragma unroll
  for (int r = 0; r < 16; ++r) p1[r] = __builtin_amdgcn_exp2f(p1[r]);
  float ps = 0;
#pragma unroll
  for (int r = 0; r < 16; ++r) ps += p0[r];
#pragma unroll
  for (int r = 0; r < 16; ++r) ps += p1[r];
  { auto rr = __builtin_amdgcn_permlane32_swap(__float_as_uint(ps), __float_as_uint(ps), false, false);
    ps = __uint_as_float(rr[0]) + __uint_as_float(rr[1]); }
  l_reg = l_reg * alpha + ps;
#define PK4(P, BASE, OUT) do { unsigned a0 = cvtpk(P[BASE + 0], P[BASE + 1]), a1 = cvtpk(P[BASE + 2], P[BASE + 3]);   \
    unsigned b0 = cvtpk(P[BASE + 4], P[BASE + 5]), b1 = cvtpk(P[BASE + 6], P[BASE + 7]);                              \
    auto r0 = __builtin_amdgcn_permlane32_swap(a0, b0, false, false); auto r1 = __builtin_amdgcn_permlane32_swap(a1, b1, false, false); \
    u32x4 w = {r0[0], r1[0], r0[1], r1[1]}; OUT = *reinterpret_cast<bf16x8*>(&w); } while (0)
  PK4(p0, 0, pa0); PK4(p0, 8, pa1); PK4(p1, 0, pa2); PK4(p1, 8, pa3);
#undef PK4
}
#define QF(d) ((d) < NQR ? qr[(d) < NQR ? (d) : 0] : *reinterpret_cast<const bf16x8*>(ql + ((d) - NQR) * 1024))
__device__ __forceinline__ void qkt(f32x16& p0, f32x16& p1, const char* Ks, const char* Krs, const bf16x8* qr, const char* ql, int r32, int hi) {
  p0 = f32x16{}; p1 = f32x16{};
#pragma unroll
  for (int d0 = 0; d0 < 8; ++d0) { int cb = (d0 * 16 + hi * 8) * 2;
    bf16x8 b0 = *reinterpret_cast<const bf16x8*>(Ks + KSWZ(r32, cb));
    bf16x8 b1 = *reinterpret_cast<const bf16x8*>(Ks + KSWZ(32 + r32, cb));
    const bf16x8 qf = QF(d0);
    p0 = __builtin_amdgcn_mfma_f32_32x32x16_bf16(b0, qf, p0, 0, 0, 0);
    p1 = __builtin_amdgcn_mfma_f32_32x32x16_bf16(b1, qf, p1, 0, 0, 0); }
#pragma unroll
  for (int d0 = 0; d0 < 4; ++d0) { int cb = (d0 * 16 + hi * 8) * 2;
    bf16x8 b0 = *reinterpret_cast<const bf16x8*>(Krs + KRSWZ(r32, cb));
    bf16x8 b1 = *reinterpret_cast<const bf16x8*>(Krs + KRSWZ(32 + r32, cb));
    const bf16x8 qf = QF(8 + d0);
    p0 = __builtin_amdgcn_mfma_f32_32x32x16_bf16(b0, qf, p0, 0, 0, 0);
    p1 = __builtin_amdgcn_mfma_f32_32x32x16_bf16(b1, qf, p1, 0, 0, 0); }
}
__device__ __forceinline__ int v_st(int k, int c) { const int kk = (k & ~0xC) | ((k & 4) << 1) | ((k & 8) >> 1); return ((kk >> 3) * 4 + (c >> 5)) * 512 + ((kk & 7) * 32 + (c & 31)) * 2; }
__device__ __forceinline__ int v_rd_base(int lane) { return ((lane & 3) << 3) | (((lane >> 2) & 3) << 6) | (((lane >> 4) & 1) << 5) | (((lane >> 5) & 1) << 8); }
constexpr int v_rd_off(int d0, int ks, int half) { return d0 * 512 + ks * 4096 + half * 2048; }
template <int OFF> __device__ __forceinline__ s16x4 tr_read(int vb) {
  s16x4 r; asm volatile("ds_read_b64_tr_b16 %0, %1 offset:%2" : "=&v"(r) : "v"(vb), "i"(OFF) : "memory"); return r;
}
template <int D0> __device__ __forceinline__ void pv_one(f32x16& od, int vb, bf16x8 pa0, bf16x8 pa1, bf16x8 pa2, bf16x8 pa3) {
  const s16x4 l0 = tr_read<v_rd_off(D0, 0, 0)>(vb), h0 = tr_read<v_rd_off(D0, 0, 1)>(vb), l1 = tr_read<v_rd_off(D0, 1, 0)>(vb), h1 = tr_read<v_rd_off(D0, 1, 1)>(vb);
  const s16x4 l2 = tr_read<v_rd_off(D0, 2, 0)>(vb), h2 = tr_read<v_rd_off(D0, 2, 1)>(vb), l3 = tr_read<v_rd_off(D0, 3, 0)>(vb), h3 = tr_read<v_rd_off(D0, 3, 1)>(vb);
  asm volatile("s_waitcnt lgkmcnt(0)" ::: "memory"); SBAR();
#define PK(L, H) (bf16x8){L[0], L[1], L[2], L[3], H[0], H[1], H[2], H[3]}
  od = __builtin_amdgcn_mfma_f32_32x32x16_bf16(pa0, PK(l0, h0), od, 0, 0, 0);
  od = __builtin_amdgcn_mfma_f32_32x32x16_bf16(pa1, PK(l1, h1), od, 0, 0, 0);
  od = __builtin_amdgcn_mfma_f32_32x32x16_bf16(pa2, PK(l2, h2), od, 0, 0, 0);
  od = __builtin_amdgcn_mfma_f32_32x32x16_bf16(pa3, PK(l3, h3), od, 0, 0, 0);
#undef PK
}
__device__ __forceinline__ void pv_d0(f32x16* o, int vb, bf16x8 pa0, bf16x8 pa1, bf16x8 pa2, bf16x8 pa3) {
  pv_one<0>(o[0], vb, pa0, pa1, pa2, pa3); pv_one<1>(o[1], vb, pa0, pa1, pa2, pa3); pv_one<2>(o[2], vb, pa0, pa1, pa2, pa3); pv_one<3>(o[3], vb, pa0, pa1, pa2, pa3);
}

__device__ __forceinline__ void attn_dense_body(const bf16* __restrict__ Qb, const bf16* __restrict__ Kn, const bf16* __restrict__ Kr, const bf16* __restrict__ Vh,
                                                bf16* __restrict__ Ob, int seq, char* lds, const int wv) {
  const int tid = tid_of(wv), wid = tid >> 6, lane = tid & 63, r32 = lane & 31, hi = lane >> 5;
  char* V_lds = lds + OFF_V; char* K_lds = lds + OFF_K; char* KR_lds = lds + OFF_KR;
  float* ws = (float*)(lds + OFF_WS) + wid * 64; float* li_l = ws; float* al_l = ws + 32;
  float m_reg = -1e30f, l_reg = 0; f32x16 o[4] = {}; bf16x8 qr[NQR]; char* ql = lds + OFF_QL + wid * (NQL * 1024) + lane * 16;
  const bf16* Qw = Qb + (long)(wid * QBLK + r32) * LDQ + hi * 8;
#pragma unroll
  for (int d0 = 0; d0 < 12; ++d0) { const bf16x8 t = *reinterpret_cast<const bf16x8*>(Qw + d0 * 16); if (d0 < NQR) qr[d0 < NQR ? d0 : 0] = t; else *reinterpret_cast<bf16x8*>(ql + (d0 - NQR) * 1024) = t; }
  const int sr = tid >> 4, sc = (tid & 15) * 8, vst0 = v_st(sr, sc), vst1 = v_st(32 + sr, sc);
  const int krr = tid >> 3, krc = (tid & 7) * 8;
  const int vb0 = (int)(uintptr_t)V_lds + v_rd_base(lane);
  struct { bf16x8 vs0, vs1, ks0, ks1, kr; } sr_[SDEPTH];
const unsigned offV0 = (unsigned)(sr * LDKV + sc) * 2u, offV1 = (unsigned)((32 + sr) * LDKV + sc) * 2u, offKR = (unsigned)(krr * LDKR + krc) * 2u;
#define SLOAD(i, k0) do { const char* vt_ = (const char*)Vh + (size_t)(k0) * (LDKV * 2); const char* kt_ = (const char*)Kn + (size_t)(k0) * (LDKV * 2); const char* rt_ = (const char*)Kr + (size_t)(k0) * (LDKR * 2); \
    sr_[i].vs0 = *reinterpret_cast<const bf16x8*>(vt_ + offV0); sr_[i].vs1 = *reinterpret_cast<const bf16x8*>(vt_ + offV1); \
    sr_[i].ks0 = *reinterpret_cast<const bf16x8*>(kt_ + offV0); sr_[i].ks1 = *reinterpret_cast<const bf16x8*>(kt_ + offV1); \
    sr_[i].kr = *reinterpret_cast<const bf16x8*>(rt_ + offKR); } while (0)
#define SWRITE(b, i) do { *(bf16x8*)(V_lds + (b) * SHM_V + vst0) = sr_[i].vs0;          \
    *(bf16x8*)(V_lds + (b) * SHM_V + vst1) = sr_[i].vs1; int kc = sc * 2;               \
    *(bf16x8*)(K_lds + (b) * SHM_K + KSWZ(sr, kc)) = sr_[i].ks0;                       \
    *(bf16x8*)(K_lds + (b) * SHM_K + KSWZ(32 + sr, kc)) = sr_[i].ks1;                  \
    *(bf16x8*)(KR_lds + (b) * SHM_KR + KRSWZ(krr, krc * 2)) = sr_[i].kr; } while (0)
#define SWAIT() do { if constexpr (SDEPTH == 2) asm volatile("s_waitcnt vmcnt(5)" ::: "memory"); else asm volatile("s_waitcnt vmcnt(0)" ::: "memory"); } while (0)
#define RESC(a) do { if (__any((a) < 1.f)) { if (hi == 0) al_l[r32] = (a); asm volatile("s_waitcnt lgkmcnt(0)" ::: "memory"); \
    _Pragma("unroll") for (int d = 0; d < 4; ++d) _Pragma("unroll") for (int r = 0; r < 16; ++r) o[d][r] *= al_l[crow(r, hi)]; } } while (0)
  f32x16 pA0, pA1, pB0, pB1; float mnA, mnB, alA, alB; bf16x8 pa0, pa1, pa2, pa3; const int NT = seq / KVBLK;
  constexpr int SE = 0, SO = SDEPTH - 1;
  SLOAD(SE, 0); asm volatile("s_waitcnt vmcnt(0)" ::: "memory"); SWRITE(0, SE); __syncthreads();
  qkt(pA0, pA1, K_lds, KR_lds, qr, ql, r32, hi); partialSM(pA0, pA1, m_reg, mnA, alA);
  SLOAD(SO, KVBLK); if constexpr (SDEPTH == 2) { if (2 < NT) SLOAD(SE, 2 * KVBLK); }
  SWAIT(); SWRITE(1, SO); __syncthreads();
  for (int j = 1; j + 1 < NT; j += 2) {
    SBAR(); qkt(pB0, pB1, K_lds + SHM_K, KR_lds + SHM_KR, qr, ql, r32, hi);
    finishSM(pA0, pA1, alA, l_reg, pa0, pa1, pa2, pa3); SBAR();
    SLOAD(SO, (j + SDEPTH) * KVBLK); SBAR();
    pv_d0(o, vb0, pa0, pa1, pa2, pa3); partialSM(pB0, pB1, m_reg, mnB, alB);
    __syncthreads(); SWAIT(); SWRITE(0, SE);
    RESC(alB); __syncthreads();
    SBAR(); qkt(pA0, pA1, K_lds, KR_lds, qr, ql, r32, hi);
    finishSM(pB0, pB1, alB, l_reg, pa0, pa1, pa2, pa3); SBAR();
    if (SDEPTH == 1 || j + 3 < NT) SLOAD(SE, (j + 1 + SDEPTH) * KVBLK); SBAR();
    pv_d0(o, vb0 + SHM_V, pa0, pa1, pa2, pa3); partialSM(pA0, pA1, m_reg, mnA, alA);
    __syncthreads(); SWAIT(); SWRITE(1, SO);
    RESC(alA); __syncthreads();
  }
  SBAR(); qkt(pB0, pB1, K_lds + SHM_K, KR_lds + SHM_KR, qr, ql, r32, hi);
  finishSM(pA0, pA1, alA, l_reg, pa0, pa1, pa2, pa3); SBAR();
  pv_d0(o, vb0, pa0, pa1, pa2, pa3); partialSM(pB0, pB1, m_reg, mnB, alB);
  __syncthreads(); RESC(alB);
  finishSM(pB0, pB1, alB, l_reg, pa0, pa1, pa2, pa3); SBAR();
  pv_d0(o, vb0 + SHM_V, pa0, pa1, pa2, pa3);
  if (hi == 0) li_l[r32] = l_reg; asm volatile("s_waitcnt lgkmcnt(0)" ::: "memory");
  float rli[16];
#pragma unroll
  for (int r = 0; r < 16; ++r) rli[r] = __builtin_amdgcn_rcpf(li_l[crow(r, hi)]);
  bf16* Ow = Ob + (long)(wid * QBLK) * LDO;
#pragma unroll
  for (int r = 0; r < 16; ++r) { int orow = crow(r, hi);
#pragma unroll
    for (int d0 = 0; d0 < 4; ++d0) Ow[(long)orow * LDO + d0 * 32 + r32] = (bf16)(cvtpk(o[d0][r] * rli[r], 0.f) & 0xffffu); }
#undef SLOAD
#undef SWRITE
#undef SWAIT
#undef RESC
}
}

__device__ __forceinline__ void gmlp_unit(const bf16* Z, const bf16* Wsp, const float* b_s, const float* g_v, bf16* O, int chunk, int g, char* lds, const int wv) {
  const int tid = tid_of(wv), wid = tid >> 6, lane = tid & 63, r32 = lane & 31, hi = lane >> 5;
  constexpr int PITCH = 136;
  bf16* VT = (bf16*)lds;
  const bf16* Zc = Z + (size_t)chunk * 128 * ZW;
  bf16x8 af[8];
  { const bf16* Ar = Wsp + (size_t)g * 16384 + (size_t)((wid & 3) * 32 + r32) * 128 + hi * 8;
#pragma unroll
    for (int k = 0; k < 8; ++k) af[k] = *reinterpret_cast<const bf16x8*>(Ar + k * 16); }
  __syncthreads();
  {
    const int j = tid >> 2, cg = tid & 3; u32x4 w[4]; float sq = 0.f;
    const bf16* zr = Zc + (size_t)j * ZW + Z_V + g * 128 + cg * 8;
#pragma unroll
    for (int i = 0; i < 4; ++i) w[i] = *(const u32x4*)(zr + 32 * i);
#pragma unroll
    for (int i = 0; i < 4; ++i) { float f[8]; unpack8(w[i], f);
#pragma unroll
      for (int e = 0; e < 8; ++e) sq += f[e] * f[e]; }
    sq += xor_get<1>(sq); sq += xor_get<2>(sq);
    const float rs = __builtin_amdgcn_rsqf(sq * (1.f / 128.f) + EPS);
#pragma unroll
    for (int i = 0; i < 4; ++i) { const int c0 = (cg + 4 * i) * 8; float f[8]; unpack8(w[i], f);
      const float* gp = g_v + g * 128 + c0; const f32x4 g0 = *(const f32x4*)gp, g1 = *(const f32x4*)(gp + 4);
      unsigned p0 = pk2(f[0] * rs * g0.x, f[1] * rs * g0.y), p1 = pk2(f[2] * rs * g0.z, f[3] * rs * g0.w), p2 = pk2(f[4] * rs * g1.x, f[5] * rs * g1.y), p3 = pk2(f[6] * rs * g1.z, f[7] * rs * g1.w);
      if (cg & 1) { const unsigned t = p0; p0 = p1; p1 = p2; p2 = p3; p3 = t; }
      if (cg & 2) { unsigned t = p0; p0 = p2; p2 = t; t = p1; p1 = p3; p3 = t; }
      const unsigned q[4] = {p0, p1, p2, p3};
#pragma unroll
      for (int d = 0; d < 4; ++d) { const int dd = (d + cg) & 3; VT[(c0 + 2 * dd) * PITCH + j] = (bf16)(q[d] & 0xffff); VT[(c0 + 2 * dd + 1) * PITCH + j] = (bf16)(q[d] >> 16); } }
  }
  __syncthreads();
  const int ib = (wid & 3) * 32, cb = (wid >> 2) * 64;
  f32x16 a0 = {}, a1 = {};
#pragma unroll
  for (int k = 0; k < 8; ++k) {
    const bf16x8 b0 = *reinterpret_cast<const bf16x8*>(VT + (cb + r32) * PITCH + k * 16 + hi * 8);
    const bf16x8 b1 = *reinterpret_cast<const bf16x8*>(VT + (cb + 32 + r32) * PITCH + k * 16 + hi * 8);
    a0 = __builtin_amdgcn_mfma_f32_32x32x16_bf16(b0, af[k], a0, 0, 0, 0);
    a1 = __builtin_amdgcn_mfma_f32_32x32x16_bf16(b1, af[k], a1, 0, 0, 0);
  }
  { const int i = ib + r32; const float bb = b_s[g * 128 + i]; const size_t row = (size_t)chunk * 128 + i;
    const bf16* up = Z + row * ZW + Z_U + g * 128 + cb + 4 * hi; bf16* op = O + row * DM + 1024 + g * 128 + cb + 4 * hi;
#pragma unroll
    for (int q = 0; q < 4; ++q) {
      const u32x2 w0 = *(const u32x2*)(up + 8 * q), w1 = *(const u32x2*)(up + 32 + 8 * q);
      u32x2 o0, o1;
      o0.x = pk2(bf_lo(w0.x) * (a0[4 * q + 0] + bb), bf_hi(w0.x) * (a0[4 * q + 1] + bb)); o0.y = pk2(bf_lo(w0.y) * (a0[4 * q + 2] + bb), bf_hi(w0.y) * (a0[4 * q + 3] + bb));
      o1.x = pk2(bf_lo(w1.x) * (a1[4 * q + 0] + bb), bf_hi(w1.x) * (a1[4 * q + 1] + bb)); o1.y = pk2(bf_lo(w1.y) * (a1[4 * q + 2] + bb), bf_hi(w1.y) * (a1[4 * q + 3] + bb));
      *(u32x2*)(op + 8 * q) = o0; *(u32x2*)(op + 32 + 8 * q) = o1; } }
}

#define XB_TMO      128
#define XB_XCNT(j)  (256  + 64 * (j))
#define XB_XSUB(j)  (1280 + 64 * (j))
#define XB_XGEN(j)  (2304 + 64 * (j))
#define XB_TOP      3328
#define XB_TOPGEN   3392
#define XCD_BAR_WORDS 3456
#define XB_SPIN_CAP (1u << 18)
__device__ __forceinline__ unsigned xb_ld(unsigned* p)              { return __hip_atomic_load(p, __ATOMIC_RELAXED, __HIP_MEMORY_SCOPE_AGENT); }
__device__ __forceinline__ unsigned xb_add(unsigned* p, unsigned v) { return __hip_atomic_fetch_add(p, v, __ATOMIC_RELAXED, __HIP_MEMORY_SCOPE_AGENT); }
__device__ __forceinline__ unsigned xb_xcc_id() { return (unsigned)__builtin_amdgcn_s_getreg((3 << 11) | 20) & 0xFu; }
#define XB_SPIN(cond, bar) do { unsigned _sp = 0; while (cond) { __builtin_amdgcn_s_sleep(1); \
    if ((++_sp & 255u) == 0u) { if (xb_ld(&(bar)[XB_TMO])) break; if (_sp > XB_SPIN_CAP) { atomicAdd(&(bar)[XB_TMO], 1u); break; } } } } while (0)
struct XcdBarrier { unsigned* bar; unsigned x; volatile LAS unsigned* st; };
__device__ __forceinline__ XcdBarrier xcd_barrier_post(unsigned* bar, volatile LAS unsigned* st) {
    XcdBarrier b; b.bar = bar; b.x = xb_xcc_id(); b.st = st;
    if (threadIdx.x == 0) (void)xb_add(&bar[XB_XCNT(b.x)], 1u);
    return b;
}
__device__ __forceinline__ void xcd_barrier_complete(unsigned* bar, unsigned x, unsigned& nloc, unsigned& nx) {
    const unsigned G = gridDim.x * gridDim.y * gridDim.z;
    unsigned sum, cnt, mine, sp = 0u;
    for (;;) {
        sum = 0u; cnt = 0u; mine = 0u;
#pragma unroll
        for (unsigned j = 0; j < 16; ++j) { const unsigned c = xb_ld(&bar[XB_XCNT(j)]); sum += c; cnt += (c > 0u) ? 1u : 0u; mine = (j == x) ? c : mine; }
        if (sum == G) break;
        __builtin_amdgcn_s_sleep(1);
        if ((++sp & 255u) == 0u) { if (xb_ld(&bar[XB_TMO])) break; if (sp > XB_SPIN_CAP) { atomicAdd(&bar[XB_TMO], 1u); break; } }
    }
    nloc = mine > 0u ? mine : 1u; nx = cnt > 0u ? cnt : 1u;
}
__device__ __forceinline__ void xcd_barrier(const XcdBarrier& b, const int wv) {
    asm volatile("s_waitcnt vmcnt(0)" ::: "memory");
    __syncthreads();
    if (tid_of(wv) == 0) {
        unsigned* bar = b.bar;
        __builtin_amdgcn_s_waitcnt(0);
        unsigned nloc = b.st[0], nx = b.st[1];
        if (nloc == 0u) { xcd_barrier_complete(bar, b.x, nloc, nx); b.st[0] = nloc; b.st[1] = nx; }
        const unsigned old = xb_add(&bar[XB_XSUB(b.x)], 1u);
        const unsigned gen = old / nloc;
        if (old + 1u == (gen + 1u) * nloc) {
            __builtin_amdgcn_fence(__ATOMIC_RELEASE, "agent");
            asm volatile("s_waitcnt vmcnt(0)" ::: "memory");
            const unsigned og = xb_add(&bar[XB_TOP], 1u);
            const unsigned tg = og / nx;
            if (og + 1u == (tg + 1u) * nx) xb_add(&bar[XB_TOPGEN], 1u);
            else XB_SPIN(xb_ld(&bar[XB_TOPGEN]) == tg, bar);
            __builtin_amdgcn_fence(__ATOMIC_ACQUIRE, "agent");
            xb_add(&bar[XB_XGEN(b.x)], 1u);
            asm volatile("s_waitcnt vmcnt(0)" ::: "memory");
        } else {
            XB_SPIN(xb_ld(&bar[XB_XGEN(b.x)]) == gen, bar);
            __builtin_amdgcn_fence(__ATOMIC_ACQUIRE, "agent");
            asm volatile("s_waitcnt vmcnt(0)" ::: "memory");
        }
    }
    __syncthreads();
}

struct Args { const float* in[23]; float* out; unsigned char* ws; int ph_lo, ph_hi; };

template <class Epi, int MODE = 0>
__device__ __forceinline__ void run_gemm(LAS unsigned char* lds, const void* A, int lda, const void* Bt, int ldb, int M, int N, int K, const Epi E, const int wv) {
    pg8::Gemm g{A, Bt, M, N, K, lda, ldb}; pg8::StaticOrder S; S.init(M, N, (int)gridDim.x, (int)blockIdx.x);
    pg8::gemm_phase<Epi, pg8::StaticOrder, true, true, MODE>(lds, g, S, E, wv);
}

__global__ void __launch_bounds__(512) mk_fwd(Args args) {
    extern __shared__ __attribute__((aligned(16))) unsigned char lds_raw[];
    LAS unsigned char* lds = (LAS unsigned char*)lds_raw;
    const int G = gridDim.x;
    const int wv = __builtin_amdgcn_readfirstlane(threadIdx.x >> 6);
    volatile LAS unsigned* bar_st = (volatile LAS unsigned*)(lds + (LDS_BYTES - 64));
    if (threadIdx.x < 2) bar_st[threadIdx.x] = 0u;
    __syncthreads();
    unsigned* barw = (unsigned*)(args.ws);
    XcdBarrier xbar; xbar.bar = barw; xbar.x = 0; xbar.st = bar_st;
#define LANE_INIT const int tid = tid_of(wv), lane = tid & 63, wave = wv, gw = blockIdx.x * 8 + wave, NGW = G * 8; (void)tid; (void)lane; (void)gw; (void)NGW;
#define PH_WS unsigned char* ws = args.ws; float* X = args.out; (void)X; (void)ws;
#define x_p (args.in[0])
#define x_s (args.in[1])
#define g_ffn1 (args.in[2])
#define w1_gate (args.in[3])
#define w1_up (args.in[4])
#define w1_down (args.in[5])
#define g_mix (args.in[6])
#define w_in (args.in[7])
#define g_q (args.in[8])
#define w_q_b (args.in[9])
#define g_kv (args.in[10])
#define w_kv_b (args.in[11])
#define g_v (args.in[12])
#define w_s (args.in[13])
#define b_s (args.in[14])
#define g_out_attn (args.in[15])
#define g_out_gmlp (args.in[16])
#define w_out (args.in[17])
#define g_ffn2 (args.in[18])
#define w2_gate (args.in[19])
#define w2_up (args.in[20])
#define w2_down (args.in[21])
#define g_final (args.in[22])
#define rope ((float*)(ws + WS_ROPE))
#define W1U ((bf16*)(ws + WS_W1U))
#define W1D ((bf16*)(ws + WS_W1D))
#define W2U ((bf16*)(ws + WS_W2U))
#define W2D ((bf16*)(ws + WS_W2D))
#define WIN ((bf16*)(ws + WS_WIN))
#define WQ ((bf16*)(ws + WS_WQ))
#define WKV ((bf16*)(ws + WS_WKV))
#define WOUT ((bf16*)(ws + WS_WOUT))
#define WSP ((bf16*)(ws + WS_WSP))
#define H ((bf16*)(ws + WS_H))
#define ACT ((bf16*)(ws + WS_ACT))
#define Z ((bf16*)(ws + WS_Z))
#define Q ((bf16*)(ws + WS_Q))
#define KV ((bf16*)(ws + WS_KV))
#define H2 ((bf16*)(ws + WS_H2))
#define X1B ((bf16*)X)
#define X2B ((bf16*)X + (size_t)T * DM)
#define CM ((float*)(ws + WS_CM))
#define RS1 ((float*)(ws + WS_RS))
#define RS2 ((float*)(ws + WS_RS) + T)
#define SS ((pg8::u64*)(ws + WS_SS))
#define SS1 (SS)
#define SS3 (SS + T)
#define SSQ (SS + 2 * T)
#define SSKV (SS + 3 * T)
#define IN(k) true
#define SEAM(k) do { if ((k) == 0) { cg::this_grid().sync(); xbar = xcd_barrier_post(barw, bar_st); } else xcd_barrier(xbar, wv); } while (0)

    if (IN(0)) {
        PH_WS LANE_INIT
        LAS float* scr = (LAS float*)(lds + wave * 16640);
        constexpr int I_UP = (DM / 64) * (DFF / 64), I_DN = (DFF / 64) * (DM / 64), I_IN = (DM / 64) * (3136 / 64), I_Q = (512 / 64) * (QW / 64), I_KV = (512 / 64) * (KVW / 64), I_OUT = (DM / 64) * (DM / 64);
        constexpr int I_CM = 4 * (DFF / 64), I_CMD = 4 * (DM / 64); constexpr int NITEMS = 4 * I_CM + I_CMD + 2 * I_DN + I_IN + I_Q + I_KV + I_OUT;
        for (int it = gw; it < NITEMS; it += NGW) {
            int r = it;
            if (r < 4 * I_CM) {
                const int mat = r / I_CM, it2 = r % I_CM;
                p0_colmax_item(mat == 0 ? w1_gate : mat == 1 ? w1_up : mat == 2 ? w2_gate : w2_up, DM, DFF, CM + mat * DFF, it2, lane, mat >= 2 ? g_ffn2 : nullptr); continue; } r -= 4 * I_CM;
            if (r < I_CMD) { p0_colmax_item(w2_down, DFF, DM, CM + 4 * DFF, r, lane, nullptr); continue; } r -= I_CMD;
            if (r < I_DN) { p0_transpose_item(w1_down, DFF, DM, W1D, 0, scr, r, lane); continue; } r -= I_DN;
            if (r < I_DN) { if (!FP8_DOWN2) p0_transpose_item(w2_down, DFF, DM, W2D, 0, scr, r, lane); continue; } r -= I_DN;
            if (r < I_IN) { p0_transpose_item(w_in, DM, 3136, WIN, 3, scr, r, lane, g_mix); continue; } r -= I_IN;
            if (r < I_Q) { p0_transpose_item(w_q_b, 512, QW, WQ, 4, scr, r, lane, g_q); continue; } r -= I_Q;
            if (r < I_KV) { p0_transpose_item(w_kv_b, 512, KVW, WKV, 0, scr, r, lane, g_kv); continue; } r -= I_KV;
            p0_transpose_item(w_out, DM, DM, WOUT, 0, scr, r, lane);
        }
        const int gt = blockIdx.x * 512 + tid, NGT = G * 512;
        if (blockIdx.x == 0) for (int i = tid; i < XCD_BAR_WORDS; i += 512) barw[i] = 0u;
        for (int i = gt; i < 192 * DM / 8; i += NGT) ((u32x4*)(WIN + (size_t)1088 * DM))[i] = (u32x4){0u, 0u, 0u, 0u};
        for (int i = gt; i < 4 * T / 2; i += NGT) ((u32x4*)SS)[i] = (u32x4){0u, 0u, 0u, 0u};
        for (int i = gt; i < 8 * 128 * 128 / 2; i += NGT) ((unsigned*)WSP)[i] = pk2(w_s[2 * i], w_s[2 * i + 1]);
        for (int i = gt; i < 8192 * 32; i += NGT) { const int pos = i >> 5, k = i & 31; const double a = (double)pos * c_inv_rev[k]; const float fr = (float)(a - floor(a));
            rope[(size_t)pos * 64 + k] = __builtin_amdgcn_cosf(fr); rope[(size_t)pos * 64 + 32 + k] = __builtin_amdgcn_sinf(fr); }
        for (int m = gw; m < T; m += NGW) { const float* xr = (m < TP ? x_p + (size_t)m * DM : x_s + (size_t)(m - TP) * DM);
            rms_row_to_i8(xr, g_ffn1, (unsigned char*)H + (size_t)m * DM, RS1 + m, lane); }
    }
    SEAM(0);
    {
        PH_WS LANE_INIT
        LAS float* scr = (LAS float*)(lds + wave * 16640);
        constexpr int I_UP = (DM / 64) * (DFF / 64), I_DN8 = FP8_DOWN2 ? (DFF / 64) * (DM / 64) : 0;
        for (int it = gw; it < I_DN8; it += NGW) p0_transpose_item8(w2_down, DFF, DM, (unsigned char*)W2D, 0, scr, it, lane, nullptr, 1.f, CM + 4 * DFF);
        for (int it = gw; it < 4 * I_UP; it += NGW) { const int mat = it / I_UP, r = it % I_UP;
            p0_transpose_item_i8(mat == 0 ? w1_gate : mat == 1 ? w1_up : mat == 2 ? w2_gate : w2_up, DM, DFF, (unsigned char*)(mat < 2 ? W1U : W2U), 1 + (mat & 1), scr, r, lane, mat >= 2 ? g_ffn2 : nullptr, CM + mat * DFF); }
    }
    SEAM(20);
    if (IN(1)) { PH_WS pg8::EpiSwiGLU<false> E{ACT, DFF, RS1, CM, CM + DFF, 1.f / 127.f}; run_gemm<pg8::EpiSwiGLU<false>, 2>(lds, H, DM, W1U, DM, T, 2 * DFF, DM, E, wv); }
    SEAM(1);
    if (IN(2)) { PH_WS
        { pg8::EpiResid<true, false, 1, true, false, false, false> E{x_p, nullptr, DM, X1B, SS1, nullptr, nullptr, 1.f}; run_gemm(lds, ACT, DFF, W1D, DFF, TP, DM, DFF, E, wv); }
        { pg8::EpiResid<true, false, 1, true, false, false, false> E{x_s, nullptr, DM, X1B + (size_t)TP * DM, SS1 + TP, nullptr, nullptr, 1.f}; run_gemm(lds, ACT + (size_t)TP * DFF, DFF, W1D, DFF, TS, DM, DFF, E, wv); }
    }
    SEAM(2);
    if (IN(3)) { PH_WS pg8::EpiZ E{Z, ZW, SS1, SSQ, SSKV, rope}; run_gemm(lds, X1B, DM, WIN, DM, T, ZW, DM, E, wv); }
    SEAM(3);
    if (IN(4)) { PH_WS
        { pg8::EpiQRope E{Q, QW, rope, SSQ}; run_gemm(lds, Z, ZW, WQ, 512, T, QW, 512, E, wv); }
        { pg8::EpiBf16 E{KV, KVW, SSKV, 1.f / 512.f}; run_gemm(lds, Z + 512, ZW, WKV, 512, T, KVW, 512, E, wv); }
    }
    SEAM(4);
    if (IN(5)) { PH_WS
        const int c = blockIdx.x;
        for (int u = c; u < (T / 128) * 8; u += G) gmlp_unit(Z, WSP, b_s, g_v, H, u >> 3, u & 7, (char*)lds_raw, wv);
        for (int u = c; u < 256 + 1024; u += G) {
            int head, row0, krow0, seq;
            if (u < 256) { head = u & 7; row0 = (u >> 3) * 256; krow0 = 0; seq = TP; }
            else { const int v = u - 256; head = v & 7; const int idx = v >> 3; const int sq = idx >> 3, qb = idx & 7; krow0 = TP + sq * 2048; row0 = krow0 + qb * 256; seq = 2048; }
            __syncthreads();
            att::attn_dense_body(Q + (size_t)row0 * QW + head * 192, KV + (size_t)krow0 * KVW + head * 256, Z + (size_t)krow0 * ZW + Z_KR, KV + (size_t)krow0 * KVW + head * 256 + 128,
                                 H + (size_t)row0 * DM + head * 128, seq, (char*)lds_raw, wv);
        }
    }
    SEAM(5);
    if (IN(6)) { PH_WS LANE_INIT for (int m = gw; m < T; m += NGW) onorm_row(H + (size_t)m * DM, g_out_attn, g_out_gmlp, lane); }
    SEAM(6);
    if (IN(7)) { PH_WS pg8::EpiResid<true, false, 2, false, false, true, false> E{X1B, nullptr, DM, X2B, nullptr, nullptr, nullptr, 1.f}; run_gemm(lds, H, DM, WOUT, DM, T, DM, DM, E, wv); }
    SEAM(7);
    { PH_WS LANE_INIT for (int m = gw; m < T; m += NGW) bf16_row_to_i8(X2B + (size_t)m * DM, (unsigned char*)H + (size_t)m * DM, RS2 + m, lane); }
    SEAM(7);
    if (IN(8)) { PH_WS pg8::EpiSwiGLU<FP8_DOWN2 != 0> E{ACT, DFF, RS2, CM + 2 * DFF, CM + 3 * DFF, 1.f / 127.f}; run_gemm<pg8::EpiSwiGLU<FP8_DOWN2 != 0>, 2>(lds, H, DM, W2U, DM, T, 2 * DFF, DM, E, wv); }
    SEAM(8);
    if (IN(9)) { PH_WS pg8::EpiResid<true, false, 1, true, FP8_DOWN2 != 0, true, false> E{X2B, nullptr, DM, H2, SS3, nullptr, CM + 4 * DFF, 1.f / (W8MAX * ACT8SCALE)}; run_gemm<pg8::EpiResid<true, false, 1, true, FP8_DOWN2 != 0, true, false>, FP8_DOWN2 ? 1 : 0>(lds, ACT, DFF, W2D, DFF, T, DM, DFF, E, wv); }
    SEAM(9);
    if (IN(10)) {
        PH_WS LANE_INIT
        for (int m = gw; m < T; m += NGW) { const u32x4* hr = (const u32x4*)(H2 + (size_t)m * DM) + lane; f32x4* xr = (f32x4*)(X + (size_t)m * DM); const float rs = __builtin_amdgcn_rsqf(pg8::ss_get(SS3 + m) * (1.f / DM) + EPS);
            u32x4 w[4];
#pragma unroll
            for (int j = 0; j < 4; ++j) w[j] = hr[64 * j];
#pragma unroll
            for (int j = 0; j < 4; ++j) { float f[8]; unpack8(w[j], f); const int c8 = (lane + 64 * j) * 2; const f32x4 g0 = ((const f32x4*)g_final)[c8], g1 = ((const f32x4*)g_final)[c8 + 1];
                xr[c8] = (f32x4){f[0] * rs * g0.x, f[1] * rs * g0.y, f[2] * rs * g0.z, f[3] * rs * g0.w}; xr[c8 + 1] = (f32x4){f[4] * rs * g1.x, f[5] * rs * g1.y, f[6] * rs * g1.z, f[7] * rs * g1.w}; } }
    }
#undef IN
#undef SEAM
}

extern "C" void kernel_launch(void* const* d_in, const int* in_sizes, int n_in, void* d_out, int out_size, void* d_ws, size_t ws_size, hipStream_t stream) {
    static int grid = 0;
    if (grid == 0) {
        if (n_in != 23 || out_size != T * DM || ws_size < WS_END) { fprintf(stderr, "kernel_launch: unexpected shapes: n_in %d out %d ws %zu\n", n_in, out_size, ws_size); grid = -1; return; }
        int dev = 0, cus = 0, per_cu = 0;
        if (hipGetDevice(&dev) != hipSuccess || hipDeviceGetAttribute(&cus, hipDeviceAttributeMultiprocessorCount, dev) != hipSuccess) { grid = -1; return; }
        if (hipFuncSetAttribute((const void*)mk_fwd, hipFuncAttributeMaxDynamicSharedMemorySize, LDS_BYTES) != hipSuccess) { fprintf(stderr, "kernel_launch: hipFuncSetAttribute failed\n"); grid = -1; return; }
        if (hipOccupancyMaxActiveBlocksPerMultiprocessor(&per_cu, (const void*)mk_fwd, 512, LDS_BYTES) != hipSuccess || per_cu < 1) { fprintf(stderr, "kernel_launch: occupancy query says %d\n", per_cu); per_cu = 1; }
        (void)hipGetLastError();
        grid = cus * per_cu;
    }
    if (grid < 0) return;
    if (hipMemsetAsync((char*)d_ws + WS_CM, 0, CM_BYTES, stream) != hipSuccess) { fprintf(stderr, "kernel_launch: hipMemsetAsync failed\n"); return; }
    Args a{};
    for (int i = 0; i < 23; ++i) a.in[i] = (const float*)d_in[i];
    a.out = (float*)d_out; a.ws = (unsigned char*)d_ws;
    a.ph_lo = 0; a.ph_hi = NPHASE;
    void* kargs[] = {&a};
    hipError_t e = hipLaunchCooperativeKernel((const void*)mk_fwd, dim3(grid), dim3(512), kargs, LDS_BYTES, stream);
    if (e != hipSuccess) fprintf(stderr, "cooperative launch failed: %s (grid %d)\n", hipGetErrorString(e), grid);
}
```

```cpp
#include <hip/hip_runtime.h>
#include <hip/hip_cooperative_groups.h>
#include <cstdio>
#include <cstdint>
namespace cg = cooperative_groups;

#ifndef FP8_FFN1
#define FP8_FFN1 0
#endif
#ifndef FP8_FFN2
#define FP8_FFN2 1
#endif
constexpr float W8SCALE = 32.f;
#ifndef FP8_DOWN2
#define FP8_DOWN2 1
#endif
constexpr float ACT8SCALE = 8.f, W8MAX = 256.f;
#ifndef MK_ONE_LAUNCH
#define MK_ONE_LAUNCH 1
#endif

__device__ __forceinline__ int tid_of(int wv) { int l; asm volatile("v_mbcnt_lo_u32_b32 %0, -1, 0\n\tv_mbcnt_hi_u32_b32 %0, -1, %0" : "=v"(l)); return wv * 64 + l; }
template <int MASK> __device__ __forceinline__ float xor_get(float v) { return __int_as_float(__builtin_amdgcn_ds_swizzle(__float_as_int(v), 0x1F | (MASK << 10))); }
__device__ __forceinline__ float xor32_sum(float v) { auto rr = __builtin_amdgcn_permlane32_swap(__float_as_uint(v), __float_as_uint(v), false, false); return __uint_as_float(rr[0]) + __uint_as_float(rr[1]); }
namespace pg8 {
#define PG8_LAS __attribute__((address_space(3)))
typedef unsigned short bf16_t;
typedef short bf16x8 __attribute__((ext_vector_type(8)));
typedef float f32x4 __attribute__((ext_vector_type(4)));
typedef unsigned u32x4 __attribute__((ext_vector_type(4)));
constexpr int BM = 256, BK = 64, HALF = 128, HTB = HALF * BK * 2, STAGE_BYTES = 8 * HTB, NXCD = 8, WGM = 4;

__host__ __device__ __forceinline__ int lds_byte(int r, int c) { const int st = (r >> 4) * 2 + (c >> 5), rr = r & 15, cc = c & 31, ob = rr * 64 + cc * 2; return st * 1024 + (ob ^ (((ob >> 9) & 1) << 5)); }
__host__ __device__ __forceinline__ void stage_rc(int b, int& R, int& C) { const int st = b / 1024, sb = b % 1024, swz = sb ^ (((sb >> 9) & 1) << 5); R = (st >> 1) * 16 + swz / 64; C = (st & 1) * 32 + (swz % 64) / 2; }
__host__ __device__ __forceinline__ int perm32(int rho) { const int n = rho >> 4, i = rho & 15; return 8 * (i >> 2) + 4 * n + (i & 3); }

typedef unsigned long long u64;
constexpr float SSFIX = 1048576.f;
__device__ __forceinline__ float ss_get(const u64* p) { return (float)(*p) * (1.f / SSFIX); }
__device__ __forceinline__ void ss_add(u64* p, float v) { atomicAdd(p, (u64)(v * SSFIX)); }
struct Unit { int pm, pn; };
struct Gemm { const void* A; const void* Bt; int M, N, K, lda, ldb; };
typedef int i32x4 __attribute__((ext_vector_type(4)));
typedef int i32x8 __attribute__((ext_vector_type(8)));
__device__ __forceinline__ i32x8 cat8(bf16x8 lo, bf16x8 hi) { return __builtin_shufflevector(__builtin_bit_cast(i32x4, lo), __builtin_bit_cast(i32x4, hi), 0, 1, 2, 3, 4, 5, 6, 7); }

struct StaticOrder {
    int nM, nN, nwg, G, c, base, stride, cnt;
    __host__ __device__ void init(int M, int N, int G_, int c_) { nM = M / BM; nN = N / BM; nwg = nM * nN; G = G_; c = c_; base = c_; stride = G_; cnt = 0x7fffffff; }
    __host__ __device__ bool next(int i, Unit& u) const {
        if (i >= cnt) return false;
        const long L = (long)i * stride + base; if (L >= nwg) return false;
        int wgid = (int)L; { const int q = nwg / NXCD, r = nwg % NXCD, xcd = wgid % NXCD, off = wgid / NXCD; wgid = (xcd < r ? xcd * (q + 1) : r * (q + 1) + (xcd - r) * q) + off; }
        const int nig = WGM * nN, gid = wgid / nig, fm = gid * WGM, gsz = (nM - fm) < WGM ? (nM - fm) : WGM;
        u.pm = fm + ((wgid % nig) % gsz); u.pn = (wgid % nig) / gsz; return true;
    }
    __device__ __forceinline__ void a_ready(const Unit&) const {}
    __device__ __forceinline__ void done(const Unit&) const {}
};

__device__ __forceinline__ unsigned cvt_pk_bf16(float lo, float hi) { unsigned r; asm volatile("v_cvt_pk_bf16_f32 %0, %1, %2" : "=v"(r) : "v"(lo), "v"(hi)); return r; }

struct EpiBf16 {
    static constexpr bool PERM = true, AFTER_DRAIN = false;
    bf16_t* O; int ldc; const u64* ss; float inv_n;
    __device__ __forceinline__ void operator()(const f32x4 (&acc)[2][2][4][2], const Unit& u, int wr, int wc, int fr, int fq) const {
        const int row0 = u.pm * BM + wr * 64 + fr; const int col0 = u.pn * BM + wc * 32 + 8 * fq;
#pragma unroll
        for (int ai = 0; ai < 2; ++ai)
#pragma unroll
            for (int m = 0; m < 4; ++m) { const int row = row0 + ai * HALF + m * 16; bf16_t* rowp = O + (size_t)row * ldc + col0;
                const float rs = ss ? __builtin_amdgcn_rsqf(ss_get(ss + row) * inv_n + 1e-6f) : 1.f;
#pragma unroll
                for (int bj = 0; bj < 2; ++bj) { const f32x4 v0 = acc[ai][bj][m][0] * rs, v1 = acc[ai][bj][m][1] * rs;
                    u32x4 w; w.x = cvt_pk_bf16(v0[0], v0[1]); w.y = cvt_pk_bf16(v0[2], v0[3]); w.z = cvt_pk_bf16(v1[0], v1[1]); w.w = cvt_pk_bf16(v1[2], v1[3]);
                    *(u32x4*)(rowp + bj * HALF) = w; } }
    }
};
__device__ __forceinline__ float gelu_t(float x) { const float t = -2.302208198f * (x + 0.044715f * x * x * x); return x * __builtin_amdgcn_rcpf(1.0f + __builtin_amdgcn_exp2f(t)); }
__device__ __forceinline__ void rope8(f32x4& v0, f32x4& v1, const float* rp, int i0) {
    const f32x4 cs = *(const f32x4*)(rp + i0), sn = *(const f32x4*)(rp + 32 + i0);
    f32x4 a, b; a[0] = v0[0] * cs[0] - v0[1] * sn[0]; a[1] = v0[0] * sn[0] + v0[1] * cs[0]; a[2] = v0[2] * cs[1] - v0[3] * sn[1]; a[3] = v0[2] * sn[1] + v0[3] * cs[1];
    b[0] = v1[0] * cs[2] - v1[1] * sn[2]; b[1] = v1[0] * sn[2] + v1[1] * cs[2]; b[2] = v1[2] * cs[3] - v1[3] * sn[3]; b[3] = v1[2] * sn[3] + v1[3] * cs[3]; v0 = a; v1 = b;
}
struct EpiZ {
    static constexpr bool PERM = true, AFTER_DRAIN = false;
    bf16_t* O; int ldc; const u64* ssx; u64* ssq; u64* sskv; const float* rope;
    __device__ __forceinline__ void operator()(const f32x4 (&acc)[2][2][4][2], const Unit& u, int wr, int wc, int fr, int fq) const {
        const int row0 = u.pm * BM + wr * 64 + fr; const int col0 = u.pn * BM + wc * 32 + 8 * fq; const int pn = u.pn;
#pragma unroll
        for (int ai = 0; ai < 2; ++ai)
#pragma unroll
            for (int m = 0; m < 4; ++m) { const int row = row0 + ai * HALF + m * 16; bf16_t* rowp = O + (size_t)row * ldc + col0;
                const float rs = __builtin_amdgcn_rsqf(ss_get(ssx + row) * (1.f / 2048.f) + 1e-6f); float sq = 0.f;
#pragma unroll
                for (int bj = 0; bj < 2; ++bj) { f32x4 v0 = acc[ai][bj][m][0] * rs, v1 = acc[ai][bj][m][1] * rs;
                    if (pn < 4) { sq += (v0[0] * v0[0] + v0[1] * v0[1]) + (v0[2] * v0[2] + v0[3] * v0[3]) + (v1[0] * v1[0] + v1[1] * v1[1]) + (v1[2] * v1[2] + v1[3] * v1[3]); }
                    else if (pn == 4) { if (bj == 0 && wc < 2) { const int pos = row < 8192 ? row : (row & 2047); rope8(v0, v1, rope + (size_t)pos * 64, (wc * 32 + 8 * fq) >> 1); } }
                    else {
#pragma unroll
                        for (int e = 0; e < 4; ++e) { v0[e] = gelu_t(v0[e]); v1[e] = gelu_t(v1[e]); } }
                    u32x4 w; w.x = cvt_pk_bf16(v0[0], v0[1]); w.y = cvt_pk_bf16(v0[2], v0[3]); w.z = cvt_pk_bf16(v1[0], v1[1]); w.w = cvt_pk_bf16(v1[2], v1[3]);
                    *(u32x4*)(rowp + bj * HALF) = w; }
                if (pn < 4) { sq += xor_get<16>(sq); sq = xor32_sum(sq); if (fq == 0) ss_add((pn < 2 ? ssq : sskv) + row, sq); } }
    }
};
struct EpiQRope {
    static constexpr bool PERM = true, AFTER_DRAIN = false;
    bf16_t* O; int ldc; const float* rope; const u64* ss;
    __device__ __forceinline__ void operator()(const f32x4 (&acc)[2][2][4][2], const Unit& u, int wr, int wc, int fr, int fq) const {
        const int row0 = u.pm * BM + wr * 64 + fr; const int col0 = u.pn * BM + wc * 32 + 8 * fq;
#pragma unroll
        for (int ai = 0; ai < 2; ++ai)
#pragma unroll
            for (int m = 0; m < 4; ++m) { const int row = row0 + ai * HALF + m * 16; bf16_t* rowp = O + (size_t)row * ldc + col0;
                const int pos = row < 8192 ? row : (row & 2047); const float rs = __builtin_amdgcn_rsqf(ss_get(ss + row) * (1.f / 512.f) + 1e-6f);
#pragma unroll
                for (int bj = 0; bj < 2; ++bj) { f32x4 v0 = acc[ai][bj][m][0] * rs, v1 = acc[ai][bj][m][1] * rs;
                    const int c = col0 + bj * HALF; const int d = c % 192;
                    if (d >= 128) rope8(v0, v1, rope + (size_t)pos * 64, (d - 128) >> 1);
                    u32x4 w; w.x = cvt_pk_bf16(v0[0], v0[1]); w.y = cvt_pk_bf16(v0[2], v0[3]); w.z = cvt_pk_bf16(v1[0], v1[1]); w.w = cvt_pk_bf16(v1[2], v1[3]);
                    *(u32x4*)(rowp + bj * HALF) = w; } }
    }
};
template <bool OUT8 = false> struct EpiSwiGLU {
    static constexpr bool PERM = true, AFTER_DRAIN = false;
    bf16_t* O; int ldc; const float* rsc; const float* cmg; const float* cmu; float cscale;
    __device__ __forceinline__ void operator()(const f32x4 (&acc)[2][2][4][2], const Unit& u, int wr, int wc, int fr, int fq) const {
        const int row0 = u.pm * BM + wr * 64 + fr; const int col0 = u.pn * HALF + wc * 32 + 8 * fq;
        f32x4 sg[2], su[2];
#pragma unroll
        for (int n = 0; n < 2; ++n) { sg[n] = cmg ? *(const f32x4*)(cmg + col0 + 4 * n) * cscale : (f32x4){1.f, 1.f, 1.f, 1.f}; su[n] = cmu ? *(const f32x4*)(cmu + col0 + 4 * n) * cscale : (f32x4){1.f, 1.f, 1.f, 1.f}; }
#pragma unroll
        for (int ai = 0; ai < 2; ++ai)
#pragma unroll
            for (int m = 0; m < 4; ++m) { const int row = row0 + ai * HALF + m * 16; bf16_t* rowp = O + (size_t)row * ldc + col0;
                const float rs = rsc ? rsc[row] : 1.f;
                f32x4 r[2];
#pragma unroll
                for (int n = 0; n < 2; ++n) { const f32x4 g = acc[ai][0][m][n] * sg[n] * rs, up = acc[ai][1][m][n] * su[n] * rs;
#pragma unroll
                    for (int e = 0; e < 4; ++e) { const float sgm = __builtin_amdgcn_rcpf(1.0f + __builtin_amdgcn_exp2f(-1.4426950408889634f * g[e])); r[n][e] = g[e] * sgm * up[e]; } }
                if constexpr (OUT8) { typedef unsigned u32x2v __attribute__((ext_vector_type(2))); _Pragma("unroll") for (int e = 0; e < 4; ++e) { r[0][e] = __builtin_amdgcn_fmed3f(r[0][e] * ACT8SCALE, -448.f, 448.f); r[1][e] = __builtin_amdgcn_fmed3f(r[1][e] * ACT8SCALE, -448.f, 448.f); }

                    int w0 = __builtin_amdgcn_cvt_pk_fp8_f32(r[0][0], r[0][1], 0, false); w0 = __builtin_amdgcn_cvt_pk_fp8_f32(r[0][2], r[0][3], w0, true);
                    int w1 = __builtin_amdgcn_cvt_pk_fp8_f32(r[1][0], r[1][1], 0, false); w1 = __builtin_amdgcn_cvt_pk_fp8_f32(r[1][2], r[1][3], w1, true);
                    *(u32x2v*)((unsigned char*)O + (size_t)row * ldc + col0) = (u32x2v){(unsigned)w0, (unsigned)w1}; }
                else { u32x4 w; w.x = cvt_pk_bf16(r[0][0], r[0][1]); w.y = cvt_pk_bf16(r[0][2], r[0][3]); w.z = cvt_pk_bf16(r[1][0], r[1][1]); w.w = cvt_pk_bf16(r[1][2], r[1][3]);
                    *(u32x4*)rowp = w; } }
    }
};
template <bool HAS_XB, bool HAS_X8, int ALPHA2, bool HAS_SS = true, bool HAS_CS = false, bool BASE16 = false, bool HAS_OUT = true> struct EpiResid {
    static constexpr bool PERM = false, AFTER_DRAIN = false; static constexpr float alpha = 0.5f * ALPHA2;
    const void* base; float* out; int ldc; bf16_t* xb; u64* ss; unsigned char* x8; const float* cs; float csmul;
    __device__ __forceinline__ void operator()(const f32x4 (&acc)[2][2][4][2], const Unit& u, int wr, int wc, int fr, int fq) const {
        typedef unsigned u32x2v __attribute__((ext_vector_type(2)));
        const int row0 = u.pm * BM + wr * 64 + fr; const int col0 = u.pn * BM + wc * 32 + 4 * fq;
        f32x4 csv[2][2];
#pragma unroll
        for (int bj = 0; bj < 2; ++bj)
#pragma unroll
            for (int n = 0; n < 2; ++n) csv[bj][n] = HAS_CS ? *(const f32x4*)(cs + col0 + bj * HALF + n * 16) * (csmul * alpha) : (f32x4){alpha, alpha, alpha, alpha};
#pragma unroll
        for (int ai = 0; ai < 2; ++ai)
#pragma unroll
            for (int m = 0; m < 4; ++m) { const int row = row0 + ai * HALF + m * 16; const size_t off = (size_t)row * ldc + col0; float sq = 0.f;
#pragma unroll
                for (int bj = 0; bj < 2; ++bj)
#pragma unroll
                    for (int n = 0; n < 2; ++n) { const size_t p = off + bj * HALF + n * 16; f32x4 b;
                        if constexpr (BASE16) { const u32x2v wb = *(const u32x2v*)((const bf16_t*)base + p); b = (f32x4){__uint_as_float(wb.x << 16), __uint_as_float(wb.x & 0xffff0000u), __uint_as_float(wb.y << 16), __uint_as_float(wb.y & 0xffff0000u)}; }
                        else b = *(const f32x4*)((const float*)base + p);
                        const f32x4 v = b + acc[ai][bj][m][n] * csv[bj][n]; if constexpr (HAS_OUT) *(f32x4*)(out + p) = v;
                        if constexpr (HAS_XB) { u32x2v w; w.x = cvt_pk_bf16(v[0], v[1]); w.y = cvt_pk_bf16(v[2], v[3]); *(u32x2v*)(xb + p) = w; }
                        if constexpr (HAS_X8) { int w8 = __builtin_amdgcn_cvt_pk_fp8_f32(v[0], v[1], 0, false); w8 = __builtin_amdgcn_cvt_pk_fp8_f32(v[2], v[3], w8, true); *(int*)(x8 + p) = w8; }
                        sq += (v[0] * v[0] + v[1] * v[1]) + (v[2] * v[2] + v[3] * v[3]); }
                if constexpr (HAS_SS) { sq += xor_get<16>(sq); sq = xor32_sum(sq); if (fq == 0) ss_add(ss + row, sq); } }
    }
};

template <class Epi, class Sched, bool ALIGN_EPI = false, bool SP2 = false, int MODE = 0>
__device__ __forceinline__ void gemm_phase(PG8_LAS unsigned char* lds, const Gemm g, const Sched S, const Epi E, const int wv) {
    const int tid = tid_of(wv), wid = __builtin_amdgcn_readfirstlane(tid >> 6), lane = tid & 63, wr = wid >> 2, wc = wid & 3, fr = lane & 15, fq = lane >> 4;
    constexpr bool FP8 = MODE == 1, BYTE_ELEMS = MODE != 0; constexpr int ES = BYTE_ELEMS ? 1 : 2;
    const int K = g.K, nt = K * ES / 128;
    unsigned voffA[2], voffB[2];
#pragma unroll
    for (int i = 0; i < 2; ++i) { int R, C; stage_rc(tid * 16 + i * 8192, R, C); const int Rb = Epi::PERM ? ((R & ~31) + perm32(R & 31)) : R;
        voffA[i] = (unsigned)(R * g.lda * ES + C * 2); voffB[i] = (unsigned)(Rb * g.ldb * ES + C * 2); }
    const size_t roffA = (size_t)64 * g.lda * ES, roffB = (size_t)64 * g.ldb * ES;
    const size_t kstep = (size_t)(BK * 2);
    const size_t hstepA = (size_t)HALF * g.lda * ES, hstepB = (size_t)HALF * g.ldb * ES;
    const size_t tstepA = 2 * hstepA, tstepB = 2 * hstepB;
    const unsigned ldsw = (unsigned)wid * 1024u;
    const int aoff = lds_byte(wr * 64 + fr, fq * 8), boff = lds_byte(wc * 32 + fr, fq * 8);
#define PG8_SA(b, h) (((b) * 2 + (h)) * HTB)
#define PG8_SB(b, h) ((4 + (b) * 2 + (h)) * HTB)
#define PG8_STAGE(bufoff, gbase, voff) do { _Pragma("unroll") for (int _i = 0; _i < 2; ++_i) \
        __builtin_amdgcn_global_load_lds((const unsigned*)((const char*)(gbase) + (BYTE_ELEMS ? _i * r##voff + (v##voff)[0] : (v##voff)[_i])), (PG8_LAS unsigned*)(lds + (bufoff) + ldsw + _i * 8192), 16, 0, 0); } while (0)
#define PG8_LDA(dst, b, h) do { _Pragma("unroll") for (int m = 0; m < 4; ++m) _Pragma("unroll") for (int k = 0; k < 2; ++k) dst[m][k] = *(const PG8_LAS bf16x8*)(lds + PG8_SA(b, h) + aoff + m * 2048 + k * 1024); } while (0)
#define PG8_LDB(dst, b, h) do { _Pragma("unroll") for (int n = 0; n < 2; ++n) _Pragma("unroll") for (int k = 0; k < 2; ++k) dst[n][k] = *(const PG8_LAS bf16x8*)(lds + PG8_SB(b, h) + boff + n * 2048 + k * 1024); } while (0)
#define PG8_MMA(ai, bj, At, Bt) do { __builtin_amdgcn_s_setprio(1); if constexpr (FP8) { _Pragma("unroll") for (int m = 0; m < 4; ++m) _Pragma("unroll") for (int n = 0; n < 2; ++n) \
        acc[ai][bj][m][n] = __builtin_amdgcn_mfma_scale_f32_16x16x128_f8f6f4(cat8(Bt[n][0], Bt[n][1]), cat8(At[m][0], At[m][1]), acc[ai][bj][m][n], 0, 0, 0, 0, 0, 0); } \
      else if constexpr (MODE == 2) { _Pragma("unroll") for (int m = 0; m < 4; ++m) _Pragma("unroll") for (int n = 0; n < 2; ++n) _Pragma("unroll") for (int k = 0; k < 2; ++k) \
        acc[ai][bj][m][n] = __builtin_bit_cast(f32x4, __builtin_amdgcn_mfma_i32_16x16x64_i8(__builtin_bit_cast(i32x4, Bt[n][k]), __builtin_bit_cast(i32x4, At[m][k]), __builtin_bit_cast(i32x4, acc[ai][bj][m][n]), 0, 0, 0)); } \
      else { _Pragma("unroll") for (int m = 0; m < 4; ++m) _Pragma("unroll") for (int n = 0; n < 2; ++n) _Pragma("unroll") for (int k = 0; k < 2; ++k) \
        acc[ai][bj][m][n] = __builtin_amdgcn_mfma_f32_16x16x32_bf16(Bt[n][k], At[m][k], acc[ai][bj][m][n], 0, 0, 0); } __builtin_amdgcn_s_setprio(0); } while (0)
#define PG8_WAIT_V(n) asm volatile("s_waitcnt vmcnt(" #n ")" ::: "memory")
#define PG8_WAIT_L(n) asm volatile("s_waitcnt lgkmcnt(" #n ")" ::: "memory")
#define PG8_BAR __builtin_amdgcn_s_barrier()
#define PG8_SCHED __builtin_amdgcn_sched_barrier(0)
    Unit cur, nxt; int ui = 0;
    if (!S.next(0, cur)) return;
    f32x4 acc[2][2][4][2];
#pragma unroll
    for (int a = 0; a < 2; ++a)
#pragma unroll
        for (int b = 0; b < 2; ++b)
#pragma unroll
            for (int m = 0; m < 4; ++m)
#pragma unroll
                for (int n = 0; n < 2; ++n) acc[a][b][m][n] = (f32x4){0.f, 0.f, 0.f, 0.f};
    bf16x8 At[4][2], B0[2][2], B1[2][2];
    const char* cA = (const char*)g.A + (size_t)cur.pm * tstepA; const char* cB = (const char*)g.Bt + (size_t)cur.pn * tstepB;
    S.a_ready(cur);
    if constexpr (SP2) {
        PG8_STAGE(PG8_SB(0, 0), cB, offB); PG8_STAGE(PG8_SB(0, 1), cB + hstepB, offB); PG8_STAGE(PG8_SA(0, 0), cA, offA); PG8_STAGE(PG8_SA(0, 1), cA + hstepA, offA);
        if (wr == 1) PG8_BAR;
        PG8_WAIT_V(2); PG8_BAR;
        PG8_STAGE(PG8_SB(1, 0), cB + kstep, offB); PG8_STAGE(PG8_SA(1, 0), cA + kstep, offA); PG8_STAGE(PG8_SB(1, 1), cB + hstepB + kstep, offB);
        PG8_WAIT_V(6); PG8_BAR;
    } else {
        PG8_STAGE(PG8_SB(0, 0), cB, offB); PG8_STAGE(PG8_SA(0, 0), cA, offA); PG8_STAGE(PG8_SB(0, 1), cB + hstepB, offB); PG8_STAGE(PG8_SA(0, 1), cA + hstepA, offA);
        if (wr == 1) PG8_BAR;
        PG8_WAIT_V(4); PG8_BAR;
        PG8_STAGE(PG8_SB(1, 0), cB + kstep, offB); PG8_STAGE(PG8_SA(1, 0), cA + kstep, offA); PG8_STAGE(PG8_SB(1, 1), cB + hstepB + kstep, offB);
        PG8_WAIT_V(6); PG8_BAR;
    }
    for (;;) {
        const bool has_next = S.next(ui + 1, nxt);
        const char* nA = has_next ? (const char*)g.A + (size_t)nxt.pm * tstepA : cA; const char* nB = has_next ? (const char*)g.Bt + (size_t)nxt.pn * tstepB : cB;
        for (int t = 0; t < nt; t += 2) {
            const bool last = (t == nt - 2);
            const char* a1 = cA + (size_t)(t + 1) * kstep;
            const char* a2 = last ? nA : cA + (size_t)(t + 2) * kstep; const char* b2 = last ? nB : cB + (size_t)(t + 2) * kstep;
            const char* a3 = a2 + kstep; const char* b3 = b2 + kstep;
            if (last && has_next) S.a_ready(nxt);
            if constexpr (SP2) {
            PG8_LDB(B0, 0, 0); PG8_LDB(B1, 0, 1); PG8_SCHED; PG8_LDA(At, 0, 0); PG8_STAGE(PG8_SA(1, 1), a1 + hstepA, offA);
            PG8_WAIT_V(8); PG8_WAIT_L(0); PG8_BAR; PG8_MMA(0, 0, At, B0); PG8_MMA(0, 1, At, B1); PG8_BAR; PG8_SCHED;
            PG8_LDA(At, 0, 1); PG8_STAGE(PG8_SB(0, 0), b2, offB); PG8_STAGE(PG8_SB(0, 1), b2 + hstepB, offB); PG8_STAGE(PG8_SA(0, 0), a2, offA);
            PG8_WAIT_V(8); PG8_WAIT_L(0); PG8_BAR; PG8_MMA(1, 0, At, B0); PG8_MMA(1, 1, At, B1); PG8_BAR; PG8_SCHED;
            PG8_LDB(B0, 1, 0); PG8_LDB(B1, 1, 1); PG8_SCHED; PG8_LDA(At, 1, 0); PG8_STAGE(PG8_SA(0, 1), a2 + hstepA, offA);
            PG8_WAIT_V(8); PG8_WAIT_L(0); PG8_BAR; PG8_MMA(0, 0, At, B0); PG8_MMA(0, 1, At, B1); PG8_BAR; PG8_SCHED;
            PG8_LDA(At, 1, 1); PG8_STAGE(PG8_SB(1, 0), b3, offB); PG8_STAGE(PG8_SB(1, 1), b3 + hstepB, offB); PG8_STAGE(PG8_SA(1, 0), a3, offA);
            PG8_WAIT_V(8); PG8_WAIT_L(0); PG8_BAR; PG8_MMA(1, 0, At, B0); PG8_MMA(1, 1, At, B1); PG8_BAR; PG8_SCHED;
            } else {
            PG8_LDB(B0, 0, 0); PG8_SCHED; PG8_LDA(At, 0, 0); PG8_STAGE(PG8_SA(1, 1), a1 + hstepA, offA);
            PG8_WAIT_L(8); PG8_BAR; PG8_WAIT_L(0); PG8_MMA(0, 0, At, B0); PG8_BAR; PG8_SCHED;
            PG8_LDB(B1, 0, 1); PG8_STAGE(PG8_SB(0, 0), b2, offB);
            PG8_BAR; PG8_WAIT_L(0); PG8_MMA(0, 1, At, B1); PG8_BAR;
            PG8_LDA(At, 0, 1); PG8_STAGE(PG8_SA(0, 0), a2, offA);
            PG8_BAR; PG8_WAIT_L(0); PG8_MMA(1, 0, At, B0); PG8_BAR; PG8_SCHED;
            PG8_STAGE(PG8_SB(0, 1), b2 + hstepB, offB);
            PG8_WAIT_V(6); PG8_BAR; PG8_MMA(1, 1, At, B1); PG8_BAR;
            PG8_LDB(B0, 1, 0); PG8_SCHED; PG8_LDA(At, 1, 0); PG8_STAGE(PG8_SA(0, 1), a2 + hstepA, offA);
            PG8_WAIT_L(8); PG8_BAR; PG8_WAIT_L(0); PG8_MMA(0, 0, At, B0); PG8_BAR; PG8_SCHED;
            PG8_LDB(B1, 1, 1); PG8_STAGE(PG8_SB(1, 0), b3, offB);
            PG8_BAR; PG8_WAIT_L(0); PG8_MMA(0, 1, At, B1); PG8_BAR;
            PG8_LDA(At, 1, 1); PG8_STAGE(PG8_SA(1, 0), a3, offA);
            PG8_BAR; PG8_WAIT_L(0); PG8_MMA(1, 0, At, B0); PG8_BAR; PG8_SCHED;
            PG8_STAGE(PG8_SB(1, 1), b3 + hstepB, offB);
            PG8_WAIT_V(6); PG8_BAR; PG8_MMA(1, 1, At, B1); PG8_BAR;
            }
        }
        if constexpr (ALIGN_EPI) { if (wr == 0) PG8_BAR; }
        if constexpr (MODE == 2) {
#pragma unroll
            for (int a = 0; a < 2; ++a)
#pragma unroll
                for (int b = 0; b < 2; ++b)
#pragma unroll
                    for (int m = 0; m < 4; ++m)
#pragma unroll
                        for (int n = 0; n < 2; ++n) { const i32x4 iv = __builtin_bit_cast(i32x4, acc[a][b][m][n]); acc[a][b][m][n] = (f32x4){(float)iv[0], (float)iv[1], (float)iv[2], (float)iv[3]}; } }
        if constexpr (!Epi::AFTER_DRAIN) { const int t2 = tid_of(wv), l2 = t2 & 63; E(acc, cur, wid >> 2, wid & 3, l2 & 15, l2 >> 4); S.done(cur); }
        if (!has_next) break;
#pragma unroll
        for (int a = 0; a < 2; ++a)
#pragma unroll
            for (int b = 0; b < 2; ++b)
#pragma unroll
                for (int m = 0; m < 4; ++m)
#pragma unroll
                    for (int n = 0; n < 2; ++n) acc[a][b][m][n] = (f32x4){0.f, 0.f, 0.f, 0.f};
        cur = nxt; cA = nA; cB = nB; ++ui;
        if constexpr (ALIGN_EPI) { if (wr == 1) PG8_BAR; }
    }
    PG8_WAIT_V(0);
    if constexpr (!ALIGN_EPI) { if (wr == 0) PG8_BAR; }
    PG8_BAR;
#undef PG8_SA
#undef PG8_SB
#undef PG8_STAGE
#undef PG8_LDA
#undef PG8_LDB
#undef PG8_MMA
#undef PG8_WAIT_V
#undef PG8_WAIT_L
#undef PG8_BAR
#undef PG8_SCHED
}
}

typedef unsigned short bf16;
typedef float f32x4 __attribute__((ext_vector_type(4)));
typedef unsigned u32x4 __attribute__((ext_vector_type(4)));
typedef unsigned u32x2 __attribute__((ext_vector_type(2)));
typedef short bf16x8 __attribute__((ext_vector_type(8)));
typedef short s16x4 __attribute__((ext_vector_type(4)));
typedef float f32x16 __attribute__((ext_vector_type(16)));
#define LAS __attribute__((address_space(3)))

constexpr int DM = 2048, DFF = 5632, TP = 8192, TS = 16 * 2048, T = TP + TS;
constexpr int ZW = 3328;
constexpr int Z_KR = 1024, Z_U = 1280, Z_V = 2304;
constexpr int QW = 1536, KVW = 2048;
constexpr float EPS = 1e-6f;
constexpr size_t MiB = 1u << 20;
constexpr size_t WS_ROPE = 1 * MiB;
constexpr size_t WS_W1U = 4 * MiB, WS_W1D = WS_W1U + 44 * MiB, WS_W2U = WS_W1D + 22 * MiB, WS_W2D = WS_W2U + 44 * MiB, WS_WIN = WS_W2D + 22 * MiB;
constexpr size_t WS_WQ = WS_WIN + 13 * MiB, WS_WKV = WS_WQ + 2 * MiB, WS_WOUT = WS_WKV + 2 * MiB, WS_WSP = WS_WOUT + 8 * MiB;
constexpr size_t WS_H = 162 * MiB;
constexpr size_t WS_ACT = 322 * MiB;
constexpr size_t WS_Z = 322 * MiB, WS_Q = 582 * MiB, WS_KV = 702 * MiB;
constexpr size_t WS_H2 = 762 * MiB, WS_SS = 922 * MiB, WS_END = 924 * MiB;
constexpr size_t WS_CM = 64 * 1024, CM_BYTES = (4 * 5632 + 2048) * 4;
constexpr size_t WS_RS = 256 * 1024;
static_assert(WS_WSP + 262144 <= WS_H, "weights fit");
constexpr int LDS_BYTES = 147456;
constexpr int NPHASE = 13;

__device__ __forceinline__ float bf_lo(unsigned w) { return __uint_as_float(w << 16); }
__device__ __forceinline__ float bf_hi(unsigned w) { return __uint_as_float(w & 0xffff0000u); }
__device__ __forceinline__ unsigned pk2(float lo, float hi) { return pg8::cvt_pk_bf16(lo, hi); }
__device__ __forceinline__ void unpack8(const u32x4 w, float (&f)[8]) { f[0] = bf_lo(w.x); f[1] = bf_hi(w.x); f[2] = bf_lo(w.y); f[3] = bf_hi(w.y); f[4] = bf_lo(w.z); f[5] = bf_hi(w.z); f[6] = bf_lo(w.w); f[7] = bf_hi(w.w); }
__device__ __forceinline__ u32x4 pack8(const float (&f)[8]) { u32x4 w; w.x = pk2(f[0], f[1]); w.y = pk2(f[2], f[3]); w.z = pk2(f[4], f[5]); w.w = pk2(f[6], f[7]); return w; }
__device__ __forceinline__ float wave_sum(float v) { v += xor_get<1>(v); v += xor_get<2>(v); v += xor_get<4>(v); v += xor_get<8>(v); v += xor_get<16>(v); return xor32_sum(v); }
__device__ __forceinline__ float gelu_tanh(float x) {
    const float t = -2.302208198f * (x + 0.044715f * x * x * x);
    return x * __builtin_amdgcn_rcpf(1.0f + __builtin_amdgcn_exp2f(t));
}

__constant__ double c_inv_rev[32] = {0.15915494309189535, 0.11934937021124886, 0.08949940160889101, 0.06711508300522726, 0.050329212104487035, 0.03774158471741977, 0.0283021958306234, 0.02122365276477766, 0.015915494309189534, 0.011934937021124886, 0.008949940160889102, 0.006711508300522725, 0.005032921210448704, 0.003774158471741977, 0.00283021958306234, 0.0021223652764777662, 0.0015915494309189536, 0.0011934937021124885, 0.0008949940160889102, 0.0006711508300522726, 0.0005032921210448703, 0.00037741584717419774, 0.00028302195830623395, 0.0002122365276477766, 0.00015915494309189535, 0.00011934937021124886, 8.949940160889102e-05, 6.711508300522725e-05, 5.0329212104487035e-05, 3.774158471741978e-05, 2.8302195830623396e-05, 2.122365276477766e-05};

__device__ __forceinline__ int dst_row(int mode, int n) {
    if (mode == 1) return ((n >> 7) << 8) + (n & 127);
    if (mode == 2) return ((n >> 7) << 8) + 128 + (n & 127);
    if (mode == 3) { if (n < 1024) return n; if (n < 1088) { const int j = n - 1024; return 1024 + (j < 32 ? 2 * j : 2 * (j - 32) + 1); } return n + 192; }
    if (mode == 4) { const int h = n / 192, d = n - h * 192; if (d < 128) return n; const int j = d - 128; return h * 192 + 128 + (j < 32 ? 2 * j : 2 * (j - 32) + 1); }
    return n;
}
__device__ __forceinline__ void p0_transpose_item(const float* W, int K, int N, bf16* WT, int mode, LAS float* scr, int item, int lane, const float* gk = nullptr) {
    const int nblk = N / 64, kb = item / nblk, nb = item % nblk, k0 = 64 * kb, n0 = 64 * nb;
    const int lr = lane >> 4, lc = (lane & 15) * 4;
#pragma unroll 4
    for (int i = 0; i < 16; ++i) { const int kk = 4 * i + lr; f32x4 v = *(const f32x4*)(W + (size_t)(k0 + kk) * N + n0 + lc); if (gk) v = v * gk[k0 + kk];
        LAS float* d = scr + kk * 65 + lc; d[0] = v.x; d[1] = v.y; d[2] = v.z; d[3] = v.w; }
    asm volatile("s_waitcnt lgkmcnt(0)" ::: "memory");
    const int c = lane & 7;
#pragma unroll
    for (int j = 0; j < 8; ++j) { const int n = (lane >> 3) + 8 * j; const LAS float* sp = scr + (8 * c) * 65 + n;
        u32x4 o; o.x = pk2(sp[0 * 65], sp[1 * 65]); o.y = pk2(sp[2 * 65], sp[3 * 65]); o.z = pk2(sp[4 * 65], sp[5 * 65]); o.w = pk2(sp[6 * 65], sp[7 * 65]);
        *(u32x4*)(WT + (size_t)dst_row(mode, n0 + n) * K + k0 + 8 * c) = o; }
    asm volatile("s_waitcnt lgkmcnt(0)" ::: "memory");
}

__device__ __forceinline__ void p0_transpose_item8(const float* W, int K, int N, unsigned char* WT, int mode, LAS float* scr, int item, int lane, const float* gk, float wscale, const float* cm = nullptr) {
    const int nblk = N / 64, kb = item / nblk, nb = item % nblk, k0 = 64 * kb, n0 = 64 * nb;
    const int lr = lane >> 4, lc = (lane & 15) * 4;
#pragma unroll 4
    for (int i = 0; i < 16; ++i) { const int kk = 4 * i + lr; f32x4 v = *(const f32x4*)(W + (size_t)(k0 + kk) * N + n0 + lc); v = v * (wscale * (gk ? gk[k0 + kk] : 1.f));
        LAS float* d = scr + kk * 65 + lc; d[0] = v.x; d[1] = v.y; d[2] = v.z; d[3] = v.w; }
    asm volatile("s_waitcnt lgkmcnt(0)" ::: "memory");
    unsigned char* orow = WT + (size_t)dst_row(mode, n0 + lane) * K + k0; const float ls = cm ? W8MAX / fmaxf(cm[n0 + lane], 1e-30f) : 1.f;
#pragma unroll
    for (int ch = 0; ch < 4; ++ch) { const LAS float* sp = scr + (16 * ch) * 65 + lane; int w[4];
#pragma unroll
        for (int q = 0; q < 4; ++q) { int t = __builtin_amdgcn_cvt_pk_fp8_f32(sp[(4 * q) * 65] * ls, sp[(4 * q + 1) * 65] * ls, 0, false); w[q] = __builtin_amdgcn_cvt_pk_fp8_f32(sp[(4 * q + 2) * 65] * ls, sp[(4 * q + 3) * 65] * ls, t, true); }
        *(u32x4*)(orow + 16 * ch) = (u32x4){(unsigned)w[0], (unsigned)w[1], (unsigned)w[2], (unsigned)w[3]}; }
    asm volatile("s_waitcnt lgkmcnt(0)" ::: "memory");
}
__device__ __forceinline__ void rms_row_to_fp8(const float* xrow, const float* g, unsigned char* orow, int lane) {
    const f32x4* xr = (const f32x4*)xrow + lane;
    f32x4 v[8]; float s = 0.f;
#pragma unroll
    for (int j = 0; j < 8; ++j) { v[j] = xr[64 * j]; s += (v[j].x * v[j].x + v[j].y * v[j].y) + (v[j].z * v[j].z + v[j].w * v[j].w); }
    const float rstd = __builtin_amdgcn_rsqf(wave_sum(s) * (1.f / DM) + EPS);
    int* o4 = (int*)orow + lane;
#pragma unroll
    for (int j = 0; j < 8; ++j) { const f32x4 gg = ((const f32x4*)g)[lane + 64 * j]; int w = __builtin_amdgcn_cvt_pk_fp8_f32(v[j].x * rstd * gg.x, v[j].y * rstd * gg.y, 0, false);
        w = __builtin_amdgcn_cvt_pk_fp8_f32(v[j].z * rstd * gg.z, v[j].w * rstd * gg.w, w, true); o4[64 * j] = w; }
}
__device__ __forceinline__ float wave_max(float v) {
    v = fmaxf(v, xor_get<1>(v)); v = fmaxf(v, xor_get<2>(v)); v = fmaxf(v, xor_get<4>(v)); v = fmaxf(v, xor_get<8>(v)); v = fmaxf(v, xor_get<16>(v));
    auto rr = __builtin_amdgcn_permlane32_swap(__float_as_uint(v), __float_as_uint(v), false, false); return fmaxf(__uint_as_float(rr[0]), __uint_as_float(rr[1]));
}
__device__ __forceinline__ unsigned q8(float v) { int q = (int)__builtin_rintf(v); q = q < -127 ? -127 : (q > 127 ? 127 : q); return (unsigned)q & 0xffu; }
__device__ __forceinline__ unsigned q8x4(float a, float b, float c, float d) { return q8(a) | (q8(b) << 8) | (q8(c) << 16) | (q8(d) << 24); }
__device__ __forceinline__ void p0_colmax_item(const float* W, int K, int N, float* cm, int item, int lane, const float* gk) {
    const int nblk = N / 64, kq = item / nblk, nb = item % nblk, n0 = 64 * nb, kbeg = kq * (K / 4);
    const int lr = lane >> 4, lc = (lane & 15) * 4; f32x4 mx = {0.f, 0.f, 0.f, 0.f};
#pragma unroll 8
    for (int i = 0; i < K / 16; ++i) { const int k = kbeg + 4 * i + lr; f32x4 v = *(const f32x4*)(W + (size_t)k * N + n0 + lc); if (gk) v = v * gk[k];
        mx.x = fmaxf(mx.x, fabsf(v.x)); mx.y = fmaxf(mx.y, fabsf(v.y)); mx.z = fmaxf(mx.z, fabsf(v.z)); mx.w = fmaxf(mx.w, fabsf(v.w)); }
#pragma unroll
    for (int e = 0; e < 4; ++e) { float m = mx[e]; m = fmaxf(m, xor_get<16>(m)); auto rr = __builtin_amdgcn_permlane32_swap(__float_as_uint(m), __float_as_uint(m), false, false); m = fmaxf(__uint_as_float(rr[0]), __uint_as_float(rr[1])); mx[e] = m; }
    if (lane < 16) {
#pragma unroll
        for (int e = 0; e < 4; ++e) atomicMax((unsigned*)cm + n0 + lc + e, __float_as_uint(mx[e])); }
}
__device__ __forceinline__ void p0_transpose_item_i8(const float* W, int K, int N, unsigned char* WT, int mode, LAS float* scr, int item, int lane, const float* gk, const float* cm) {
    const int nblk = N / 64, kb = item / nblk, nb = item % nblk, k0 = 64 * kb, n0 = 64 * nb;
    const int lr = lane >> 4, lc = (lane & 15) * 4;
#pragma unroll 4
    for (int i = 0; i < 16; ++i) { const int kk = 4 * i + lr; f32x4 v = *(const f32x4*)(W + (size_t)(k0 + kk) * N + n0 + lc); if (gk) v = v * gk[k0 + kk];
        LAS float* d = scr + kk * 65 + lc; d[0] = v.x; d[1] = v.y; d[2] = v.z; d[3] = v.w; }
    asm volatile("s_waitcnt lgkmcnt(0)" ::: "memory");
    const float inv = 127.f / fmaxf(cm[n0 + lane], 1e-30f);
    unsigned char* orow = WT + (size_t)dst_row(mode, n0 + lane) * K + k0;
#pragma unroll
    for (int ch = 0; ch < 4; ++ch) { const LAS float* sp = scr + (16 * ch) * 65 + lane; unsigned w[4];
#pragma unroll
        for (int q = 0; q < 4; ++q) w[q] = q8x4(sp[(4 * q) * 65] * inv, sp[(4 * q + 1) * 65] * inv, sp[(4 * q + 2) * 65] * inv, sp[(4 * q + 3) * 65] * inv);
        *(u32x4*)(orow + 16 * ch) = (u32x4){w[0], w[1], w[2], w[3]}; }
    asm volatile("s_waitcnt lgkmcnt(0)" ::: "memory");
}
__device__ __forceinline__ void rms_row_to_i8(const float* xrow, const float* g, unsigned char* orow, float* rsc, int lane) {
    const f32x4* xr = (const f32x4*)xrow + lane;
    f32x4 v[8]; float s = 0.f;
#pragma unroll
    for (int j = 0; j < 8; ++j) { v[j] = xr[64 * j]; s += (v[j].x * v[j].x + v[j].y * v[j].y) + (v[j].z * v[j].z + v[j].w * v[j].w); }
    const float rstd = __builtin_amdgcn_rsqf(wave_sum(s) * (1.f / DM) + EPS); float mx = 0.f;
#pragma unroll
    for (int j = 0; j < 8; ++j) { const f32x4 gg = ((const f32x4*)g)[lane + 64 * j]; v[j] = v[j] * rstd * gg; mx = fmaxf(fmaxf(mx, fmaxf(fabsf(v[j].x), fabsf(v[j].y))), fmaxf(fabsf(v[j].z), fabsf(v[j].w))); }
    mx = fmaxf(wave_max(mx), 1e-30f); const float inv = 127.f / mx;
    unsigned* o4 = (unsigned*)orow + lane;
#pragma unroll
    for (int j = 0; j < 8; ++j) o4[64 * j] = q8x4(v[j].x * inv, v[j].y * inv, v[j].z * inv, v[j].w * inv);
    if (lane == 0) *rsc = mx * (1.f / 127.f);
}
__device__ __forceinline__ void bf16_row_to_i8(const bf16* xrow, unsigned char* orow, float* rsc, int lane) {
    const u32x4* xr = (const u32x4*)xrow + lane; float f[4][8]; float s = 0.f, mx = 0.f;
#pragma unroll
    for (int j = 0; j < 4; ++j) { unpack8(xr[64 * j], f[j]);
#pragma unroll
        for (int e = 0; e < 8; ++e) { s += f[j][e] * f[j][e]; mx = fmaxf(mx, fabsf(f[j][e])); } }
    const float rstd = __builtin_amdgcn_rsqf(wave_sum(s) * (1.f / DM) + EPS); mx = fmaxf(wave_max(mx), 1e-30f); const float inv = 127.f / mx;
    u32x2* o8 = (u32x2*)orow + lane;
#pragma unroll
    for (int j = 0; j < 4; ++j) { u32x2 w; w.x = q8x4(f[j][0] * inv, f[j][1] * inv, f[j][2] * inv, f[j][3] * inv); w.y = q8x4(f[j][4] * inv, f[j][5] * inv, f[j][6] * inv, f[j][7] * inv); o8[64 * j] = w; }
    if (lane == 0) *rsc = mx * (1.f / 127.f) * rstd;
}
__device__ __forceinline__ void rms_row_to_bf16(const float* xrow, const float* g, bf16* orow, int lane) {
    const f32x4* xr = (const f32x4*)xrow + lane;
    f32x4 v[8]; float s = 0.f;
#pragma unroll
    for (int j = 0; j < 8; ++j) { v[j] = xr[64 * j]; s += (v[j].x * v[j].x + v[j].y * v[j].y) + (v[j].z * v[j].z + v[j].w * v[j].w); }
    const float rstd = __builtin_amdgcn_rsqf(wave_sum(s) * (1.f / DM) + EPS);
    u32x2* o8 = (u32x2*)orow + lane;
#pragma unroll
    for (int j = 0; j < 8; ++j) { const f32x4 gg = ((const f32x4*)g)[lane + 64 * j]; u32x2 w; w.x = pk2(v[j].x * rstd * gg.x, v[j].y * rstd * gg.y); w.y = pk2(v[j].z * rstd * gg.z, v[j].w * rstd * gg.w); o8[64 * j] = w; }
}
__device__ __forceinline__ void rms_row_inplace_f32(float* xrow, const float* g, int lane) {
    f32x4* xr = (f32x4*)xrow + lane;
    f32x4 v[8]; float s = 0.f;
#pragma unroll
    for (int j = 0; j < 8; ++j) { v[j] = xr[64 * j]; s += (v[j].x * v[j].x + v[j].y * v[j].y) + (v[j].z * v[j].z + v[j].w * v[j].w); }
    const float rstd = __builtin_amdgcn_rsqf(wave_sum(s) * (1.f / DM) + EPS);
#pragma unroll
    for (int j = 0; j < 8; ++j) { const f32x4 gg = ((const f32x4*)g)[lane + 64 * j]; xr[64 * j] = v[j] * rstd * gg; }
}


__device__ __forceinline__ void onorm_row(bf16* o, const float* g_a, const float* g_g, int lane) {
#pragma unroll
    for (int half = 0; half < 2; ++half) {
        u32x4* p = (u32x4*)(o + half * 1024) + lane; float f0[8], f1[8]; unpack8(p[0], f0); unpack8(p[64], f1); float s = 0.f;
#pragma unroll
        for (int e = 0; e < 8; ++e) s += f0[e] * f0[e] + f1[e] * f1[e];
        const float rstd = __builtin_amdgcn_rsqf(wave_sum(s) * (1.f / 1024.f) + EPS);
        const float* g = (half ? g_g : g_a) + 8 * lane;
#pragma unroll
        for (int e = 0; e < 8; ++e) { f0[e] *= rstd * g[e]; f1[e] *= rstd * g[512 + e]; }
        p[0] = pack8(f0); p[64] = pack8(f1);
    }
}

namespace att {
constexpr int NW = 8, QBLK = 32, KVBLK = 64;
constexpr int LDQ = QW, LDKV = KVW, LDKR = ZW, LDO = DM;
constexpr float SCALE = 0.07216878364870322f;
constexpr float THR = 8.f;
#ifndef ATT_SDEPTH
#define ATT_SDEPTH 1
#endif
constexpr int SDEPTH = ATT_SDEPTH;
constexpr int SHM_V = KVBLK * 128 * 2, SHM_K = KVBLK * 128 * 2, SHM_KR = KVBLK * 64 * 2;
#ifndef ATT_NQL
#define ATT_NQL 0
#endif
constexpr int NQL = ATT_NQL, NQR = 12 - NQL;
constexpr int OFF_V = 0, OFF_K = 2 * SHM_V, OFF_KR = OFF_K + 2 * SHM_K, OFF_WS = OFF_KR + 2 * SHM_KR, OFF_QL = OFF_WS + NW * 64 * 4, ATT_LDS = OFF_QL + NW * NQL * 1024;
static_assert(ATT_LDS <= 147456, "attention LDS");
#define KSWZ(row, colB) ((row) * 256 + ((colB) ^ (((row) & 7) << 4)))
#define KRSWZ(row, colB) ((row) * 128 + ((colB) ^ ((((row) >> 1) & 7) << 4)))
#define SBAR() __builtin_amdgcn_sched_barrier(0)
__device__ __forceinline__ int crow(int r, int hi) { return (r & 3) + 8 * (r >> 2) + 4 * hi; }
__device__ __forceinline__ unsigned cvtpk(float lo, float hi) { unsigned r; asm volatile("v_cvt_pk_bf16_f32 %0, %1, %2" : "=v"(r) : "v"(lo), "v"(hi)); return r; }

__device__ __forceinline__ void partialSM(f32x16& p0, f32x16& p1, float& m_reg, float& mn, float& alpha) {
  constexpr float C = SCALE * 1.4426950408889634f;
  float pmax = p0[0];
#pragma unroll
  for (int r = 1; r < 16; ++r) pmax = fmaxf(pmax, p0[r]);
#pragma unroll
  for (int r = 0; r < 16; ++r) pmax = fmaxf(pmax, p1[r]);
  { auto rr = __builtin_amdgcn_permlane32_swap(__float_as_uint(pmax), __float_as_uint(pmax), false, false);
    pmax = fmaxf(__uint_as_float(rr[0]), __uint_as_float(rr[1])); }
  if (__builtin_expect(__all(pmax - m_reg <= THR / SCALE), 1)) { mn = m_reg; alpha = 1.f; }
  else { mn = fmaxf(m_reg, pmax); alpha = __builtin_amdgcn_exp2f((m_reg - mn) * C); m_reg = mn; }
  float mnC = -mn * C;
#pragma unroll
  for (int r = 0; r < 16; ++r) p0[r] = fmaf(p0[r], C, mnC);
#pragma unroll
  for (int r = 0; r < 16; ++r) p1[r] = fmaf(p1[r], C, mnC);
#pragma unroll
  for (int r = 0; r < 16; ++r) p0[r] = __builtin_amdgcn_exp2f(p0[r]);
}
__device__ __forceinline__ void finishSM(f32x16& p0, f32x16& p1, float alpha, float& l_reg, bf16x8& pa0, bf16x8& pa1, bf16x8& pa2, bf16x8& pa3) {
#pragma unroll
  for (int r = 0; r < 16; ++r) p1[r] = __builtin_amdgcn_exp2f(p1[r]);
  float ps = 0;
#pragma unroll
  for (int r = 0; r < 16; ++r) ps += p0[r];
#pragma unroll
  for (int r = 0; r < 16; ++r) ps += p1[r];
  { auto rr = __builtin_amdgcn_permlane32_swap(__float_as_uint(ps), __float_as_uint(ps), false, false);
    ps = __uint_as_float(rr[0]) + __uint_as_float(rr[1]); }
  l_reg = l_reg * alpha + ps;
#define PK4(P, BASE, OUT) do { unsigned a0 = cvtpk(P[BASE + 0], P[BASE + 1]), a1 = cvtpk(P[BASE + 2], P[BASE + 3]);   \
    unsigned b0 = cvtpk(P[BASE + 4], P[BASE + 5]), b1 = cvtpk(P[BASE + 6], P[BASE + 7]);                              \
    auto r0 = __builtin_amdgcn_permlane32_swap(a0, b0, false, false); auto r1 = __builtin_amdgcn_permlane32_swap(a1, b1, false, false); \
    u32x4 w = {r0[0], r1[0], r0[1], r1[1]}; OUT = *reinterpret_cast<bf16x8*>(&w); } while (0)
  PK4(p0, 0, pa0); PK4(p0, 8, pa1); PK4(p1, 0, pa2); PK4(p1, 8, pa3);
#undef PK4
}
#define QF(d) ((d) < NQR ? qr[(d) < NQR ? (d) : 0] : *reinterpret_cast<const bf16x8*>(ql + ((d) - NQR) * 1024))
__device__ __forceinline__ void qkt(f32x16& p0, f32x16& p1, const char* Ks, const char* Krs, const bf16x8* qr, const char* ql, int r32, int hi) {
  p0 = f32x16{}; p1 = f32x16{};
#pragma unroll
  for (int d0 = 0; d0 < 8; ++d0) { int cb = (d0 * 16 + hi * 8) * 2;
    bf16x8 b0 = *reinterpret_cast<const bf16x8*>(Ks + KSWZ(r32, cb));
    bf16x8 b1 = *reinterpret_cast<const bf16x8*>(Ks + KSWZ(32 + r32, cb));
    const bf16x8 qf = QF(d0);
    p0 = __builtin_amdgcn_mfma_f32_32x32x16_bf16(b0, qf, p0, 0, 0, 0);
    p1 = __builtin_amdgcn_mfma_f32_32x32x16_bf16(b1, qf, p1, 0, 0, 0); }
#pragma unroll
  for (int d0 = 0; d0 < 4; ++d0) { int cb = (d0 * 16 + hi * 8) * 2;
    bf16x8 b0 = *reinterpret_cast<const bf16x8*>(Krs + KRSWZ(r32, cb));
    bf16x8 b1 = *reinterpret_cast<const bf16x8*>(Krs + KRSWZ(32 + r32, cb));
    const bf16x8 qf = QF(8 + d0);
    p0 = __builtin_amdgcn_mfma_f32_32x32x16_bf16(b0, qf, p0, 0, 0, 0);
    p1 = __builtin_amdgcn_mfma_f32_32x32x16_bf16(b1, qf, p1, 0, 0, 0); }
}
__device__ __forceinline__ int v_st(int k, int c) { const int kk = (k & ~0xC) | ((k & 4) << 1) | ((k & 8) >> 1); return ((kk >> 3) * 4 + (c >> 5)) * 512 + ((kk & 7) * 32 + (c & 31)) * 2; }
__device__ __forceinline__ int v_rd_base(int lane) { return ((lane & 3) << 3) | (((lane >> 2) & 3) << 6) | (((lane >> 4) & 1) << 5) | (((lane >> 5) & 1) << 8); }
constexpr int v_rd_off(int d0, int ks, int half) { return d0 * 512 + ks * 4096 + half * 2048; }
template <int OFF> __device__ __forceinline__ s16x4 tr_read(int vb) {
  s16x4 r; asm volatile("ds_read_b64_tr_b16 %0, %1 offset:%2" : "=&v"(r) : "v"(vb), "i"(OFF) : "memory"); return r;
}
template <int D0> __device__ __forceinline__ void pv_one(f32x16& od, int vb, bf16x8 pa0, bf16x8 pa1, bf16x8 pa2, bf16x8 pa3) {
  const s16x4 l0 = tr_read<v_rd_off(D0, 0, 0)>(vb), h0 = tr_read<v_rd_off(D0, 0, 1)>(vb), l1 = tr_read<v_rd_off(D0, 1, 0)>(vb), h1 = tr_read<v_rd_off(D0, 1, 1)>(vb);
  const s16x4 l2 = tr_read<v_rd_off(D0, 2, 0)>(vb), h2 = tr_read<v_rd_off(D0, 2, 1)>(vb), l3 = tr_read<v_rd_off(D0, 3, 0)>(vb), h3 = tr_read<v_rd_off(D0, 3, 1)>(vb);
  asm volatile("s_waitcnt lgkmcnt(0)" ::: "memory"); SBAR();
#define PK(L, H) (bf16x8){L[0], L[1], L[2], L[3], H[0], H[1], H[2], H[3]}
  od = __builtin_amdgcn_mfma_f32_32x32x16_bf16(pa0, PK(l0, h0), od, 0, 0, 0);
  od = __builtin_amdgcn_mfma_f32_32x32x16_bf16(pa1, PK(l1, h1), od, 0, 0, 0);
  od = __builtin_amdgcn_mfma_f32_32x32x16_bf16(pa2, PK(l2, h2), od, 0, 0, 0);
  od = __builtin_amdgcn_mfma_f32_32x32x16_bf16(pa3, PK(l3, h3), od, 0, 0, 0);
#undef PK
}
__device__ __forceinline__ void pv_d0(f32x16* o, int vb, bf16x8 pa0, bf16x8 pa1, bf16x8 pa2, bf16x8 pa3) {
  pv_one<0>(o[0], vb, pa0, pa1, pa2, pa3); pv_one<1>(o[1], vb, pa0, pa1, pa2, pa3); pv_one<2>(o[2], vb, pa0, pa1, pa2, pa3); pv_one<3>(o[3], vb, pa0, pa1, pa2, pa3);
}

__device__ __forceinline__ void attn_dense_body(const bf16* __restrict__ Qb, const bf16* __restrict__ Kn, const bf16* __restrict__ Kr, const bf16* __restrict__ Vh,
                                                bf16* __restrict__ Ob, int seq, char* lds, const int wv) {
  const int tid = tid_of(wv), wid = tid >> 6, lane = tid & 63, r32 = lane & 31, hi = lane >> 5;
  char* V_lds = lds + OFF_V; char* K_lds = lds + OFF_K; char* KR_lds = lds + OFF_KR;
  float* ws = (float*)(lds + OFF_WS) + wid * 64; float* li_l = ws; float* al_l = ws + 32;
  float m_reg = -1e30f, l_reg = 0; f32x16 o[4] = {}; bf16x8 qr[NQR]; char* ql = lds + OFF_QL + wid * (NQL * 1024) + lane * 16;
  const bf16* Qw = Qb + (long)(wid * QBLK + r32) * LDQ + hi * 8;
#pragma unroll
  for (int d0 = 0; d0 < 12; ++d0) { const bf16x8 t = *reinterpret_cast<const bf16x8*>(Qw + d0 * 16); if (d0 < NQR) qr[d0 < NQR ? d0 : 0] = t; else *reinterpret_cast<bf16x8*>(ql + (d0 - NQR) * 1024) = t; }
  const int sr = tid >> 4, sc = (tid & 15) * 8, vst0 = v_st(sr, sc), vst1 = v_st(32 + sr, sc);
  const int krr = tid >> 3, krc = (tid & 7) * 8;
  const int vb0 = (int)(uintptr_t)V_lds + v_rd_base(lane);
  struct { bf16x8 vs0, vs1, ks0, ks1, kr; } sr_[SDEPTH];
const unsigned offV0 = (unsigned)(sr * LDKV + sc) * 2u, offV1 = (unsigned)((32 + sr) * LDKV + sc) * 2u, offKR = (unsigned)(krr * LDKR + krc) * 2u;
#define SLOAD(i, k0) do { const char* vt_ = (const char*)Vh + (size_t)(k0) * (LDKV * 2); const char* kt_ = (const char*)Kn + (size_t)(k0) * (LDKV * 2); const char* rt_ = (const char*)Kr + (size_t)(k0) * (LDKR * 2); \
    sr_[i].vs0 = *reinterpret_cast<const bf16x8*>(vt_ + offV0); sr_[i].vs1 = *reinterpret_cast<const bf16x8*>(vt_ + offV1); \
    sr_[i].ks0 = *reinterpret_cast<const bf16x8*>(kt_ + offV0); sr_[i].ks1 = *reinterpret_cast<const bf16x8*>(kt_ + offV1); \
    sr_[i].kr = *reinterpret_cast<const bf16x8*>(rt_ + offKR); } while (0)
#define SWRITE(b, i) do { *(bf16x8*)(V_lds + (b) * SHM_V + vst0) = sr_[i].vs0;          \
    *(bf16x8*)(V_lds + (b) * SHM_V + vst1) = sr_[i].vs1; int kc = sc * 2;               \
    *(bf16x8*)(K_lds + (b) * SHM_K + KSWZ(sr, kc)) = sr_[i].ks0;                       \
    *(bf16x8*)(K_lds + (b) * SHM_K + KSWZ(32 + sr, kc)) = sr_[i].ks1;                  \
    *(bf16x8*)(KR_lds + (b) * SHM_KR + KRSWZ(krr, krc * 2)) = sr_[i].kr; } while (0)
#define SWAIT() do { if constexpr (SDEPTH == 2) asm volatile("s_waitcnt vmcnt(5)" ::: "memory"); else asm volatile("s_waitcnt vmcnt(0)" ::: "memory"); } while (0)
#define RESC(a) do { if (__any((a) < 1.f)) { if (hi == 0) al_l[r32] = (a); asm volatile("s_waitcnt lgkmcnt(0)" ::: "memory"); \
    _Pragma("unroll") for (int d = 0; d < 4; ++d) _Pragma("unroll") for (int r = 0; r < 16; ++r) o[d][r] *= al_l[crow(r, hi)]; } } while (0)
  f32x16 pA0, pA1, pB0, pB1; float mnA, mnB, alA, alB; bf16x8 pa0, pa1, pa2, pa3; const int NT = seq / KVBLK;
  constexpr int SE = 0, SO = SDEPTH - 1;
  SLOAD(SE, 0); asm volatile("s_waitcnt vmcnt(0)" ::: "memory"); SWRITE(0, SE); __syncthreads();
  qkt(pA0, pA1, K_lds, KR_lds, qr, ql, r32, hi); partialSM(pA0, pA1, m_reg, mnA, alA);
  SLOAD(SO, KVBLK); if constexpr (SDEPTH == 2) { if (2 < NT) SLOAD(SE, 2 * KVBLK); }
  SWAIT(); SWRITE(1, SO); __syncthreads();
  for (int j = 1; j + 1 < NT; j += 2) {
    SBAR(); qkt(pB0, pB1, K_lds + SHM_K, KR_lds + SHM_KR, qr, ql, r32, hi);
    finishSM(pA0, pA1, alA, l_reg, pa0, pa1, pa2, pa3); SBAR();
    SLOAD(SO, (j + SDEPTH) * KVBLK); SBAR();
    pv_d0(o, vb0, pa0, pa1, pa2, pa3); partialSM(pB0, pB1, m_reg, mnB, alB);
    __syncthreads(); SWAIT(); SWRITE(0, SE);
    RESC(alB); __syncthreads();
    SBAR(); qkt(pA0, pA1, K_lds, KR_lds, qr, ql, r32, hi);
    finishSM(pB0, pB1, alB, l_reg, pa0, pa1, pa2, pa3); SBAR();
    if (SDEPTH == 1 || j + 3 < NT) SLOAD(SE, (j + 1 + SDEPTH) * KVBLK); SBAR();
    pv_d0(o, vb0 + SHM_V, pa0, pa1, pa2, pa3); partialSM(pA0, pA1, m_reg, mnA, alA);
    __syncthreads(); SWAIT(); SWRITE(1, SO);
    RESC(alA); __syncthreads();
  }
  SBAR(); qkt(pB0, pB1, K_lds + SHM_K, KR_lds + SHM_KR, qr, ql, r32, hi);
  finishSM(pA0, pA1, alA, l_reg, pa0, pa1, pa2, pa3); SBAR();
  pv_d0(o, vb0, pa0, pa1, pa2, pa3); partialSM(pB0, pB1, m_reg, mnB, alB);
  __syncthreads(); RESC(alB);
  finishSM(pB0, pB1, alB, l_reg, pa0, pa1, pa2, pa3); SBAR();
  pv_d0(o, vb0 + SHM_V, pa0, pa1, pa2, pa3);
  if (hi == 0) li_l[r32] = l_reg; asm volatile("s_waitcnt lgkmcnt(0)" ::: "memory");
  float rli[16];
#pragma unroll
  for (int r = 0; r < 16; ++r) rli[r] = __builtin_amdgcn_rcpf(li_l[crow(r, hi)]);
  bf16* Ow = Ob + (long)(wid * QBLK) * LDO;
#pragma unroll
  for (int r = 0; r < 16; ++r) { int orow = crow(r, hi);
#pragma unroll
    for (int d0 = 0; d0 < 4; ++d0) Ow[(long)orow * LDO + d0 * 32 + r32] = (bf16)(cvtpk(o[d0][r] * rli[r], 0.f) & 0xffffu); }
#undef SLOAD
#undef SWRITE
#undef SWAIT
#undef RESC
}
}

__device__ __forceinline__ void gmlp_unit(const bf16* Z, const bf16* Wsp, const float* b_s, const float* g_v, bf16* O, int chunk, int g, char* lds, const int wv) {
  const int tid = tid_of(wv), wid = tid >> 6, lane = tid & 63, r32 = lane & 31, hi = lane >> 5;
  constexpr int PITCH = 136;
  bf16* VT = (bf16*)lds;
  const bf16* Zc = Z + (size_t)chunk * 128 * ZW;
  bf16x8 af[8];
  { const bf16* Ar = Wsp + (size_t)g * 16384 + (size_t)((wid & 3) * 32 + r32) * 128 + hi * 8;
#pragma unroll
    for (int k = 0; k < 8; ++k) af[k] = *reinterpret_cast<const bf16x8*>(Ar + k * 16); }
  __syncthreads();
  {
    const int j = tid >> 2, cg = tid & 3; u32x4 w[4]; float sq = 0.f;
    const bf16* zr = Zc + (size_t)j * ZW + Z_V + g * 128 + cg * 8;
#pragma unroll
    for (int i = 0; i < 4; ++i) w[i] = *(const u32x4*)(zr + 32 * i);
#pragma unroll
    for (int i = 0; i < 4; ++i) { float f[8]; unpack8(w[i], f);
#pragma unroll
      for (int e = 0; e < 8; ++e) sq += f[e] * f[e]; }
    sq += xor_get<1>(sq); sq += xor_get<2>(sq);
    const float rs = __builtin_amdgcn_rsqf(sq * (1.f / 128.f) + EPS);
#pragma unroll
    for (int i = 0; i < 4; ++i) { const int c0 = (cg + 4 * i) * 8; float f[8]; unpack8(w[i], f);
      const float* gp = g_v + g * 128 + c0; const f32x4 g0 = *(const f32x4*)gp, g1 = *(const f32x4*)(gp + 4);
      unsigned p0 = pk2(f[0] * rs * g0.x, f[1] * rs * g0.y), p1 = pk2(f[2] * rs * g0.z, f[3] * rs * g0.w), p2 = pk2(f[4] * rs * g1.x, f[5] * rs * g1.y), p3 = pk2(f[6] * rs * g1.z, f[7] * rs * g1.w);
      if (cg & 1) { const unsigned t = p0; p0 = p1; p1 = p2; p2 = p3; p3 = t; }
      if (cg & 2) { unsigned t = p0; p0 = p2; p2 = t; t = p1; p1 = p3; p3 = t; }
      const unsigned q[4] = {p0, p1, p2, p3};
#pragma unroll
      for (int d = 0; d < 4; ++d) { const int dd = (d + cg) & 3; VT[(c0 + 2 * dd) * PITCH + j] = (bf16)(q[d] & 0xffff); VT[(c0 + 2 * dd + 1) * PITCH + j] = (bf16)(q[d] >> 16); } }
  }
  __syncthreads();
  const int ib = (wid & 3) * 32, cb = (wid >> 2) * 64;
  f32x16 a0 = {}, a1 = {};
#pragma unroll
  for (int k = 0; k < 8; ++k) {
    const bf16x8 b0 = *reinterpret_cast<const bf16x8*>(VT + (cb + r32) * PITCH + k * 16 + hi * 8);
    const bf16x8 b1 = *reinterpret_cast<const bf16x8*>(VT + (cb + 32 + r32) * PITCH + k * 16 + hi * 8);
    a0 = __builtin_amdgcn_mfma_f32_32x32x16_bf16(b0, af[k], a0, 0, 0, 0);
    a1 = __builtin_amdgcn_mfma_f32_32x32x16_bf16(b1, af[k], a1, 0, 0, 0);
  }
  { const int i = ib + r32; const float bb = b_s[g * 128 + i]; const size_t row = (size_t)chunk * 128 + i;
    const bf16* up = Z + row * ZW + Z_U + g * 128 + cb + 4 * hi; bf16* op = O + row * DM + 1024 + g * 128 + cb + 4 * hi;
#pragma unroll
    for (int q = 0; q < 4; ++q) {
      const u32x2 w0 = *(const u32x2*)(up + 8 * q), w1 = *(const u32x2*)(up + 32 + 8 * q);
      u32x2 o0, o1;
      o0.x = pk2(bf_lo(w0.x) * (a0[4 * q + 0] + bb), bf_hi(w0.x) * (a0[4 * q + 1] + bb)); o0.y = pk2(bf_lo(w0.y) * (a0[4 * q + 2] + bb), bf_hi(w0.y) * (a0[4 * q + 3] + bb));
      o1.x = pk2(bf_lo(w1.x) * (a1[4 * q + 0] + bb), bf_hi(w1.x) * (a1[4 * q + 1] + bb)); o1.y = pk2(bf_lo(w1.y) * (a1[4 * q + 2] + bb), bf_hi(w1.y) * (a1[4 * q + 3] + bb));
      *(u32x2*)(op + 8 * q) = o0; *(u32x2*)(op + 32 + 8 * q) = o1; } }
}

#define XB_TMO      128
#define XB_XCNT(j)  (256  + 64 * (j))
#define XB_XSUB(j)  (1280 + 64 * (j))
#define XB_XGEN(j)  (2304 + 64 * (j))
#define XB_TOP      3328
#define XB_TOPGEN   3392
#define XCD_BAR_WORDS 3456
#define XB_SPIN_CAP (1u << 18)
__device__ __forceinline__ unsigned xb_ld(unsigned* p)              { return __hip_atomic_load(p, __ATOMIC_RELAXED, __HIP_MEMORY_SCOPE_AGENT); }
__device__ __forceinline__ unsigned xb_add(unsigned* p, unsigned v) { return __hip_atomic_fetch_add(p, v, __ATOMIC_RELAXED, __HIP_MEMORY_SCOPE_AGENT); }
__device__ __forceinline__ unsigned xb_xcc_id() { return (unsigned)__builtin_amdgcn_s_getreg((3 << 11) | 20) & 0xFu; }
#define XB_SPIN(cond, bar) do { unsigned _sp = 0; while (cond) { __builtin_amdgcn_s_sleep(1); \
    if ((++_sp & 255u) == 0u) { if (xb_ld(&(bar)[XB_TMO])) break; if (_sp > XB_SPIN_CAP) { atomicAdd(&(bar)[XB_TMO], 1u); break; } } } } while (0)
struct XcdBarrier { unsigned* bar; unsigned x; volatile LAS unsigned* st; };
__device__ __forceinline__ XcdBarrier xcd_barrier_post(unsigned* bar, volatile LAS unsigned* st) {
    XcdBarrier b; b.bar = bar; b.x = xb_xcc_id(); b.st = st;
    if (threadIdx.x == 0) (void)xb_add(&bar[XB_XCNT(b.x)], 1u);
    return b;
}
__device__ __forceinline__ void xcd_barrier_complete(unsigned* bar, unsigned x, unsigned& nloc, unsigned& nx) {
    const unsigned G = gridDim.x * gridDim.y * gridDim.z;
    unsigned sum, cnt, mine, sp = 0u;
    for (;;) {
        sum = 0u; cnt = 0u; mine = 0u;
#pragma unroll
        for (unsigned j = 0; j < 16; ++j) { const unsigned c = xb_ld(&bar[XB_XCNT(j)]); sum += c; cnt += (c > 0u) ? 1u : 0u; mine = (j == x) ? c : mine; }
        if (sum == G) break;
        __builtin_amdgcn_s_sleep(1);
        if ((++sp & 255u) == 0u) { if (xb_ld(&bar[XB_TMO])) break; if (sp > XB_SPIN_CAP) { atomicAdd(&bar[XB_TMO], 1u); break; } }
    }
    nloc = mine > 0u ? mine : 1u; nx = cnt > 0u ? cnt : 1u;
}
__device__ __forceinline__ void xcd_barrier(const XcdBarrier& b, const int wv) {
    asm volatile("s_waitcnt vmcnt(0)" ::: "memory");
    __syncthreads();
    if (tid_of(wv) == 0) {
        unsigned* bar = b.bar;
        __builtin_amdgcn_s_waitcnt(0);
        unsigned nloc = b.st[0], nx = b.st[1];
        if (nloc == 0u) { xcd_barrier_complete(bar, b.x, nloc, nx); b.st[0] = nloc; b.st[1] = nx; }
        const unsigned old = xb_add(&bar[XB_XSUB(b.x)], 1u);
        const unsigned gen = old / nloc;
        if (old + 1u == (gen + 1u) * nloc) {
            __builtin_amdgcn_fence(__ATOMIC_RELEASE, "agent");
            asm volatile("s_waitcnt vmcnt(0)" ::: "memory");
            const unsigned og = xb_add(&bar[XB_TOP], 1u);
            const unsigned tg = og / nx;
            if (og + 1u == (tg + 1u) * nx) xb_add(&bar[XB_TOPGEN], 1u);
            else XB_SPIN(xb_ld(&bar[XB_TOPGEN]) == tg, bar);
            __builtin_amdgcn_fence(__ATOMIC_ACQUIRE, "agent");
            xb_add(&bar[XB_XGEN(b.x)], 1u);
            asm volatile("s_waitcnt vmcnt(0)" ::: "memory");
        } else {
            XB_SPIN(xb_ld(&bar[XB_XGEN(b.x)]) == gen, bar);
            __builtin_amdgcn_fence(__ATOMIC_ACQUIRE, "agent");
            asm volatile("s_waitcnt vmcnt(0)" ::: "memory");
        }
    }
    __syncthreads();
}

struct Args { const float* in[23]; float* out; unsigned char* ws; int ph_lo, ph_hi; };

template <class Epi, int MODE = 0>
__device__ __forceinline__ void run_gemm(LAS unsigned char* lds, const void* A, int lda, const void* Bt, int ldb, int M, int N, int K, const Epi E, const int wv, int base = -1, int stride = 0, int cnt = 0x7fffffff) {
    pg8::Gemm g{A, Bt, M, N, K, lda, ldb}; pg8::StaticOrder S; S.init(M, N, (int)gridDim.x, (int)blockIdx.x);
    if (base >= 0) { S.base = base; S.stride = stride; } S.cnt = cnt;
    pg8::gemm_phase<Epi, pg8::StaticOrder, true, true, MODE>(lds, g, S, E, wv);
}

__global__ void __launch_bounds__(512) mk_fwd(Args args) {
    extern __shared__ __attribute__((aligned(16))) unsigned char lds_raw[];
    LAS unsigned char* lds = (LAS unsigned char*)lds_raw;
    const int G = gridDim.x;
    const int wv = __builtin_amdgcn_readfirstlane(threadIdx.x >> 6);
    volatile LAS unsigned* bar_st = (volatile LAS unsigned*)(lds + (LDS_BYTES - 64));
    if (threadIdx.x < 2) bar_st[threadIdx.x] = 0u;
    __syncthreads();
    unsigned* barw = (unsigned*)(args.ws);
    XcdBarrier xbar; xbar.bar = barw; xbar.x = 0; xbar.st = bar_st;
#define LANE_INIT const int tid = tid_of(wv), lane = tid & 63, wave = wv, gw = blockIdx.x * 8 + wave, NGW = G * 8; (void)tid; (void)lane; (void)gw; (void)NGW;
#define PH_WS unsigned char* ws = args.ws; float* X = args.out; (void)X; (void)ws;
#define x_p (args.in[0])
#define x_s (args.in[1])
#define g_ffn1 (args.in[2])
#define w1_gate (args.in[3])
#define w1_up (args.in[4])
#define w1_down (args.in[5])
#define g_mix (args.in[6])
#define w_in (args.in[7])
#define g_q (args.in[8])
#define w_q_b (args.in[9])
#define g_kv (args.in[10])
#define w_kv_b (args.in[11])
#define g_v (args.in[12])
#define w_s (args.in[13])
#define b_s (args.in[14])
#define g_out_attn (args.in[15])
#define g_out_gmlp (args.in[16])
#define w_out (args.in[17])
#define g_ffn2 (args.in[18])
#define w2_gate (args.in[19])
#define w2_up (args.in[20])
#define w2_down (args.in[21])
#define g_final (args.in[22])
#define rope ((float*)(ws + WS_ROPE))
#define W1U ((bf16*)(ws + WS_W1U))
#define W1D ((bf16*)(ws + WS_W1D))
#define W2U ((bf16*)(ws + WS_W2U))
#define W2D ((bf16*)(ws + WS_W2D))
#define WIN ((bf16*)(ws + WS_WIN))
#define WQ ((bf16*)(ws + WS_WQ))
#define WKV ((bf16*)(ws + WS_WKV))
#define WOUT ((bf16*)(ws + WS_WOUT))
#define WSP ((bf16*)(ws + WS_WSP))
#define H ((bf16*)(ws + WS_H))
#define ACT ((bf16*)(ws + WS_ACT))
#define Z ((bf16*)(ws + WS_Z))
#define Q ((bf16*)(ws + WS_Q))
#define KV ((bf16*)(ws + WS_KV))
#define H2 ((bf16*)(ws + WS_H2))
#define X1B ((bf16*)X)
#define X2B ((bf16*)X + (size_t)T * DM)
#define CM ((float*)(ws + WS_CM))
#define RS1 ((float*)(ws + WS_RS))
#define RS2 ((float*)(ws + WS_RS) + T)
#define SS ((pg8::u64*)(ws + WS_SS))
#define SS1 (SS)
#define SS3 (SS + T)
#define SSQ (SS + 2 * T)
#define SSKV (SS + 3 * T)
#define IN(k) true
#define SEAM(k) do { if ((k) == 0) { cg::this_grid().sync(); xbar = xcd_barrier_post(barw, bar_st); } else xcd_barrier(xbar, wv); } while (0)

    if (IN(0)) {
        PH_WS LANE_INIT
        LAS float* scr = (LAS float*)(lds + wave * 16640);
        constexpr int I_UP = (DM / 64) * (DFF / 64), I_DN = (DFF / 64) * (DM / 64), I_IN = (DM / 64) * (3136 / 64), I_Q = (512 / 64) * (QW / 64), I_KV = (512 / 64) * (KVW / 64), I_OUT = (DM / 64) * (DM / 64);
        constexpr int I_CM = 4 * (DFF / 64), I_CMD = 4 * (DM / 64); constexpr int NITEMS = 4 * I_CM + I_CMD + 2 * I_DN + I_IN + I_Q + I_KV + I_OUT;
        for (int it = gw; it < NITEMS; it += NGW) {
            int r = it;
            if (r < 4 * I_CM) {
                const int mat = r / I_CM, it2 = r % I_CM;
                p0_colmax_item(mat == 0 ? w1_gate : mat == 1 ? w1_up : mat == 2 ? w2_gate : w2_up, DM, DFF, CM + mat * DFF, it2, lane, mat >= 2 ? g_ffn2 : nullptr); continue; } r -= 4 * I_CM;
            if (r < I_CMD) { p0_colmax_item(w2_down, DFF, DM, CM + 4 * DFF, r, lane, nullptr); continue; } r -= I_CMD;
            if (r < I_DN) { p0_transpose_item(w1_down, DFF, DM, W1D, 0, scr, r, lane); continue; } r -= I_DN;
            if (r < I_DN) { if (!FP8_DOWN2) p0_transpose_item(w2_down, DFF, DM, W2D, 0, scr, r, lane); continue; } r -= I_DN;
            if (r < I_IN) { p0_transpose_item(w_in, DM, 3136, WIN, 3, scr, r, lane, g_mix); continue; } r -= I_IN;
            if (r < I_Q) { p0_transpose_item(w_q_b, 512, QW, WQ, 4, scr, r, lane, g_q); continue; } r -= I_Q;
            if (r < I_KV) { p0_transpose_item(w_kv_b, 512, KVW, WKV, 0, scr, r, lane, g_kv); continue; } r -= I_KV;
            p0_transpose_item(w_out, DM, DM, WOUT, 0, scr, r, lane);
        }
        const int gt = blockIdx.x * 512 + tid, NGT = G * 512;
        if (blockIdx.x == 0) for (int i = tid; i < XCD_BAR_WORDS; i += 512) barw[i] = 0u;
        for (int i = gt; i < 192 * DM / 8; i += NGT) ((u32x4*)(WIN + (size_t)1088 * DM))[i] = (u32x4){0u, 0u, 0u, 0u};
        for (int i = gt; i < 4 * T / 2; i += NGT) ((u32x4*)SS)[i] = (u32x4){0u, 0u, 0u, 0u};
        for (int i = gt; i < 8 * 128 * 128 / 2; i += NGT) ((unsigned*)WSP)[i] = pk2(w_s[2 * i], w_s[2 * i + 1]);
        for (int i = gt; i < 8192 * 32; i += NGT) { const int pos = i >> 5, k = i & 31; const double a = (double)pos * c_inv_rev[k]; const float fr = (float)(a - floor(a));
            rope[(size_t)pos * 64 + k] = __builtin_amdgcn_cosf(fr); rope[(size_t)pos * 64 + 32 + k] = __builtin_amdgcn_sinf(fr); }
        for (int m = gw; m < T; m += NGW) { const float* xr = (m < TP ? x_p + (size_t)m * DM : x_s + (size_t)(m - TP) * DM);
            rms_row_to_i8(xr, g_ffn1, (unsigned char*)H + (size_t)m * DM, RS1 + m, lane); }
    }
    SEAM(0);
    {
        PH_WS LANE_INIT
        LAS float* scr = (LAS float*)(lds + wave * 16640);
        constexpr int I_UP = (DM / 64) * (DFF / 64), I_DN8 = FP8_DOWN2 ? (DFF / 64) * (DM / 64) : 0;
        for (int it = gw; it < I_DN8; it += NGW) p0_transpose_item8(w2_down, DFF, DM, (unsigned char*)W2D, 0, scr, it, lane, nullptr, 1.f, CM + 4 * DFF);
        for (int it = gw; it < 4 * I_UP; it += NGW) { const int mat = it / I_UP, r = it % I_UP;
            p0_transpose_item_i8(mat == 0 ? w1_gate : mat == 1 ? w1_up : mat == 2 ? w2_gate : w2_up, DM, DFF, (unsigned char*)(mat < 2 ? W1U : W2U), 1 + (mat & 1), scr, r, lane, mat >= 2 ? g_ffn2 : nullptr, CM + mat * DFF); }
    }
    SEAM(20);
    if (IN(1)) { PH_WS pg8::EpiSwiGLU<false> E{ACT, DFF, RS1, CM, CM + DFF, 1.f / 127.f}; run_gemm<pg8::EpiSwiGLU<false>, 2>(lds, H, DM, W1U, DM, T, 2 * DFF, DM, E, wv); }
    SEAM(1);
    if (IN(2)) { PH_WS
        { pg8::EpiResid<true, false, 1, true, false, false, false> E{x_p, nullptr, DM, X1B, SS1, nullptr, nullptr, 1.f}; run_gemm(lds, ACT, DFF, W1D, DFF, TP, DM, DFF, E, wv); }
        { pg8::EpiResid<true, false, 1, true, false, false, false> E{x_s, nullptr, DM, X1B + (size_t)TP * DM, SS1 + TP, nullptr, nullptr, 1.f}; run_gemm(lds, ACT + (size_t)TP * DFF, DFF, W1D, DFF, TS, DM, DFF, E, wv); }
    }
    SEAM(2);
    const bool rebal = (G == 256);
    if (IN(3)) { PH_WS pg8::EpiZ E{Z, ZW, SS1, SSQ, SSKV, rope}; run_gemm(lds, X1B, DM, WIN, DM, T, ZW, DM, E, wv, -1, 0, rebal ? 8 : 0x7fffffff); }
    SEAM(3);
    if (IN(4)) { PH_WS
        const int c_ = (int)blockIdx.x;
        if (rebal && c_ < 32) { pg8::EpiZ E{Z, ZW, SS1, SSQ, SSKV, rope}; run_gemm(lds, X1B, DM, WIN, DM, T, ZW, DM, E, wv, 2048 + c_, 256, 1); }
        { pg8::EpiQRope E{Q, QW, rope, SSQ};
          if (!rebal) run_gemm(lds, Z, ZW, WQ, 512, T, QW, 512, E, wv);
          else if (c_ >= 32) run_gemm(lds, Z, ZW, WQ, 512, T, QW, 512, E, wv, c_ - 32, 224, 4);
          else run_gemm(lds, Z, ZW, WQ, 512, T, QW, 512, E, wv, 896 + c_, 32, 2); }
        { pg8::EpiBf16 E{KV, KVW, SSKV, 1.f / 512.f}; run_gemm(lds, Z + 512, ZW, WKV, 512, T, KVW, 512, E, wv); }
    }
    SEAM(4);
    if (IN(5)) { PH_WS
        const int c = blockIdx.x;
        for (int u = c; u < (T / 128) * 8; u += G) gmlp_unit(Z, WSP, b_s, g_v, H, u >> 3, u & 7, (char*)lds_raw, wv);
        for (int u = c; u < 256 + 1024; u += G) {
            int head, row0, krow0, seq;
            if (u < 256) { head = u & 7; row0 = (u >> 3) * 256; krow0 = 0; seq = TP; }
            else { const int v = u - 256; head = v & 7; const int idx = v >> 3; const int sq = idx >> 3, qb = idx & 7; krow0 = TP + sq * 2048; row0 = krow0 + qb * 256; seq = 2048; }
            __syncthreads();
            att::attn_dense_body(Q + (size_t)row0 * QW + head * 192, KV + (size_t)krow0 * KVW + head * 256, Z + (size_t)krow0 * ZW + Z_KR, KV + (size_t)krow0 * KVW + head * 256 + 128,
                                 H + (size_t)row0 * DM + head * 128, seq, (char*)lds_raw, wv);
        }
    }
    SEAM(5);
    if (IN(6)) { PH_WS LANE_INIT for (int m = gw; m < T; m += NGW) onorm_row(H + (size_t)m * DM, g_out_attn, g_out_gmlp, lane); }
    SEAM(6);
    if (IN(7)) { PH_WS pg8::EpiResid<true, false, 2, false, false, true, false> E{X1B, nullptr, DM, X2B, nullptr, nullptr, nullptr, 1.f}; run_gemm(lds, H, DM, WOUT, DM, T, DM, DM, E, wv); }
    SEAM(7);
    { PH_WS LANE_INIT for (int m = gw; m < T; m += NGW) bf16_row_to_i8(X2B + (size_t)m * DM, (unsigned char*)H + (size_t)m * DM, RS2 + m, lane); }
    SEAM(7);
    if (IN(8)) { PH_WS pg8::EpiSwiGLU<FP8_DOWN2 != 0> E{ACT, DFF, RS2, CM + 2 * DFF, CM + 3 * DFF, 1.f / 127.f}; run_gemm<pg8::EpiSwiGLU<FP8_DOWN2 != 0>, 2>(lds, H, DM, W2U, DM, T, 2 * DFF, DM, E, wv); }
    SEAM(8);
    if (IN(9)) { PH_WS pg8::EpiResid<true, false, 1, true, FP8_DOWN2 != 0, true, false> E{X2B, nullptr, DM, H2, SS3, nullptr, CM + 4 * DFF, 1.f / (W8MAX * ACT8SCALE)}; run_gemm<pg8::EpiResid<true, false, 1, true, FP8_DOWN2 != 0, true, false>, FP8_DOWN2 ? 1 : 0>(lds, ACT, DFF, W2D, DFF, T, DM, DFF, E, wv); }
    SEAM(9);
    if (IN(10)) {
        PH_WS LANE_INIT
        for (int m = gw; m < T; m += NGW) { const u32x4* hr = (const u32x4*)(H2 + (size_t)m * DM) + lane; f32x4* xr = (f32x4*)(X + (size_t)m * DM); const float rs = __builtin_amdgcn_rsqf(pg8::ss_get(SS3 + m) * (1.f / DM) + EPS);
            u32x4 w[4];
#pragma unroll
            for (int j = 0; j < 4; ++j) w[j] = hr[64 * j];
#pragma unroll
            for (int j = 0; j < 4; ++j) { float f[8]; unpack8(w[j], f); const int c8 = (lane + 64 * j) * 2; const f32x4 g0 = ((const f32x4*)g_final)[c8], g1 = ((const f32x4*)g_final)[c8 + 1];
                xr[c8] = (f32x4){f[0] * rs * g0.x, f[1] * rs * g0.y, f[2] * rs * g0.z, f[3] * rs * g0.w}; xr[c8 + 1] = (f32x4){f[4] * rs * g1.x, f[5] * rs * g1.y, f[6] * rs * g1.z, f[7] * rs * g1.w}; } }
    }
#undef IN
#undef SEAM
}

extern "C" void kernel_launch(void* const* d_in, const int* in_sizes, int n_in, void* d_out, int out_size, void* d_ws, size_t ws_size, hipStream_t stream) {
    static int grid = 0;
    if (grid == 0) {
        if (n_in != 23 || out_size != T * DM || ws_size < WS_END) { fprintf(stderr, "kernel_launch: unexpected shapes: n_in %d out %d ws %zu\n", n_in, out_size, ws_size); grid = -1; return; }
        int dev = 0, cus = 0, per_cu = 0;
        if (hipGetDevice(&dev) != hipSuccess || hipDeviceGetAttribute(&cus, hipDeviceAttributeMultiprocessorCount, dev) != hipSuccess) { grid = -1; return; }
        if (hipFuncSetAttribute((const void*)mk_fwd, hipFuncAttributeMaxDynamicSharedMemorySize, LDS_BYTES) != hipSuccess) { fprintf(stderr, "kernel_launch: hipFuncSetAttribute failed\n"); grid = -1; return; }
        if (hipOccupancyMaxActiveBlocksPerMultiprocessor(&per_cu, (const void*)mk_fwd, 512, LDS_BYTES) != hipSuccess || per_cu < 1) { fprintf(stderr, "kernel_launch: occupancy query says %d\n", per_cu); per_cu = 1; }
        (void)hipGetLastError();
        grid = cus * per_cu;
    }
    if (grid < 0) return;
    if (hipMemsetAsync((char*)d_ws + WS_CM, 0, CM_BYTES, stream) != hipSuccess) { fprintf(stderr, "kernel_launch: hipMemsetAsync failed\n"); return; }
    Args a{};
    for (int i = 0; i < 23; ++i) a.in[i] = (const float*)d_in[i];
    a.out = (float*)d_out; a.ws = (unsigned char*)d_ws;
    a.ph_lo = 0; a.ph_hi = NPHASE;
    void* kargs[] = {&a};
    hipError_t e = hipLaunchCooperativeKernel((const void*)mk_fwd, dim3(grid), dim3(512), kargs, LDS_BYTES, stream);
    if (e != hipSuccess) fprintf(stderr, "cooperative launch failed: %s (grid %d)\n", hipGetErrorString(e), grid);
}
```

```cpp
#include <hip/hip_runtime.h>
#include <hip/hip_cooperative_groups.h>
#include <cstdio>
#include <cstdint>
namespace cg = cooperative_groups;

#ifndef FP8_FFN1
#define FP8_FFN1 0
#endif
#ifndef FP8_FFN2
#define FP8_FFN2 1
#endif
constexpr float W8SCALE = 32.f;
#ifndef FP8_DOWN2
#define FP8_DOWN2 1
#endif
constexpr float ACT8SCALE = 8.f, W8MAX = 256.f;
#ifndef MK_ONE_LAUNCH
#define MK_ONE_LAUNCH 1
#endif

__device__ __forceinline__ int tid_of(int wv) { int l; asm volatile("v_mbcnt_lo_u32_b32 %0, -1, 0\n\tv_mbcnt_hi_u32_b32 %0, -1, %0" : "=v"(l)); return wv * 64 + l; }
template <int MASK> __device__ __forceinline__ float xor_get(float v) { return __int_as_float(__builtin_amdgcn_ds_swizzle(__float_as_int(v), 0x1F | (MASK << 10))); }
__device__ __forceinline__ float xor32_sum(float v) { auto rr = __builtin_amdgcn_permlane32_swap(__float_as_uint(v), __float_as_uint(v), false, false); return __uint_as_float(rr[0]) + __uint_as_float(rr[1]); }
namespace pg8 {
#define PG8_LAS __attribute__((address_space(3)))
typedef unsigned short bf16_t;
typedef short bf16x8 __attribute__((ext_vector_type(8)));
typedef float f32x4 __attribute__((ext_vector_type(4)));
typedef unsigned u32x4 __attribute__((ext_vector_type(4)));
constexpr int BM = 256, BK = 64, HALF = 128, HTB = HALF * BK * 2, STAGE_BYTES = 8 * HTB, NXCD = 8, WGM = 4;

__host__ __device__ __forceinline__ int lds_byte(int r, int c) { const int st = (r >> 4) * 2 + (c >> 5), rr = r & 15, cc = c & 31, ob = rr * 64 + cc * 2; return st * 1024 + (ob ^ (((ob >> 9) & 1) << 5)); }
__host__ __device__ __forceinline__ void stage_rc(int b, int& R, int& C) { const int st = b / 1024, sb = b % 1024, swz = sb ^ (((sb >> 9) & 1) << 5); R = (st >> 1) * 16 + swz / 64; C = (st & 1) * 32 + (swz % 64) / 2; }
__host__ __device__ __forceinline__ int perm32(int rho) { const int n = rho >> 4, i = rho & 15; return 8 * (i >> 2) + 4 * n + (i & 3); }

typedef unsigned long long u64;
constexpr float SSFIX = 1048576.f;
__device__ __forceinline__ float ss_get(const u64* p) { return (float)(*p) * (1.f / SSFIX); }
__device__ __forceinline__ void ss_add(u64* p, float v) { atomicAdd(p, (u64)(v * SSFIX)); }
struct Unit { int pm, pn; };
struct Gemm { const void* A; const void* Bt; int M, N, K, lda, ldb; };
typedef int i32x4 __attribute__((ext_vector_type(4)));
typedef int i32x8 __attribute__((ext_vector_type(8)));
__device__ __forceinline__ i32x8 cat8(bf16x8 lo, bf16x8 hi) { return __builtin_shufflevector(__builtin_bit_cast(i32x4, lo), __builtin_bit_cast(i32x4, hi), 0, 1, 2, 3, 4, 5, 6, 7); }

struct StaticOrder {
    int nM, nN, nwg, G, c, base, stride, cnt;
    __host__ __device__ void init(int M, int N, int G_, int c_) { nM = M / BM; nN = N / BM; nwg = nM * nN; G = G_; c = c_; base = c_; stride = G_; cnt = 0x7fffffff; }
    __host__ __device__ bool next(int i, Unit& u) const {
        if (i >= cnt) return false;
        const long L = (long)i * stride + base; if (L >= nwg) return false;
        int wgid = (int)L; { const int q = nwg / NXCD, r = nwg % NXCD, xcd = wgid % NXCD, off = wgid / NXCD; wgid = (xcd < r ? xcd * (q + 1) : r * (q + 1) + (xcd - r) * q) + off; }
        const int nig = WGM * nN, gid = wgid / nig, fm = gid * WGM, gsz = (nM - fm) < WGM ? (nM - fm) : WGM;
        u.pm = fm + ((wgid % nig) % gsz); u.pn = (wgid % nig) / gsz; return true;
    }
    __device__ __forceinline__ void a_ready(const Unit&) const {}
    __device__ __forceinline__ void done(const Unit&) const {}
};

__device__ __forceinline__ unsigned cvt_pk_bf16(float lo, float hi) { unsigned r; asm volatile("v_cvt_pk_bf16_f32 %0, %1, %2" : "=v"(r) : "v"(lo), "v"(hi)); return r; }

struct EpiBf16 {
    static constexpr bool PERM = true, AFTER_DRAIN = false;
    bf16_t* O; int ldc; const u64* ss; float inv_n;
    __device__ __forceinline__ void operator()(const f32x4 (&acc)[2][2][4][2], const Unit& u, int wr, int wc, int fr, int fq) const {
        const int row0 = u.pm * BM + wr * 64 + fr; const int col0 = u.pn * BM + wc * 32 + 8 * fq;
#pragma unroll
        for (int ai = 0; ai < 2; ++ai)
#pragma unroll
            for (int m = 0; m < 4; ++m) { const int row = row0 + ai * HALF + m * 16; bf16_t* rowp = O + (size_t)row * ldc + col0;
                const float rs = ss ? __builtin_amdgcn_rsqf(ss_get(ss + row) * inv_n + 1e-6f) : 1.f;
#pragma unroll
                for (int bj = 0; bj < 2; ++bj) { const f32x4 v0 = acc[ai][bj][m][0] * rs, v1 = acc[ai][bj][m][1] * rs;
                    u32x4 w; w.x = cvt_pk_bf16(v0[0], v0[1]); w.y = cvt_pk_bf16(v0[2], v0[3]); w.z = cvt_pk_bf16(v1[0], v1[1]); w.w = cvt_pk_bf16(v1[2], v1[3]);
                    *(u32x4*)(rowp + bj * HALF) = w; } }
    }
};
__device__ __forceinline__ float gelu_t(float x) { const float t = -2.302208198f * (x + 0.044715f * x * x * x); return x * __builtin_amdgcn_rcpf(1.0f + __builtin_amdgcn_exp2f(t)); }
__device__ __forceinline__ void rope8(f32x4& v0, f32x4& v1, const float* rp, int i0) {
    const f32x4 cs = *(const f32x4*)(rp + i0), sn = *(const f32x4*)(rp + 32 + i0);
    f32x4 a, b; a[0] = v0[0] * cs[0] - v0[1] * sn[0]; a[1] = v0[0] * sn[0] + v0[1] * cs[0]; a[2] = v0[2] * cs[1] - v0[3] * sn[1]; a[3] = v0[2] * sn[1] + v0[3] * cs[1];
    b[0] = v1[0] * cs[2] - v1[1] * sn[2]; b[1] = v1[0] * sn[2] + v1[1] * cs[2]; b[2] = v1[2] * cs[3] - v1[3] * sn[3]; b[3] = v1[2] * sn[3] + v1[3] * cs[3]; v0 = a; v1 = b;
}
struct EpiZ {
    static constexpr bool PERM = true, AFTER_DRAIN = false;
    bf16_t* O; int ldc; const u64* ssx; u64* ssq; u64* sskv; const float* rope;
    __device__ __forceinline__ void operator()(const f32x4 (&acc)[2][2][4][2], const Unit& u, int wr, int wc, int fr, int fq) const {
        const int row0 = u.pm * BM + wr * 64 + fr; const int col0 = u.pn * BM + wc * 32 + 8 * fq; const int pn = u.pn;
#pragma unroll
        for (int ai = 0; ai < 2; ++ai)
#pragma unroll
            for (int m = 0; m < 4; ++m) { const int row = row0 + ai * HALF + m * 16; bf16_t* rowp = O + (size_t)row * ldc + col0;
                const float rs = __builtin_amdgcn_rsqf(ss_get(ssx + row) * (1.f / 2048.f) + 1e-6f); float sq = 0.f;
#pragma unroll
                for (int bj = 0; bj < 2; ++bj) { f32x4 v0 = acc[ai][bj][m][0] * rs, v1 = acc[ai][bj][m][1] * rs;
                    if (pn < 4) { sq += (v0[0] * v0[0] + v0[1] * v0[1]) + (v0[2] * v0[2] + v0[3] * v0[3]) + (v1[0] * v1[0] + v1[1] * v1[1]) + (v1[2] * v1[2] + v1[3] * v1[3]); }
                    else if (pn == 4) { if (bj == 0 && wc < 2) { const int pos = row < 8192 ? row : (row & 2047); rope8(v0, v1, rope + (size_t)pos * 64, (wc * 32 + 8 * fq) >> 1); } }
                    else {
#pragma unroll
                        for (int e = 0; e < 4; ++e) { v0[e] = gelu_t(v0[e]); v1[e] = gelu_t(v1[e]); } }
                    u32x4 w; w.x = cvt_pk_bf16(v0[0], v0[1]); w.y = cvt_pk_bf16(v0[2], v0[3]); w.z = cvt_pk_bf16(v1[0], v1[1]); w.w = cvt_pk_bf16(v1[2], v1[3]);
                    *(u32x4*)(rowp + bj * HALF) = w; }
                if (pn < 4) { sq += xor_get<16>(sq); sq = xor32_sum(sq); if (fq == 0) ss_add((pn < 2 ? ssq : sskv) + row, sq); } }
    }
};
struct EpiQRope {
    static constexpr bool PERM = true, AFTER_DRAIN = false;
    bf16_t* O; int ldc; const float* rope; const u64* ss;
    __device__ __forceinline__ void operator()(const f32x4 (&acc)[2][2][4][2], const Unit& u, int wr, int wc, int fr, int fq) const {
        const int row0 = u.pm * BM + wr * 64 + fr; const int col0 = u.pn * BM + wc * 32 + 8 * fq;
#pragma unroll
        for (int ai = 0; ai < 2; ++ai)
#pragma unroll
            for (int m = 0; m < 4; ++m) { const int row = row0 + ai * HALF + m * 16; bf16_t* rowp = O + (size_t)row * ldc + col0;
                const int pos = row < 8192 ? row : (row & 2047); const float rs = __builtin_amdgcn_rsqf(ss_get(ss + row) * (1.f / 512.f) + 1e-6f);
#pragma unroll
                for (int bj = 0; bj < 2; ++bj) { f32x4 v0 = acc[ai][bj][m][0] * rs, v1 = acc[ai][bj][m][1] * rs;
                    const int c = col0 + bj * HALF; const int d = c % 192;
                    if (d >= 128) rope8(v0, v1, rope + (size_t)pos * 64, (d - 128) >> 1);
                    u32x4 w; w.x = cvt_pk_bf16(v0[0], v0[1]); w.y = cvt_pk_bf16(v0[2], v0[3]); w.z = cvt_pk_bf16(v1[0], v1[1]); w.w = cvt_pk_bf16(v1[2], v1[3]);
                    *(u32x4*)(rowp + bj * HALF) = w; } }
    }
};
template <bool OUT8 = false> struct EpiSwiGLU {
    static constexpr bool PERM = true, AFTER_DRAIN = false;
    bf16_t* O; int ldc; const float* rsc; const float* cmg; const float* cmu; float cscale;
    __device__ __forceinline__ void operator()(const f32x4 (&acc)[2][2][4][2], const Unit& u, int wr, int wc, int fr, int fq) const {
        const int row0 = u.pm * BM + wr * 64 + fr; const int col0 = u.pn * HALF + wc * 32 + 8 * fq;
        f32x4 sg[2], su[2];
#pragma unroll
        for (int n = 0; n < 2; ++n) { sg[n] = cmg ? *(const f32x4*)(cmg + col0 + 4 * n) * cscale : (f32x4){1.f, 1.f, 1.f, 1.f}; su[n] = cmu ? *(const f32x4*)(cmu + col0 + 4 * n) * cscale : (f32x4){1.f, 1.f, 1.f, 1.f}; }
#pragma unroll
        for (int ai = 0; ai < 2; ++ai)
#pragma unroll
            for (int m = 0; m < 4; ++m) { const int row = row0 + ai * HALF + m * 16; bf16_t* rowp = O + (size_t)row * ldc + col0;
                const float rs = rsc ? rsc[row] : 1.f;
                f32x4 r[2];
#pragma unroll
                for (int n = 0; n < 2; ++n) { const f32x4 g = acc[ai][0][m][n] * sg[n] * rs, up = acc[ai][1][m][n] * su[n] * rs;
#pragma unroll
                    for (int e = 0; e < 4; ++e) { const float sgm = __builtin_amdgcn_rcpf(1.0f + __builtin_amdgcn_exp2f(-1.4426950408889634f * g[e])); r[n][e] = g[e] * sgm * up[e]; } }
                if constexpr (OUT8) { typedef unsigned u32x2v __attribute__((ext_vector_type(2))); _Pragma("unroll") for (int e = 0; e < 4; ++e) { r[0][e] = __builtin_amdgcn_fmed3f(r[0][e] * ACT8SCALE, -448.f, 448.f); r[1][e] = __builtin_amdgcn_fmed3f(r[1][e] * ACT8SCALE, -448.f, 448.f); }

                    int w0 = __builtin_amdgcn_cvt_pk_fp8_f32(r[0][0], r[0][1], 0, false); w0 = __builtin_amdgcn_cvt_pk_fp8_f32(r[0][2], r[0][3], w0, true);
                    int w1 = __builtin_amdgcn_cvt_pk_fp8_f32(r[1][0], r[1][1], 0, false); w1 = __builtin_amdgcn_cvt_pk_fp8_f32(r[1][2], r[1][3], w1, true);
                    *(u32x2v*)((unsigned char*)O + (size_t)row * ldc + col0) = (u32x2v){(unsigned)w0, (unsigned)w1}; }
                else { u32x4 w; w.x = cvt_pk_bf16(r[0][0], r[0][1]); w.y = cvt_pk_bf16(r[0][2], r[0][3]); w.z = cvt_pk_bf16(r[1][0], r[1][1]); w.w = cvt_pk_bf16(r[1][2], r[1][3]);
                    *(u32x4*)rowp = w; } }
    }
};
template <bool HAS_XB, bool HAS_X8, int ALPHA2, bool HAS_SS = true, bool HAS_CS = false, bool BASE16 = false, bool HAS_OUT = true> struct EpiResid {
    static constexpr bool PERM = false, AFTER_DRAIN = false; static constexpr float alpha = 0.5f * ALPHA2;
    const void* base; float* out; int ldc; bf16_t* xb; u64* ss; unsigned char* x8; const float* cs; float csmul;
    __device__ __forceinline__ void operator()(const f32x4 (&acc)[2][2][4][2], const Unit& u, int wr, int wc, int fr, int fq) const {
        typedef unsigned u32x2v __attribute__((ext_vector_type(2)));
        const int row0 = u.pm * BM + wr * 64 + fr; const int col0 = u.pn * BM + wc * 32 + 4 * fq;
        f32x4 csv[2][2];
#pragma unroll
        for (int bj = 0; bj < 2; ++bj)
#pragma unroll
            for (int n = 0; n < 2; ++n) csv[bj][n] = HAS_CS ? *(const f32x4*)(cs + col0 + bj * HALF + n * 16) * (csmul * alpha) : (f32x4){alpha, alpha, alpha, alpha};
#pragma unroll
        for (int ai = 0; ai < 2; ++ai)
#pragma unroll
            for (int m = 0; m < 4; ++m) { const int row = row0 + ai * HALF + m * 16; const size_t off = (size_t)row * ldc + col0; float sq = 0.f;
#pragma unroll
                for (int bj = 0; bj < 2; ++bj)
#pragma unroll
                    for (int n = 0; n < 2; ++n) { const size_t p = off + bj * HALF + n * 16; f32x4 b;
                        if constexpr (BASE16) { const u32x2v wb = *(const u32x2v*)((const bf16_t*)base + p); b = (f32x4){__uint_as_float(wb.x << 16), __uint_as_float(wb.x & 0xffff0000u), __uint_as_float(wb.y << 16), __uint_as_float(wb.y & 0xffff0000u)}; }
                        else b = *(const f32x4*)((const float*)base + p);
                        const f32x4 v = b + acc[ai][bj][m][n] * csv[bj][n]; if constexpr (HAS_OUT) *(f32x4*)(out + p) = v;
                        if constexpr (HAS_XB) { u32x2v w; w.x = cvt_pk_bf16(v[0], v[1]); w.y = cvt_pk_bf16(v[2], v[3]); *(u32x2v*)(xb + p) = w; }
                        if constexpr (HAS_X8) { int w8 = __builtin_amdgcn_cvt_pk_fp8_f32(v[0], v[1], 0, false); w8 = __builtin_amdgcn_cvt_pk_fp8_f32(v[2], v[3], w8, true); *(int*)(x8 + p) = w8; }
                        sq += (v[0] * v[0] + v[1] * v[1]) + (v[2] * v[2] + v[3] * v[3]); }
                if constexpr (HAS_SS) { sq += xor_get<16>(sq); sq = xor32_sum(sq); if (fq == 0) ss_add(ss + row, sq); } }
    }
};

struct EpiMix {
    static constexpr bool PERM = false, AFTER_DRAIN = false;
    const bf16_t* base; bf16_t* xb; int ldc; const u64* ssa; const u64* ssg;
    __device__ __forceinline__ void mid(f32x4 (&acc)[2][2][4][2], const Unit& u, int wr, int fr) const {
        const int row0 = u.pm * BM + wr * 64 + fr;
#pragma unroll
        for (int ai = 0; ai < 2; ++ai)
#pragma unroll
            for (int m = 0; m < 4; ++m) { const int row = row0 + ai * HALF + m * 16;
                const float ra = __builtin_amdgcn_rsqf(ss_get(ssa + row) * (1.f / 1024.f) + 1e-6f), rg = __builtin_amdgcn_rsqf(ss_get(ssg + row) * (1.f / 1024.f) + 1e-6f);
                const float ratio = ra * __builtin_amdgcn_rcpf(rg);
#pragma unroll
                for (int bj = 0; bj < 2; ++bj)
#pragma unroll
                    for (int n = 0; n < 2; ++n) acc[ai][bj][m][n] = acc[ai][bj][m][n] * ratio; }
    }
    __device__ __forceinline__ void operator()(const f32x4 (&acc)[2][2][4][2], const Unit& u, int wr, int wc, int fr, int fq) const {
        typedef unsigned u32x2v __attribute__((ext_vector_type(2)));
        const int row0 = u.pm * BM + wr * 64 + fr; const int col0 = u.pn * BM + wc * 32 + 4 * fq;
#pragma unroll
        for (int ai = 0; ai < 2; ++ai)
#pragma unroll
            for (int m = 0; m < 4; ++m) { const int row = row0 + ai * HALF + m * 16; const size_t off = (size_t)row * ldc + col0;
                const float rg = __builtin_amdgcn_rsqf(ss_get(ssg + row) * (1.f / 1024.f) + 1e-6f);
#pragma unroll
                for (int bj = 0; bj < 2; ++bj)
#pragma unroll
                    for (int n = 0; n < 2; ++n) { const size_t p = off + bj * HALF + n * 16; const u32x2v wb = *(const u32x2v*)(base + p);
                        const f32x4 b = {__uint_as_float(wb.x << 16), __uint_as_float(wb.x & 0xffff0000u), __uint_as_float(wb.y << 16), __uint_as_float(wb.y & 0xffff0000u)};
                        const f32x4 v = b + acc[ai][bj][m][n] * rg; u32x2v w; w.x = cvt_pk_bf16(v[0], v[1]); w.y = cvt_pk_bf16(v[2], v[3]); *(u32x2v*)(xb + p) = w; } }
    }
};

template <class Epi, class Sched, bool ALIGN_EPI = false, bool SP2 = false, int MODE = 0, bool MID = false>
__device__ __forceinline__ void gemm_phase(PG8_LAS unsigned char* lds, const Gemm g, const Sched S, const Epi E, const int wv) {
    const int tid = tid_of(wv), wid = __builtin_amdgcn_readfirstlane(tid >> 6), lane = tid & 63, wr = wid >> 2, wc = wid & 3, fr = lane & 15, fq = lane >> 4;
    constexpr bool FP8 = MODE == 1, BYTE_ELEMS = MODE != 0; constexpr int ES = BYTE_ELEMS ? 1 : 2;
    const int K = g.K, nt = K * ES / 128;
    unsigned voffA[2], voffB[2];
#pragma unroll
    for (int i = 0; i < 2; ++i) { int R, C; stage_rc(tid * 16 + i * 8192, R, C); const int Rb = Epi::PERM ? ((R & ~31) + perm32(R & 31)) : R;
        voffA[i] = (unsigned)(R * g.lda * ES + C * 2); voffB[i] = (unsigned)(Rb * g.ldb * ES + C * 2); }
    const size_t roffA = (size_t)64 * g.lda * ES, roffB = (size_t)64 * g.ldb * ES;
    const size_t kstep = (size_t)(BK * 2);
    const size_t hstepA = (size_t)HALF * g.lda * ES, hstepB = (size_t)HALF * g.ldb * ES;
    const size_t tstepA = 2 * hstepA, tstepB = 2 * hstepB;
    const unsigned ldsw = (unsigned)wid * 1024u;
    const int aoff = lds_byte(wr * 64 + fr, fq * 8), boff = lds_byte(wc * 32 + fr, fq * 8);
#define PG8_SA(b, h) (((b) * 2 + (h)) * HTB)
#define PG8_SB(b, h) ((4 + (b) * 2 + (h)) * HTB)
#define PG8_STAGE(bufoff, gbase, voff) do { _Pragma("unroll") for (int _i = 0; _i < 2; ++_i) \
        __builtin_amdgcn_global_load_lds((const unsigned*)((const char*)(gbase) + (BYTE_ELEMS ? _i * r##voff + (v##voff)[0] : (v##voff)[_i])), (PG8_LAS unsigned*)(lds + (bufoff) + ldsw + _i * 8192), 16, 0, 0); } while (0)
#define PG8_LDA(dst, b, h) do { _Pragma("unroll") for (int m = 0; m < 4; ++m) _Pragma("unroll") for (int k = 0; k < 2; ++k) dst[m][k] = *(const PG8_LAS bf16x8*)(lds + PG8_SA(b, h) + aoff + m * 2048 + k * 1024); } while (0)
#define PG8_LDB(dst, b, h) do { _Pragma("unroll") for (int n = 0; n < 2; ++n) _Pragma("unroll") for (int k = 0; k < 2; ++k) dst[n][k] = *(const PG8_LAS bf16x8*)(lds + PG8_SB(b, h) + boff + n * 2048 + k * 1024); } while (0)
#define PG8_MMA(ai, bj, At, Bt) do { __builtin_amdgcn_s_setprio(1); if constexpr (FP8) { _Pragma("unroll") for (int m = 0; m < 4; ++m) _Pragma("unroll") for (int n = 0; n < 2; ++n) \
        acc[ai][bj][m][n] = __builtin_amdgcn_mfma_scale_f32_16x16x128_f8f6f4(cat8(Bt[n][0], Bt[n][1]), cat8(At[m][0], At[m][1]), acc[ai][bj][m][n], 0, 0, 0, 0, 0, 0); } \
      else if constexpr (MODE == 2) { _Pragma("unroll") for (int m = 0; m < 4; ++m) _Pragma("unroll") for (int n = 0; n < 2; ++n) _Pragma("unroll") for (int k = 0; k < 2; ++k) \
        acc[ai][bj][m][n] = __builtin_bit_cast(f32x4, __builtin_amdgcn_mfma_i32_16x16x64_i8(__builtin_bit_cast(i32x4, Bt[n][k]), __builtin_bit_cast(i32x4, At[m][k]), __builtin_bit_cast(i32x4, acc[ai][bj][m][n]), 0, 0, 0)); } \
      else { _Pragma("unroll") for (int m = 0; m < 4; ++m) _Pragma("unroll") for (int n = 0; n < 2; ++n) _Pragma("unroll") for (int k = 0; k < 2; ++k) \
        acc[ai][bj][m][n] = __builtin_amdgcn_mfma_f32_16x16x32_bf16(Bt[n][k], At[m][k], acc[ai][bj][m][n], 0, 0, 0); } __builtin_amdgcn_s_setprio(0); } while (0)
#define PG8_WAIT_V(n) asm volatile("s_waitcnt vmcnt(" #n ")" ::: "memory")
#define PG8_WAIT_L(n) asm volatile("s_waitcnt lgkmcnt(" #n ")" ::: "memory")
#define PG8_BAR __builtin_amdgcn_s_barrier()
#define PG8_SCHED __builtin_amdgcn_sched_barrier(0)
    Unit cur, nxt; int ui = 0;
    if (!S.next(0, cur)) return;
    f32x4 acc[2][2][4][2];
#pragma unroll
    for (int a = 0; a < 2; ++a)
#pragma unroll
        for (int b = 0; b < 2; ++b)
#pragma unroll
            for (int m = 0; m < 4; ++m)
#pragma unroll
                for (int n = 0; n < 2; ++n) acc[a][b][m][n] = (f32x4){0.f, 0.f, 0.f, 0.f};
    bf16x8 At[4][2], B0[2][2], B1[2][2];
    const char* cA = (const char*)g.A + (size_t)cur.pm * tstepA; const char* cB = (const char*)g.Bt + (size_t)cur.pn * tstepB;
    S.a_ready(cur);
    if constexpr (SP2) {
        PG8_STAGE(PG8_SB(0, 0), cB, offB); PG8_STAGE(PG8_SB(0, 1), cB + hstepB, offB); PG8_STAGE(PG8_SA(0, 0), cA, offA); PG8_STAGE(PG8_SA(0, 1), cA + hstepA, offA);
        if (wr == 1) PG8_BAR;
        PG8_WAIT_V(2); PG8_BAR;
        PG8_STAGE(PG8_SB(1, 0), cB + kstep, offB); PG8_STAGE(PG8_SA(1, 0), cA + kstep, offA); PG8_STAGE(PG8_SB(1, 1), cB + hstepB + kstep, offB);
        PG8_WAIT_V(6); PG8_BAR;
    } else {
        PG8_STAGE(PG8_SB(0, 0), cB, offB); PG8_STAGE(PG8_SA(0, 0), cA, offA); PG8_STAGE(PG8_SB(0, 1), cB + hstepB, offB); PG8_STAGE(PG8_SA(0, 1), cA + hstepA, offA);
        if (wr == 1) PG8_BAR;
        PG8_WAIT_V(4); PG8_BAR;
        PG8_STAGE(PG8_SB(1, 0), cB + kstep, offB); PG8_STAGE(PG8_SA(1, 0), cA + kstep, offA); PG8_STAGE(PG8_SB(1, 1), cB + hstepB + kstep, offB);
        PG8_WAIT_V(6); PG8_BAR;
    }
    for (;;) {
        const bool has_next = S.next(ui + 1, nxt);
        const char* nA = has_next ? (const char*)g.A + (size_t)nxt.pm * tstepA : cA; const char* nB = has_next ? (const char*)g.Bt + (size_t)nxt.pn * tstepB : cB;
        for (int t = 0; t < nt; t += 2) {
            const bool last = (t == nt - 2);
            const char* a1 = cA + (size_t)(t + 1) * kstep;
            const char* a2 = last ? nA : cA + (size_t)(t + 2) * kstep; const char* b2 = last ? nB : cB + (size_t)(t + 2) * kstep;
            const char* a3 = a2 + kstep; const char* b3 = b2 + kstep;
            if (last && has_next) S.a_ready(nxt);
            if constexpr (MID) { if (t == nt / 2) { const int t3 = tid_of(wv); E.mid(acc, cur, wid >> 2, t3 & 15); } }
            if constexpr (SP2) {
            PG8_LDB(B0, 0, 0); PG8_LDB(B1, 0, 1); PG8_SCHED; PG8_LDA(At, 0, 0); PG8_STAGE(PG8_SA(1, 1), a1 + hstepA, offA);
            PG8_WAIT_V(8); PG8_WAIT_L(0); PG8_BAR; PG8_MMA(0, 0, At, B0); PG8_MMA(0, 1, At, B1); PG8_BAR; PG8_SCHED;
            PG8_LDA(At, 0, 1); PG8_STAGE(PG8_SB(0, 0), b2, offB); PG8_STAGE(PG8_SB(0, 1), b2 + hstepB, offB); PG8_STAGE(PG8_SA(0, 0), a2, offA);
            PG8_WAIT_V(8); PG8_WAIT_L(0); PG8_BAR; PG8_MMA(1, 0, At, B0); PG8_MMA(1, 1, At, B1); PG8_BAR; PG8_SCHED;
            PG8_LDB(B0, 1, 0); PG8_LDB(B1, 1, 1); PG8_SCHED; PG8_LDA(At, 1, 0); PG8_STAGE(PG8_SA(0, 1), a2 + hstepA, offA);
            PG8_WAIT_V(8); PG8_WAIT_L(0); PG8_BAR; PG8_MMA(0, 0, At, B0); PG8_MMA(0, 1, At, B1); PG8_BAR; PG8_SCHED;
            PG8_LDA(At, 1, 1); PG8_STAGE(PG8_SB(1, 0), b3, offB); PG8_STAGE(PG8_SB(1, 1), b3 + hstepB, offB); PG8_STAGE(PG8_SA(1, 0), a3, offA);
            PG8_WAIT_V(8); PG8_WAIT_L(0); PG8_BAR; PG8_MMA(1, 0, At, B0); PG8_MMA(1, 1, At, B1); PG8_BAR; PG8_SCHED;
            } else {
            PG8_LDB(B0, 0, 0); PG8_SCHED; PG8_LDA(At, 0, 0); PG8_STAGE(PG8_SA(1, 1), a1 + hstepA, offA);
            PG8_WAIT_L(8); PG8_BAR; PG8_WAIT_L(0); PG8_MMA(0, 0, At, B0); PG8_BAR; PG8_SCHED;
            PG8_LDB(B1, 0, 1); PG8_STAGE(PG8_SB(0, 0), b2, offB);
            PG8_BAR; PG8_WAIT_L(0); PG8_MMA(0, 1, At, B1); PG8_BAR;
            PG8_LDA(At, 0, 1); PG8_STAGE(PG8_SA(0, 0), a2, offA);
            PG8_BAR; PG8_WAIT_L(0); PG8_MMA(1, 0, At, B0); PG8_BAR; PG8_SCHED;
            PG8_STAGE(PG8_SB(0, 1), b2 + hstepB, offB);
            PG8_WAIT_V(6); PG8_BAR; PG8_MMA(1, 1, At, B1); PG8_BAR;
            PG8_LDB(B0, 1, 0); PG8_SCHED; PG8_LDA(At, 1, 0); PG8_STAGE(PG8_SA(0, 1), a2 + hstepA, offA);
            PG8_WAIT_L(8); PG8_BAR; PG8_WAIT_L(0); PG8_MMA(0, 0, At, B0); PG8_BAR; PG8_SCHED;
            PG8_LDB(B1, 1, 1); PG8_STAGE(PG8_SB(1, 0), b3, offB);
            PG8_BAR; PG8_WAIT_L(0); PG8_MMA(0, 1, At, B1); PG8_BAR;
            PG8_LDA(At, 1, 1); PG8_STAGE(PG8_SA(1, 0), a3, offA);
            PG8_BAR; PG8_WAIT_L(0); PG8_MMA(1, 0, At, B0); PG8_BAR; PG8_SCHED;
            PG8_STAGE(PG8_SB(1, 1), b3 + hstepB, offB);
            PG8_WAIT_V(6); PG8_BAR; PG8_MMA(1, 1, At, B1); PG8_BAR;
            }
        }
        if constexpr (ALIGN_EPI) { if (wr == 0) PG8_BAR; }
        if constexpr (MODE == 2) {
#pragma unroll
            for (int a = 0; a < 2; ++a)
#pragma unroll
                for (int b = 0; b < 2; ++b)
#pragma unroll
                    for (int m = 0; m < 4; ++m)
#pragma unroll
                        for (int n = 0; n < 2; ++n) { const i32x4 iv = __builtin_bit_cast(i32x4, acc[a][b][m][n]); acc[a][b][m][n] = (f32x4){(float)iv[0], (float)iv[1], (float)iv[2], (float)iv[3]}; } }
        if constexpr (!Epi::AFTER_DRAIN) { const int t2 = tid_of(wv), l2 = t2 & 63; E(acc, cur, wid >> 2, wid & 3, l2 & 15, l2 >> 4); S.done(cur); }
        if (!has_next) break;
#pragma unroll
        for (int a = 0; a < 2; ++a)
#pragma unroll
            for (int b = 0; b < 2; ++b)
#pragma unroll
                for (int m = 0; m < 4; ++m)
#pragma unroll
                    for (int n = 0; n < 2; ++n) acc[a][b][m][n] = (f32x4){0.f, 0.f, 0.f, 0.f};
        cur = nxt; cA = nA; cB = nB; ++ui;
        if constexpr (ALIGN_EPI) { if (wr == 1) PG8_BAR; }
    }
    PG8_WAIT_V(0);
    if constexpr (!ALIGN_EPI) { if (wr == 0) PG8_BAR; }
    PG8_BAR;
#undef PG8_SA
#undef PG8_SB
#undef PG8_STAGE
#undef PG8_LDA
#undef PG8_LDB
#undef PG8_MMA
#undef PG8_WAIT_V
#undef PG8_WAIT_L
#undef PG8_BAR
#undef PG8_SCHED
}
}

typedef unsigned short bf16;
typedef float f32x4 __attribute__((ext_vector_type(4)));
typedef unsigned u32x4 __attribute__((ext_vector_type(4)));
typedef unsigned u32x2 __attribute__((ext_vector_type(2)));
typedef short bf16x8 __attribute__((ext_vector_type(8)));
typedef short s16x4 __attribute__((ext_vector_type(4)));
typedef float f32x16 __attribute__((ext_vector_type(16)));
#define LAS __attribute__((address_space(3)))

constexpr int DM = 2048, DFF = 5632, TP = 8192, TS = 16 * 2048, T = TP + TS;
constexpr int ZW = 3328;
constexpr int Z_KR = 1024, Z_U = 1280, Z_V = 2304;
constexpr int QW = 1536, KVW = 2048;
constexpr float EPS = 1e-6f;
constexpr size_t MiB = 1u << 20;
constexpr size_t WS_ROPE = 1 * MiB;
constexpr size_t WS_W1U = 4 * MiB, WS_W1D = WS_W1U + 44 * MiB, WS_W2U = WS_W1D + 22 * MiB, WS_W2D = WS_W2U + 44 * MiB, WS_WIN = WS_W2D + 22 * MiB;
constexpr size_t WS_WQ = WS_WIN + 13 * MiB, WS_WKV = WS_WQ + 2 * MiB, WS_WOUT = WS_WKV + 2 * MiB, WS_WSP = WS_WOUT + 8 * MiB;
constexpr size_t WS_H = 162 * MiB;
constexpr size_t WS_ACT = 322 * MiB;
constexpr size_t WS_Z = 322 * MiB, WS_Q = 582 * MiB, WS_KV = 702 * MiB;
constexpr size_t WS_H2 = 762 * MiB, WS_SS = 922 * MiB, WS_END = 924 * MiB;
constexpr size_t WS_CM = 64 * 1024, CM_BYTES = (4 * 5632 + 2048) * 4;
constexpr size_t WS_RS = 256 * 1024;
static_assert(WS_WSP + 262144 <= WS_H, "weights fit");
constexpr int LDS_BYTES = 147456;
constexpr int NPHASE = 13;

__device__ __forceinline__ float bf_lo(unsigned w) { return __uint_as_float(w << 16); }
__device__ __forceinline__ float bf_hi(unsigned w) { return __uint_as_float(w & 0xffff0000u); }
__device__ __forceinline__ unsigned pk2(float lo, float hi) { return pg8::cvt_pk_bf16(lo, hi); }
__device__ __forceinline__ void unpack8(const u32x4 w, float (&f)[8]) { f[0] = bf_lo(w.x); f[1] = bf_hi(w.x); f[2] = bf_lo(w.y); f[3] = bf_hi(w.y); f[4] = bf_lo(w.z); f[5] = bf_hi(w.z); f[6] = bf_lo(w.w); f[7] = bf_hi(w.w); }
__device__ __forceinline__ u32x4 pack8(const float (&f)[8]) { u32x4 w; w.x = pk2(f[0], f[1]); w.y = pk2(f[2], f[3]); w.z = pk2(f[4], f[5]); w.w = pk2(f[6], f[7]); return w; }
__device__ __forceinline__ float wave_sum(float v) { v += xor_get<1>(v); v += xor_get<2>(v); v += xor_get<4>(v); v += xor_get<8>(v); v += xor_get<16>(v); return xor32_sum(v); }
__device__ __forceinline__ float gelu_tanh(float x) {
    const float t = -2.302208198f * (x + 0.044715f * x * x * x);
    return x * __builtin_amdgcn_rcpf(1.0f + __builtin_amdgcn_exp2f(t));
}

__constant__ double c_inv_rev[32] = {0.15915494309189535, 0.11934937021124886, 0.08949940160889101, 0.06711508300522726, 0.050329212104487035, 0.03774158471741977, 0.0283021958306234, 0.02122365276477766, 0.015915494309189534, 0.011934937021124886, 0.008949940160889102, 0.006711508300522725, 0.005032921210448704, 0.003774158471741977, 0.00283021958306234, 0.0021223652764777662, 0.0015915494309189536, 0.0011934937021124885, 0.0008949940160889102, 0.0006711508300522726, 0.0005032921210448703, 0.00037741584717419774, 0.00028302195830623395, 0.0002122365276477766, 0.00015915494309189535, 0.00011934937021124886, 8.949940160889102e-05, 6.711508300522725e-05, 5.0329212104487035e-05, 3.774158471741978e-05, 2.8302195830623396e-05, 2.122365276477766e-05};

__device__ __forceinline__ int dst_row(int mode, int n) {
    if (mode == 1) return ((n >> 7) << 8) + (n & 127);
    if (mode == 2) return ((n >> 7) << 8) + 128 + (n & 127);
    if (mode == 3) { if (n < 1024) return n; if (n < 1088) { const int j = n - 1024; return 1024 + (j < 32 ? 2 * j : 2 * (j - 32) + 1); } return n + 192; }
    if (mode == 4) { const int h = n / 192, d = n - h * 192; if (d < 128) return n; const int j = d - 128; return h * 192 + 128 + (j < 32 ? 2 * j : 2 * (j - 32) + 1); }
    return n;
}
__device__ __forceinline__ void p0_transpose_item(const float* W, int K, int N, bf16* WT, int mode, LAS float* scr, int item, int lane, const float* gk = nullptr) {
    const int nblk = N / 64, kb = item / nblk, nb = item % nblk, k0 = 64 * kb, n0 = 64 * nb;
    const int lr = lane >> 4, lc = (lane & 15) * 4;
#pragma unroll 4
    for (int i = 0; i < 16; ++i) { const int kk = 4 * i + lr; f32x4 v = *(const f32x4*)(W + (size_t)(k0 + kk) * N + n0 + lc); if (gk) v = v * gk[k0 + kk];
        LAS float* d = scr + kk * 65 + lc; d[0] = v.x; d[1] = v.y; d[2] = v.z; d[3] = v.w; }
    asm volatile("s_waitcnt lgkmcnt(0)" ::: "memory");
    const int c = lane & 7;
#pragma unroll
    for (int j = 0; j < 8; ++j) { const int n = (lane >> 3) + 8 * j; const LAS float* sp = scr + (8 * c) * 65 + n;
        u32x4 o; o.x = pk2(sp[0 * 65], sp[1 * 65]); o.y = pk2(sp[2 * 65], sp[3 * 65]); o.z = pk2(sp[4 * 65], sp[5 * 65]); o.w = pk2(sp[6 * 65], sp[7 * 65]);
        *(u32x4*)(WT + (size_t)dst_row(mode, n0 + n) * K + k0 + 8 * c) = o; }
    asm volatile("s_waitcnt lgkmcnt(0)" ::: "memory");
}

__device__ __forceinline__ void p0_transpose_item8(const float* W, int K, int N, unsigned char* WT, int mode, LAS float* scr, int item, int lane, const float* gk, float wscale, const float* cm = nullptr) {
    const int nblk = N / 64, kb = item / nblk, nb = item % nblk, k0 = 64 * kb, n0 = 64 * nb;
    const int lr = lane >> 4, lc = (lane & 15) * 4;
#pragma unroll 4
    for (int i = 0; i < 16; ++i) { const int kk = 4 * i + lr; f32x4 v = *(const f32x4*)(W + (size_t)(k0 + kk) * N + n0 + lc); v = v * (wscale * (gk ? gk[k0 + kk] : 1.f));
        LAS float* d = scr + kk * 65 + lc; d[0] = v.x; d[1] = v.y; d[2] = v.z; d[3] = v.w; }
    asm volatile("s_waitcnt lgkmcnt(0)" ::: "memory");
    unsigned char* orow = WT + (size_t)dst_row(mode, n0 + lane) * K + k0; const float ls = cm ? W8MAX / fmaxf(cm[n0 + lane], 1e-30f) : 1.f;
#pragma unroll
    for (int ch = 0; ch < 4; ++ch) { const LAS float* sp = scr + (16 * ch) * 65 + lane; int w[4];
#pragma unroll
        for (int q = 0; q < 4; ++q) { int t = __builtin_amdgcn_cvt_pk_fp8_f32(sp[(4 * q) * 65] * ls, sp[(4 * q + 1) * 65] * ls, 0, false); w[q] = __builtin_amdgcn_cvt_pk_fp8_f32(sp[(4 * q + 2) * 65] * ls, sp[(4 * q + 3) * 65] * ls, t, true); }
        *(u32x4*)(orow + 16 * ch) = (u32x4){(unsigned)w[0], (unsigned)w[1], (unsigned)w[2], (unsigned)w[3]}; }
    asm volatile("s_waitcnt lgkmcnt(0)" ::: "memory");
}
__device__ __forceinline__ void rms_row_to_fp8(const float* xrow, const float* g, unsigned char* orow, int lane) {
    const f32x4* xr = (const f32x4*)xrow + lane;
    f32x4 v[8]; float s = 0.f;
#pragma unroll
    for (int j = 0; j < 8; ++j) { v[j] = xr[64 * j]; s += (v[j].x * v[j].x + v[j].y * v[j].y) + (v[j].z * v[j].z + v[j].w * v[j].w); }
    const float rstd = __builtin_amdgcn_rsqf(wave_sum(s) * (1.f / DM) + EPS);
    int* o4 = (int*)orow + lane;
#pragma unroll
    for (int j = 0; j < 8; ++j) { const f32x4 gg = ((const f32x4*)g)[lane + 64 * j]; int w = __builtin_amdgcn_cvt_pk_fp8_f32(v[j].x * rstd * gg.x, v[j].y * rstd * gg.y, 0, false);
        w = __builtin_amdgcn_cvt_pk_fp8_f32(v[j].z * rstd * gg.z, v[j].w * rstd * gg.w, w, true); o4[64 * j] = w; }
}
__device__ __forceinline__ float wave_max(float v) {
    v = fmaxf(v, xor_get<1>(v)); v = fmaxf(v, xor_get<2>(v)); v = fmaxf(v, xor_get<4>(v)); v = fmaxf(v, xor_get<8>(v)); v = fmaxf(v, xor_get<16>(v));
    auto rr = __builtin_amdgcn_permlane32_swap(__float_as_uint(v), __float_as_uint(v), false, false); return fmaxf(__uint_as_float(rr[0]), __uint_as_float(rr[1]));
}
__device__ __forceinline__ unsigned q8(float v) { int q = (int)__builtin_rintf(v); q = q < -127 ? -127 : (q > 127 ? 127 : q); return (unsigned)q & 0xffu; }
__device__ __forceinline__ unsigned q8x4(float a, float b, float c, float d) { return q8(a) | (q8(b) << 8) | (q8(c) << 16) | (q8(d) << 24); }
__device__ __forceinline__ void p0_colmax_item(const float* W, int K, int N, float* cm, int item, int lane, const float* gk) {
    const int nblk = N / 64, kq = item / nblk, nb = item % nblk, n0 = 64 * nb, kbeg = kq * (K / 4);
    const int lr = lane >> 4, lc = (lane & 15) * 4; f32x4 mx = {0.f, 0.f, 0.f, 0.f};
#pragma unroll 8
    for (int i = 0; i < K / 16; ++i) { const int k = kbeg + 4 * i + lr; f32x4 v = *(const f32x4*)(W + (size_t)k * N + n0 + lc); if (gk) v = v * gk[k];
        mx.x = fmaxf(mx.x, fabsf(v.x)); mx.y = fmaxf(mx.y, fabsf(v.y)); mx.z = fmaxf(mx.z, fabsf(v.z)); mx.w = fmaxf(mx.w, fabsf(v.w)); }
#pragma unroll
    for (int e = 0; e < 4; ++e) { float m = mx[e]; m = fmaxf(m, xor_get<16>(m)); auto rr = __builtin_amdgcn_permlane32_swap(__float_as_uint(m), __float_as_uint(m), false, false); m = fmaxf(__uint_as_float(rr[0]), __uint_as_float(rr[1])); mx[e] = m; }
    if (lane < 16) {
#pragma unroll
        for (int e = 0; e < 4; ++e) atomicMax((unsigned*)cm + n0 + lc + e, __float_as_uint(mx[e])); }
}
__device__ __forceinline__ void p0_transpose_item_i8(const float* W, int K, int N, unsigned char* WT, int mode, LAS float* scr, int item, int lane, const float* gk, const float* cm) {
    const int nblk = N / 64, kb = item / nblk, nb = item % nblk, k0 = 64 * kb, n0 = 64 * nb;
    const int lr = lane >> 4, lc = (lane & 15) * 4;
#pragma unroll 4
    for (int i = 0; i < 16; ++i) { const int kk = 4 * i + lr; f32x4 v = *(const f32x4*)(W + (size_t)(k0 + kk) * N + n0 + lc); if (gk) v = v * gk[k0 + kk];
        LAS float* d = scr + kk * 65 + lc; d[0] = v.x; d[1] = v.y; d[2] = v.z; d[3] = v.w; }
    asm volatile("s_waitcnt lgkmcnt(0)" ::: "memory");
    const float inv = 127.f / fmaxf(cm[n0 + lane], 1e-30f);
    unsigned char* orow = WT + (size_t)dst_row(mode, n0 + lane) * K + k0;
#pragma unroll
    for (int ch = 0; ch < 4; ++ch) { const LAS float* sp = scr + (16 * ch) * 65 + lane; unsigned w[4];
#pragma unroll
        for (int q = 0; q < 4; ++q) w[q] = q8x4(sp[(4 * q) * 65] * inv, sp[(4 * q + 1) * 65] * inv, sp[(4 * q + 2) * 65] * inv, sp[(4 * q + 3) * 65] * inv);
        *(u32x4*)(orow + 16 * ch) = (u32x4){w[0], w[1], w[2], w[3]}; }
    asm volatile("s_waitcnt lgkmcnt(0)" ::: "memory");
}
__device__ __forceinline__ void rms_row_to_i8(const float* xrow, const float* g, unsigned char* orow, float* rsc, int lane) {
    const f32x4* xr = (const f32x4*)xrow + lane;
    f32x4 v[8]; float s = 0.f;
#pragma unroll
    for (int j = 0; j < 8; ++j) { v[j] = xr[64 * j]; s += (v[j].x * v[j].x + v[j].y * v[j].y) + (v[j].z * v[j].z + v[j].w * v[j].w); }
    const float rstd = __builtin_amdgcn_rsqf(wave_sum(s) * (1.f / DM) + EPS); float mx = 0.f;
#pragma unroll
    for (int j = 0; j < 8; ++j) { const f32x4 gg = ((const f32x4*)g)[lane + 64 * j]; v[j] = v[j] * rstd * gg; mx = fmaxf(fmaxf(mx, fmaxf(fabsf(v[j].x), fabsf(v[j].y))), fmaxf(fabsf(v[j].z), fabsf(v[j].w))); }
    mx = fmaxf(wave_max(mx), 1e-30f); const float inv = 127.f / mx;
    unsigned* o4 = (unsigned*)orow + lane;
#pragma unroll
    for (int j = 0; j < 8; ++j) o4[64 * j] = q8x4(v[j].x * inv, v[j].y * inv, v[j].z * inv, v[j].w * inv);
    if (lane == 0) *rsc = mx * (1.f / 127.f);
}
__device__ __forceinline__ void bf16_row_to_i8(const bf16* xrow, unsigned char* orow, float* rsc, int lane) {
    const u32x4* xr = (const u32x4*)xrow + lane; float f[4][8]; float s = 0.f, mx = 0.f;
#pragma unroll
    for (int j = 0; j < 4; ++j) { unpack8(xr[64 * j], f[j]);
#pragma unroll
        for (int e = 0; e < 8; ++e) { s += f[j][e] * f[j][e]; mx = fmaxf(mx, fabsf(f[j][e])); } }
    const float rstd = __builtin_amdgcn_rsqf(wave_sum(s) * (1.f / DM) + EPS); mx = fmaxf(wave_max(mx), 1e-30f); const float inv = 127.f / mx;
    u32x2* o8 = (u32x2*)orow + lane;
#pragma unroll
    for (int j = 0; j < 4; ++j) { u32x2 w; w.x = q8x4(f[j][0] * inv, f[j][1] * inv, f[j][2] * inv, f[j][3] * inv); w.y = q8x4(f[j][4] * inv, f[j][5] * inv, f[j][6] * inv, f[j][7] * inv); o8[64 * j] = w; }
    if (lane == 0) *rsc = mx * (1.f / 127.f) * rstd;
}
__device__ __forceinline__ void rms_row_to_bf16(const float* xrow, const float* g, bf16* orow, int lane) {
    const f32x4* xr = (const f32x4*)xrow + lane;
    f32x4 v[8]; float s = 0.f;
#pragma unroll
    for (int j = 0; j < 8; ++j) { v[j] = xr[64 * j]; s += (v[j].x * v[j].x + v[j].y * v[j].y) + (v[j].z * v[j].z + v[j].w * v[j].w); }
    const float rstd = __builtin_amdgcn_rsqf(wave_sum(s) * (1.f / DM) + EPS);
    u32x2* o8 = (u32x2*)orow + lane;
#pragma unroll
    for (int j = 0; j < 8; ++j) { const f32x4 gg = ((const f32x4*)g)[lane + 64 * j]; u32x2 w; w.x = pk2(v[j].x * rstd * gg.x, v[j].y * rstd * gg.y); w.y = pk2(v[j].z * rstd * gg.z, v[j].w * rstd * gg.w); o8[64 * j] = w; }
}
__device__ __forceinline__ void rms_row_inplace_f32(float* xrow, const float* g, int lane) {
    f32x4* xr = (f32x4*)xrow + lane;
    f32x4 v[8]; float s = 0.f;
#pragma unroll
    for (int j = 0; j < 8; ++j) { v[j] = xr[64 * j]; s += (v[j].x * v[j].x + v[j].y * v[j].y) + (v[j].z * v[j].z + v[j].w * v[j].w); }
    const float rstd = __builtin_amdgcn_rsqf(wave_sum(s) * (1.f / DM) + EPS);
#pragma unroll
    for (int j = 0; j < 8; ++j) { const f32x4 gg = ((const f32x4*)g)[lane + 64 * j]; xr[64 * j] = v[j] * rstd * gg; }
}


__device__ __forceinline__ void onorm_row(bf16* o, const float* g_a, const float* g_g, int lane) {
#pragma unroll
    for (int half = 0; half < 2; ++half) {
        u32x4* p = (u32x4*)(o + half * 1024) + lane; float f0[8], f1[8]; unpack8(p[0], f0); unpack8(p[64], f1); float s = 0.f;
#pragma unroll
        for (int e = 0; e < 8; ++e) s += f0[e] * f0[e] + f1[e] * f1[e];
        const float rstd = __builtin_amdgcn_rsqf(wave_sum(s) * (1.f / 1024.f) + EPS);
        const float* g = (half ? g_g : g_a) + 8 * lane;
#pragma unroll
        for (int e = 0; e < 8; ++e) { f0[e] *= rstd * g[e]; f1[e] *= rstd * g[512 + e]; }
        p[0] = pack8(f0); p[64] = pack8(f1);
    }
}

namespace att {
constexpr int NW = 8, QBLK = 32, KVBLK = 64;
constexpr int LDQ = QW, LDKV = KVW, LDKR = ZW, LDO = DM;
constexpr float SCALE = 0.07216878364870322f;
constexpr float THR = 8.f;
#ifndef ATT_SDEPTH
#define ATT_SDEPTH 1
#endif
constexpr int SDEPTH = ATT_SDEPTH;
constexpr int SHM_V = KVBLK * 128 * 2, SHM_K = KVBLK * 128 * 2, SHM_KR = KVBLK * 64 * 2;
#ifndef ATT_NQL
#define ATT_NQL 0
#endif
constexpr int NQL = ATT_NQL, NQR = 12 - NQL;
constexpr int OFF_V = 0, OFF_K = 2 * SHM_V, OFF_KR = OFF_K + 2 * SHM_K, OFF_WS = OFF_KR + 2 * SHM_KR, OFF_QL = OFF_WS + NW * 64 * 4, ATT_LDS = OFF_QL + NW * NQL * 1024;
static_assert(ATT_LDS <= 147456, "attention LDS");
#define KSWZ(row, colB) ((row) * 256 + ((colB) ^ (((row) & 7) << 4)))
#define KRSWZ(row, colB) ((row) * 128 + ((colB) ^ ((((row) >> 1) & 7) << 4)))
#define SBAR() __builtin_amdgcn_sched_barrier(0)
__device__ __forceinline__ int crow(int r, int hi) { return (r & 3) + 8 * (r >> 2) + 4 * hi; }
__device__ __forceinline__ unsigned cvtpk(float lo, float hi) { unsigned r; asm volatile("v_cvt_pk_bf16_f32 %0, %1, %2" : "=v"(r) : "v"(lo), "v"(hi)); return r; }

__device__ __forceinline__ void partialSM(f32x16& p0, f32x16& p1, float& m_reg, float& mn, float& alpha) {
  constexpr float C = SCALE * 1.4426950408889634f;
  float pmax = p0[0];
#pragma unroll
  for (int r = 1; r < 16; ++r) pmax = fmaxf(pmax, p0[r]);
#pragma unroll
  for (int r = 0; r < 16; ++r) pmax = fmaxf(pmax, p1[r]);
  { auto rr = __builtin_amdgcn_permlane32_swap(__float_as_uint(pmax), __float_as_uint(pmax), false, false);
    pmax = fmaxf(__uint_as_float(rr[0]), __uint_as_float(rr[1])); }
  if (__builtin_expect(__all(pmax - m_reg <= THR / SCALE), 1)) { mn = m_reg; alpha = 1.f; }
  else { mn = fmaxf(m_reg, pmax); alpha = __builtin_amdgcn_exp2f((m_reg - mn) * C); m_reg = mn; }
  float mnC = -mn * C;
#pragma unroll
  for (int r = 0; r < 16; ++r) p0[r] = fmaf(p0[r], C, mnC);
#pragma unroll
  for (int r = 0; r < 16; ++r) p1[r] = fmaf(p1[r], C, mnC);
#pragma unroll
  for (int r = 0; r < 16; ++r) p0[r] = __builtin_amdgcn_exp2f(p0[r]);
}
__device__ __forceinline__ void finishSM(f32x16& p0, f32x16& p1, float alpha, float& l_reg, bf16x8& pa0, bf16x8& pa1, bf16x8& pa2, bf16x8& pa3) {
#pragma unroll
  for (int r = 0; r < 16; ++r) p1[r] = __builtin_amdgcn_exp2f(p1[r]);
  float ps = 0;
#pragma unroll
  for (int r = 0; r < 16; ++r) ps += p0[r];
#pragma unroll
  for (int r = 0; r < 16; ++r) ps += p1[r];
  { auto rr = __builtin_amdgcn_permlane32_swap(__float_as_uint(ps), __float_as_uint(ps), false, false);
    ps = __uint_as_float(rr[0]) + __uint_as_float(rr[1]); }
  l_reg = l_reg * alpha + ps;
#define PK4(P, BASE, OUT) do { unsigned a0 = cvtpk(P[BASE + 0], P[BASE + 1]), a1 = cvtpk(P[BASE + 2], P[BASE + 3]);   \
    unsigned b0 = cvtpk(P[BASE + 4], P[BASE + 5]), b1 = cvtpk(P[BASE + 6], P[BASE + 7]);                              \
    auto r0 = __builtin_amdgcn_permlane32_swap(a0, b0, false, false); auto r1 = __builtin_amdgcn_permlane32_swap(a1, b1, false, false); \
    u32x4 w = {r0[0], r1[0], r0[1], r1[1]}; OUT = *reinterpret_cast<bf16x8*>(&w); } while (0)
  PK4(p0, 0, pa0); PK4(p0, 8, pa1); PK4(p1, 0, pa2); PK4(p1, 8, pa3);
#undef PK4
}
#define QF(d) ((d) < NQR ? qr[(d) < NQR ? (d) : 0] : *reinterpret_cast<const bf16x8*>(ql + ((d) - NQR) * 1024))
__device__ __forceinline__ void qkt(f32x16& p0, f32x16& p1, const char* Ks, const char* Krs, const bf16x8* qr, const char* ql, int r32, int hi) {
  p0 = f32x16{}; p1 = f32x16{};
#pragma unroll
  for (int d0 = 0; d0 < 8; ++d0) { int cb = (d0 * 16 + hi * 8) * 2;
    bf16x8 b0 = *reinterpret_cast<const bf16x8*>(Ks + KSWZ(r32, cb));
    bf16x8 b1 = *reinterpret_cast<const bf16x8*>(Ks + KSWZ(32 + r32, cb));
    const bf16x8 qf = QF(d0);
    p0 = __builtin_amdgcn_mfma_f32_32x32x16_bf16(b0, qf, p0, 0, 0, 0);
    p1 = __builtin_amdgcn_mfma_f32_32x32x16_bf16(b1, qf, p1, 0, 0, 0); }
#pragma unroll
  for (int d0 = 0; d0 < 4; ++d0) { int cb = (d0 * 16 + hi * 8) * 2;
    bf16x8 b0 = *reinterpret_cast<const bf16x8*>(Krs + KRSWZ(r32, cb));
    bf16x8 b1 = *reinterpret_cast<const bf16x8*>(Krs + KRSWZ(32 + r32, cb));
    const bf16x8 qf = QF(8 + d0);
    p0 = __builtin_amdgcn_mfma_f32_32x32x16_bf16(b0, qf, p0, 0, 0, 0);
    p1 = __builtin_amdgcn_mfma_f32_32x32x16_bf16(b1, qf, p1, 0, 0, 0); }
}
__device__ __forceinline__ int v_st(int k, int c) { const int kk = (k & ~0xC) | ((k & 4) << 1) | ((k & 8) >> 1); return ((kk >> 3) * 4 + (c >> 5)) * 512 + ((kk & 7) * 32 + (c & 31)) * 2; }
__device__ __forceinline__ int v_rd_base(int lane) { return ((lane & 3) << 3) | (((lane >> 2) & 3) << 6) | (((lane >> 4) & 1) << 5) | (((lane >> 5) & 1) << 8); }
constexpr int v_rd_off(int d0, int ks, int half) { return d0 * 512 + ks * 4096 + half * 2048; }
template <int OFF> __device__ __forceinline__ s16x4 tr_read(int vb) {
  s16x4 r; asm volatile("ds_read_b64_tr_b16 %0, %1 offset:%2" : "=&v"(r) : "v"(vb), "i"(OFF) : "memory"); return r;
}
template <int D0> __device__ __forceinline__ void pv_one(f32x16& od, int vb, bf16x8 pa0, bf16x8 pa1, bf16x8 pa2, bf16x8 pa3) {
  const s16x4 l0 = tr_read<v_rd_off(D0, 0, 0)>(vb), h0 = tr_read<v_rd_off(D0, 0, 1)>(vb), l1 = tr_read<v_rd_off(D0, 1, 0)>(vb), h1 = tr_read<v_rd_off(D0, 1, 1)>(vb);
  const s16x4 l2 = tr_read<v_rd_off(D0, 2, 0)>(vb), h2 = tr_read<v_rd_off(D0, 2, 1)>(vb), l3 = tr_read<v_rd_off(D0, 3, 0)>(vb), h3 = tr_read<v_rd_off(D0, 3, 1)>(vb);
  asm volatile("s_waitcnt lgkmcnt(0)" ::: "memory"); SBAR();
#define PK(L, H) (bf16x8){L[0], L[1], L[2], L[3], H[0], H[1], H[2], H[3]}
  od = __builtin_amdgcn_mfma_f32_32x32x16_bf16(pa0, PK(l0, h0), od, 0, 0, 0);
  od = __builtin_amdgcn_mfma_f32_32x32x16_bf16(pa1, PK(l1, h1), od, 0, 0, 0);
  od = __builtin_amdgcn_mfma_f32_32x32x16_bf16(pa2, PK(l2, h2), od, 0, 0, 0);
  od = __builtin_amdgcn_mfma_f32_32x32x16_bf16(pa3, PK(l3, h3), od, 0, 0, 0);
#undef PK
}
__device__ __forceinline__ void pv_d0(f32x16* o, int vb, bf16x8 pa0, bf16x8 pa1, bf16x8 pa2, bf16x8 pa3) {
  pv_one<0>(o[0], vb, pa0, pa1, pa2, pa3); pv_one<1>(o[1], vb, pa0, pa1, pa2, pa3); pv_one<2>(o[2], vb, pa0, pa1, pa2, pa3); pv_one<3>(o[3], vb, pa0, pa1, pa2, pa3);
}

__device__ __forceinline__ void attn_dense_body(const bf16* __restrict__ Qb, const bf16* __restrict__ Kn, const bf16* __restrict__ Kr, const bf16* __restrict__ Vh,
                                                bf16* __restrict__ Ob, pg8::u64* ssa, int seq, char* lds, const int wv) {
  const int tid = tid_of(wv), wid = tid >> 6, lane = tid & 63, r32 = lane & 31, hi = lane >> 5;
  char* V_lds = lds + OFF_V; char* K_lds = lds + OFF_K; char* KR_lds = lds + OFF_KR;
  float* ws = (float*)(lds + OFF_WS) + wid * 64; float* li_l = ws; float* al_l = ws + 32;
  float m_reg = -1e30f, l_reg = 0; f32x16 o[4] = {}; bf16x8 qr[NQR]; char* ql = lds + OFF_QL + wid * (NQL * 1024) + lane * 16;
  const bf16* Qw = Qb + (long)(wid * QBLK + r32) * LDQ + hi * 8;
#pragma unroll
  for (int d0 = 0; d0 < 12; ++d0) { const bf16x8 t = *reinterpret_cast<const bf16x8*>(Qw + d0 * 16); if (d0 < NQR) qr[d0 < NQR ? d0 : 0] = t; else *reinterpret_cast<bf16x8*>(ql + (d0 - NQR) * 1024) = t; }
  const int sr = tid >> 4, sc = (tid & 15) * 8, vst0 = v_st(sr, sc), vst1 = v_st(32 + sr, sc);
  const int krr = tid >> 3, krc = (tid & 7) * 8;
  const int vb0 = (int)(uintptr_t)V_lds + v_rd_base(lane);
  struct { bf16x8 vs0, vs1, ks0, ks1, kr; } sr_[SDEPTH];
const unsigned offV0 = (unsigned)(sr * LDKV + sc) * 2u, offV1 = (unsigned)((32 + sr) * LDKV + sc) * 2u, offKR = (unsigned)(krr * LDKR + krc) * 2u;
#define SLOAD(i, k0) do { const char* vt_ = (const char*)Vh + (size_t)(k0) * (LDKV * 2); const char* kt_ = (const char*)Kn + (size_t)(k0) * (LDKV * 2); const char* rt_ = (const char*)Kr + (size_t)(k0) * (LDKR * 2); \
    sr_[i].vs0 = *reinterpret_cast<const bf16x8*>(vt_ + offV0); sr_[i].vs1 = *reinterpret_cast<const bf16x8*>(vt_ + offV1); \
    sr_[i].ks0 = *reinterpret_cast<const bf16x8*>(kt_ + offV0); sr_[i].ks1 = *reinterpret_cast<const bf16x8*>(kt_ + offV1); \
    sr_[i].kr = *reinterpret_cast<const bf16x8*>(rt_ + offKR); } while (0)
#define SWRITE(b, i) do { *(bf16x8*)(V_lds + (b) * SHM_V + vst0) = sr_[i].vs0;          \
    *(bf16x8*)(V_lds + (b) * SHM_V + vst1) = sr_[i].vs1; int kc = sc * 2;               \
    *(bf16x8*)(K_lds + (b) * SHM_K + KSWZ(sr, kc)) = sr_[i].ks0;                       \
    *(bf16x8*)(K_lds + (b) * SHM_K + KSWZ(32 + sr, kc)) = sr_[i].ks1;                  \
    *(bf16x8*)(KR_lds + (b) * SHM_KR + KRSWZ(krr, krc * 2)) = sr_[i].kr; } while (0)
#define SWAIT() do { if constexpr (SDEPTH == 2) asm volatile("s_waitcnt vmcnt(5)" ::: "memory"); else asm volatile("s_waitcnt vmcnt(0)" ::: "memory"); } while (0)
#define RESC(a) do { if (__any((a) < 1.f)) { if (hi == 0) al_l[r32] = (a); asm volatile("s_waitcnt lgkmcnt(0)" ::: "memory"); \
    _Pragma("unroll") for (int d = 0; d < 4; ++d) _Pragma("unroll") for (int r = 0; r < 16; ++r) o[d][r] *= al_l[crow(r, hi)]; } } while (0)
  f32x16 pA0, pA1, pB0, pB1; float mnA, mnB, alA, alB; bf16x8 pa0, pa1, pa2, pa3; const int NT = seq / KVBLK;
  constexpr int SE = 0, SO = SDEPTH - 1;
  SLOAD(SE, 0); asm volatile("s_waitcnt vmcnt(0)" ::: "memory"); SWRITE(0, SE); __syncthreads();
  qkt(pA0, pA1, K_lds, KR_lds, qr, ql, r32, hi); partialSM(pA0, pA1, m_reg, mnA, alA);
  SLOAD(SO, KVBLK); if constexpr (SDEPTH == 2) { if (2 < NT) SLOAD(SE, 2 * KVBLK); }
  SWAIT(); SWRITE(1, SO); __syncthreads();
  for (int j = 1; j + 1 < NT; j += 2) {
    SBAR(); qkt(pB0, pB1, K_lds + SHM_K, KR_lds + SHM_KR, qr, ql, r32, hi);
    finishSM(pA0, pA1, alA, l_reg, pa0, pa1, pa2, pa3); SBAR();
    SLOAD(SO, (j + SDEPTH) * KVBLK); SBAR();
    pv_d0(o, vb0, pa0, pa1, pa2, pa3); partialSM(pB0, pB1, m_reg, mnB, alB);
    __syncthreads(); SWAIT(); SWRITE(0, SE);
    RESC(alB); __syncthreads();
    SBAR(); qkt(pA0, pA1, K_lds, KR_lds, qr, ql, r32, hi);
    finishSM(pB0, pB1, alB, l_reg, pa0, pa1, pa2, pa3); SBAR();
    if (SDEPTH == 1 || j + 3 < NT) SLOAD(SE, (j + 1 + SDEPTH) * KVBLK); SBAR();
    pv_d0(o, vb0 + SHM_V, pa0, pa1, pa2, pa3); partialSM(pA0, pA1, m_reg, mnA, alA);
    __syncthreads(); SWAIT(); SWRITE(1, SO);
    RESC(alA); __syncthreads();
  }
  SBAR(); qkt(pB0, pB1, K_lds + SHM_K, KR_lds + SHM_KR, qr, ql, r32, hi);
  finishSM(pA0, pA1, alA, l_reg, pa0, pa1, pa2, pa3); SBAR();
  pv_d0(o, vb0, pa0, pa1, pa2, pa3); partialSM(pB0, pB1, m_reg, mnB, alB);
  __syncthreads(); RESC(alB);
  finishSM(pB0, pB1, alB, l_reg, pa0, pa1, pa2, pa3); SBAR();
  pv_d0(o, vb0 + SHM_V, pa0, pa1, pa2, pa3);
  if (hi == 0) li_l[r32] = l_reg; asm volatile("s_waitcnt lgkmcnt(0)" ::: "memory");
  float rli[16];
#pragma unroll
  for (int r = 0; r < 16; ++r) rli[r] = __builtin_amdgcn_rcpf(li_l[crow(r, hi)]);
  bf16* Ow = Ob + (long)(wid * QBLK) * LDO;
#pragma unroll
  for (int r = 0; r < 16; ++r) { int orow = crow(r, hi);
    float sq = 0.f;
#pragma unroll
    for (int d0 = 0; d0 < 4; ++d0) { const float v = o[d0][r] * rli[r]; sq += v * v; Ow[(long)orow * LDO + d0 * 32 + r32] = (bf16)(cvtpk(v, 0.f) & 0xffffu); }
    sq += xor_get<1>(sq); sq += xor_get<2>(sq); sq += xor_get<4>(sq); sq += xor_get<8>(sq); sq += xor_get<16>(sq);
    if (r32 == 0) pg8::ss_add(ssa + wid * QBLK + orow, sq); }
#undef SLOAD
#undef SWRITE
#undef SWAIT
#undef RESC
}
}

__device__ __forceinline__ void gmlp_unit(const bf16* Z, const bf16* Wsp, const float* b_s, const float* g_v, bf16* O, pg8::u64* ssg, int chunk, int g, char* lds, const int wv) {
  const int tid = tid_of(wv), wid = tid >> 6, lane = tid & 63, r32 = lane & 31, hi = lane >> 5;
  constexpr int PITCH = 136;
  bf16* VT = (bf16*)lds;
  const bf16* Zc = Z + (size_t)chunk * 128 * ZW;
  bf16x8 af[8];
  { const bf16* Ar = Wsp + (size_t)g * 16384 + (size_t)((wid & 3) * 32 + r32) * 128 + hi * 8;
#pragma unroll
    for (int k = 0; k < 8; ++k) af[k] = *reinterpret_cast<const bf16x8*>(Ar + k * 16); }
  __syncthreads();
  {
    const int j = tid >> 2, cg = tid & 3; u32x4 w[4]; float sq = 0.f;
    const bf16* zr = Zc + (size_t)j * ZW + Z_V + g * 128 + cg * 8;
#pragma unroll
    for (int i = 0; i < 4; ++i) w[i] = *(const u32x4*)(zr + 32 * i);
#pragma unroll
    for (int i = 0; i < 4; ++i) { float f[8]; unpack8(w[i], f);
#pragma unroll
      for (int e = 0; e < 8; ++e) sq += f[e] * f[e]; }
    sq += xor_get<1>(sq); sq += xor_get<2>(sq);
    const float rs = __builtin_amdgcn_rsqf(sq * (1.f / 128.f) + EPS);
#pragma unroll
    for (int i = 0; i < 4; ++i) { const int c0 = (cg + 4 * i) * 8; float f[8]; unpack8(w[i], f);
      const float* gp = g_v + g * 128 + c0; const f32x4 g0 = *(const f32x4*)gp, g1 = *(const f32x4*)(gp + 4);
      unsigned p0 = pk2(f[0] * rs * g0.x, f[1] * rs * g0.y), p1 = pk2(f[2] * rs * g0.z, f[3] * rs * g0.w), p2 = pk2(f[4] * rs * g1.x, f[5] * rs * g1.y), p3 = pk2(f[6] * rs * g1.z, f[7] * rs * g1.w);
      if (cg & 1) { const unsigned t = p0; p0 = p1; p1 = p2; p2 = p3; p3 = t; }
      if (cg & 2) { unsigned t = p0; p0 = p2; p2 = t; t = p1; p1 = p3; p3 = t; }
      const unsigned q[4] = {p0, p1, p2, p3};
#pragma unroll
      for (int d = 0; d < 4; ++d) { const int dd = (d + cg) & 3; VT[(c0 + 2 * dd) * PITCH + j] = (bf16)(q[d] & 0xffff); VT[(c0 + 2 * dd + 1) * PITCH + j] = (bf16)(q[d] >> 16); } }
  }
  __syncthreads();
  const int ib = (wid & 3) * 32, cb = (wid >> 2) * 64;
  f32x16 a0 = {}, a1 = {};
#pragma unroll
  for (int k = 0; k < 8; ++k) {
    const bf16x8 b0 = *reinterpret_cast<const bf16x8*>(VT + (cb + r32) * PITCH + k * 16 + hi * 8);
    const bf16x8 b1 = *reinterpret_cast<const bf16x8*>(VT + (cb + 32 + r32) * PITCH + k * 16 + hi * 8);
    a0 = __builtin_amdgcn_mfma_f32_32x32x16_bf16(b0, af[k], a0, 0, 0, 0);
    a1 = __builtin_amdgcn_mfma_f32_32x32x16_bf16(b1, af[k], a1, 0, 0, 0);
  }
  { const int i = ib + r32; const float bb = b_s[g * 128 + i]; const size_t row = (size_t)chunk * 128 + i;
    const bf16* up = Z + row * ZW + Z_U + g * 128 + cb + 4 * hi; bf16* op = O + row * DM + 1024 + g * 128 + cb + 4 * hi;
    float sq = 0.f;
#pragma unroll
    for (int q = 0; q < 4; ++q) {
      const u32x2 w0 = *(const u32x2*)(up + 8 * q), w1 = *(const u32x2*)(up + 32 + 8 * q);
      u32x2 o0, o1;
      { const float uu[8] = {bf_lo(w0.x), bf_hi(w0.x), bf_lo(w0.y), bf_hi(w0.y), bf_lo(w1.x), bf_hi(w1.x), bf_lo(w1.y), bf_hi(w1.y)};
#pragma unroll
        for (int e = 0; e < 4; ++e) { const float v0 = uu[e] * (a0[4 * q + e] + bb), v1 = uu[4 + e] * (a1[4 * q + e] + bb); sq += v0 * v0 + v1 * v1; } }
      o0.x = pk2(bf_lo(w0.x) * (a0[4 * q + 0] + bb), bf_hi(w0.x) * (a0[4 * q + 1] + bb)); o0.y = pk2(bf_lo(w0.y) * (a0[4 * q + 2] + bb), bf_hi(w0.y) * (a0[4 * q + 3] + bb));
      o1.x = pk2(bf_lo(w1.x) * (a1[4 * q + 0] + bb), bf_hi(w1.x) * (a1[4 * q + 1] + bb)); o1.y = pk2(bf_lo(w1.y) * (a1[4 * q + 2] + bb), bf_hi(w1.y) * (a1[4 * q + 3] + bb));
      *(u32x2*)(op + 8 * q) = o0; *(u32x2*)(op + 32 + 8 * q) = o1; }
    sq = xor32_sum(sq);
    if (hi == 0) pg8::ss_add(ssg + row, sq); }
}

#define XB_TMO      128
#define XB_XCNT(j)  (256  + 64 * (j))
#define XB_XSUB(j)  (1280 + 64 * (j))
#define XB_XGEN(j)  (2304 + 64 * (j))
#define XB_TOP      3328
#define XB_TOPGEN   3392
#define XCD_BAR_WORDS 3456
#define XB_SPIN_CAP (1u << 18)
__device__ __forceinline__ unsigned xb_ld(unsigned* p)              { return __hip_atomic_load(p, __ATOMIC_RELAXED, __HIP_MEMORY_SCOPE_AGENT); }
__device__ __forceinline__ unsigned xb_add(unsigned* p, unsigned v) { return __hip_atomic_fetch_add(p, v, __ATOMIC_RELAXED, __HIP_MEMORY_SCOPE_AGENT); }
__device__ __forceinline__ unsigned xb_xcc_id() { return (unsigned)__builtin_amdgcn_s_getreg((3 << 11) | 20) & 0xFu; }
#define XB_SPIN(cond, bar) do { unsigned _sp = 0; while (cond) { __builtin_amdgcn_s_sleep(1); \
    if ((++_sp & 255u) == 0u) { if (xb_ld(&(bar)[XB_TMO])) break; if (_sp > XB_SPIN_CAP) { atomicAdd(&(bar)[XB_TMO], 1u); break; } } } } while (0)
struct XcdBarrier { unsigned* bar; unsigned x; volatile LAS unsigned* st; };
__device__ __forceinline__ XcdBarrier xcd_barrier_post(unsigned* bar, volatile LAS unsigned* st) {
    XcdBarrier b; b.bar = bar; b.x = xb_xcc_id(); b.st = st;
    if (threadIdx.x == 0) (void)xb_add(&bar[XB_XCNT(b.x)], 1u);
    return b;
}
__device__ __forceinline__ void xcd_barrier_complete(unsigned* bar, unsigned x, unsigned& nloc, unsigned& nx) {
    const unsigned G = gridDim.x * gridDim.y * gridDim.z;
    unsigned sum, cnt, mine, sp = 0u;
    for (;;) {
        sum = 0u; cnt = 0u; mine = 0u;
#pragma unroll
        for (unsigned j = 0; j < 16; ++j) { const unsigned c = xb_ld(&bar[XB_XCNT(j)]); sum += c; cnt += (c > 0u) ? 1u : 0u; mine = (j == x) ? c : mine; }
        if (sum == G) break;
        __builtin_amdgcn_s_sleep(1);
        if ((++sp & 255u) == 0u) { if (xb_ld(&bar[XB_TMO])) break; if (sp > XB_SPIN_CAP) { atomicAdd(&bar[XB_TMO], 1u); break; } }
    }
    nloc = mine > 0u ? mine : 1u; nx = cnt > 0u ? cnt : 1u;
}
__device__ __forceinline__ void xcd_barrier(const XcdBarrier& b, const int wv) {
    asm volatile("s_waitcnt vmcnt(0)" ::: "memory");
    __syncthreads();
    if (tid_of(wv) == 0) {
        unsigned* bar = b.bar;
        __builtin_amdgcn_s_waitcnt(0);
        unsigned nloc = b.st[0], nx = b.st[1];
        if (nloc == 0u) { xcd_barrier_complete(bar, b.x, nloc, nx); b.st[0] = nloc; b.st[1] = nx; }
        const unsigned old = xb_add(&bar[XB_XSUB(b.x)], 1u);
        const unsigned gen = old / nloc;
        if (old + 1u == (gen + 1u) * nloc) {
            __builtin_amdgcn_fence(__ATOMIC_RELEASE, "agent");
            asm volatile("s_waitcnt vmcnt(0)" ::: "memory");
            const unsigned og = xb_add(&bar[XB_TOP], 1u);
            const unsigned tg = og / nx;
            if (og + 1u == (tg + 1u) * nx) xb_add(&bar[XB_TOPGEN], 1u);
            else XB_SPIN(xb_ld(&bar[XB_TOPGEN]) == tg, bar);
            __builtin_amdgcn_fence(__ATOMIC_ACQUIRE, "agent");
            xb_add(&bar[XB_XGEN(b.x)], 1u);
            asm volatile("s_waitcnt vmcnt(0)" ::: "memory");
        } else {
            XB_SPIN(xb_ld(&bar[XB_XGEN(b.x)]) == gen, bar);
            __builtin_amdgcn_fence(__ATOMIC_ACQUIRE, "agent");
            asm volatile("s_waitcnt vmcnt(0)" ::: "memory");
        }
    }
    __syncthreads();
}

struct Args { const float* in[23]; float* out; unsigned char* ws; int ph_lo, ph_hi; };

template <class Epi, int MODE = 0, bool MID = false>
__device__ __forceinline__ void run_gemm(LAS unsigned char* lds, const void* A, int lda, const void* Bt, int ldb, int M, int N, int K, const Epi E, const int wv, int base = -1, int stride = 0, int cnt = 0x7fffffff) {
    pg8::Gemm g{A, Bt, M, N, K, lda, ldb}; pg8::StaticOrder S; S.init(M, N, (int)gridDim.x, (int)blockIdx.x);
    if (base >= 0) { S.base = base; S.stride = stride; } S.cnt = cnt;
    pg8::gemm_phase<Epi, pg8::StaticOrder, true, true, MODE, MID>(lds, g, S, E, wv);
}

__global__ void __launch_bounds__(512) mk_fwd(Args args) {
    extern __shared__ __attribute__((aligned(16))) unsigned char lds_raw[];
    LAS unsigned char* lds = (LAS unsigned char*)lds_raw;
    const int G = gridDim.x;
    const int wv = __builtin_amdgcn_readfirstlane(threadIdx.x >> 6);
    volatile LAS unsigned* bar_st = (volatile LAS unsigned*)(lds + (LDS_BYTES - 64));
    if (threadIdx.x < 2) bar_st[threadIdx.x] = 0u;
    __syncthreads();
    unsigned* barw = (unsigned*)(args.ws);
    XcdBarrier xbar; xbar.bar = barw; xbar.x = 0; xbar.st = bar_st;
#define LANE_INIT const int tid = tid_of(wv), lane = tid & 63, wave = wv, gw = blockIdx.x * 8 + wave, NGW = G * 8; (void)tid; (void)lane; (void)gw; (void)NGW;
#define PH_WS unsigned char* ws = args.ws; float* X = args.out; (void)X; (void)ws;
#define x_p (args.in[0])
#define x_s (args.in[1])
#define g_ffn1 (args.in[2])
#define w1_gate (args.in[3])
#define w1_up (args.in[4])
#define w1_down (args.in[5])
#define g_mix (args.in[6])
#define w_in (args.in[7])
#define g_q (args.in[8])
#define w_q_b (args.in[9])
#define g_kv (args.in[10])
#define w_kv_b (args.in[11])
#define g_v (args.in[12])
#define w_s (args.in[13])
#define b_s (args.in[14])
#define g_out_attn (args.in[15])
#define g_out_gmlp (args.in[16])
#define w_out (args.in[17])
#define g_ffn2 (args.in[18])
#define w2_gate (args.in[19])
#define w2_up (args.in[20])
#define w2_down (args.in[21])
#define g_final (args.in[22])
#define rope ((float*)(ws + WS_ROPE))
#define W1U ((bf16*)(ws + WS_W1U))
#define W1D ((bf16*)(ws + WS_W1D))
#define W2U ((bf16*)(ws + WS_W2U))
#define W2D ((bf16*)(ws + WS_W2D))
#define WIN ((bf16*)(ws + WS_WIN))
#define WQ ((bf16*)(ws + WS_WQ))
#define WKV ((bf16*)(ws + WS_WKV))
#define WOUT ((bf16*)(ws + WS_WOUT))
#define WSP ((bf16*)(ws + WS_WSP))
#define H ((bf16*)(ws + WS_H))
#define ACT ((bf16*)(ws + WS_ACT))
#define Z ((bf16*)(ws + WS_Z))
#define Q ((bf16*)(ws + WS_Q))
#define KV ((bf16*)(ws + WS_KV))
#define H2 ((bf16*)(ws + WS_H2))
#define X1B ((bf16*)X)
#define X2B ((bf16*)X + (size_t)T * DM)
#define CM ((float*)(ws + WS_CM))
#define RS1 ((float*)(ws + WS_RS))
#define RS2 ((float*)(ws + WS_RS) + T)
#define SS ((pg8::u64*)(ws + WS_SS))
#define SS1 (SS)
#define SS3 (SS + T)
#define SSQ (SS + 2 * T)
#define SSKV (SS + 3 * T)
#define SSA (SS + 4 * T)
#define SSG (SS + 5 * T)
#define IN(k) true
#define SEAM(k) do { if ((k) == 0) { cg::this_grid().sync(); xbar = xcd_barrier_post(barw, bar_st); } else xcd_barrier(xbar, wv); } while (0)

    if (IN(0)) {
        PH_WS LANE_INIT
        LAS float* scr = (LAS float*)(lds + wave * 16640);
        constexpr int I_UP = (DM / 64) * (DFF / 64), I_DN = (DFF / 64) * (DM / 64), I_IN = (DM / 64) * (3136 / 64), I_Q = (512 / 64) * (QW / 64), I_KV = (512 / 64) * (KVW / 64), I_OUT = (DM / 64) * (DM / 64);
        constexpr int I_CM = 4 * (DFF / 64), I_CMD = 4 * (DM / 64); constexpr int NITEMS = 4 * I_CM + I_CMD + 2 * I_DN + I_IN + I_Q + I_KV + I_OUT;
        for (int it = gw; it < NITEMS; it += NGW) {
            int r = it;
            if (r < 4 * I_CM) {
                const int mat = r / I_CM, it2 = r % I_CM;
                p0_colmax_item(mat == 0 ? w1_gate : mat == 1 ? w1_up : mat == 2 ? w2_gate : w2_up, DM, DFF, CM + mat * DFF, it2, lane, mat >= 2 ? g_ffn2 : nullptr); continue; } r -= 4 * I_CM;
            if (r < I_CMD) { p0_colmax_item(w2_down, DFF, DM, CM + 4 * DFF, r, lane, nullptr); continue; } r -= I_CMD;
            if (r < I_DN) { p0_transpose_item(w1_down, DFF, DM, W1D, 0, scr, r, lane); continue; } r -= I_DN;
            if (r < I_DN) { if (!FP8_DOWN2) p0_transpose_item(w2_down, DFF, DM, W2D, 0, scr, r, lane); continue; } r -= I_DN;
            if (r < I_IN) { p0_transpose_item(w_in, DM, 3136, WIN, 3, scr, r, lane, g_mix); continue; } r -= I_IN;
            if (r < I_Q) { p0_transpose_item(w_q_b, 512, QW, WQ, 4, scr, r, lane, g_q); continue; } r -= I_Q;
            if (r < I_KV) { p0_transpose_item(w_kv_b, 512, KVW, WKV, 0, scr, r, lane, g_kv); continue; } r -= I_KV;
            p0_transpose_item(w_out, DM, DM, WOUT, 0, scr, r, lane, (r / (DM / 64)) < 16 ? g_out_attn : g_out_gmlp - 1024);
        }
        const int gt = blockIdx.x * 512 + tid, NGT = G * 512;
        if (blockIdx.x == 0) for (int i = tid; i < XCD_BAR_WORDS; i += 512) barw[i] = 0u;
        for (int i = gt; i < 192 * DM / 8; i += NGT) ((u32x4*)(WIN + (size_t)1088 * DM))[i] = (u32x4){0u, 0u, 0u, 0u};
        for (int i = gt; i < 6 * T / 2; i += NGT) ((u32x4*)SS)[i] = (u32x4){0u, 0u, 0u, 0u};
        for (int i = gt; i < 8 * 128 * 128 / 2; i += NGT) ((unsigned*)WSP)[i] = pk2(w_s[2 * i], w_s[2 * i + 1]);
        for (int i = gt; i < 8192 * 32; i += NGT) { const int pos = i >> 5, k = i & 31; const double a = (double)pos * c_inv_rev[k]; const float fr = (float)(a - floor(a));
            rope[(size_t)pos * 64 + k] = __builtin_amdgcn_cosf(fr); rope[(size_t)pos * 64 + 32 + k] = __builtin_amdgcn_sinf(fr); }
        for (int m = gw; m < T; m += NGW) { const float* xr = (m < TP ? x_p + (size_t)m * DM : x_s + (size_t)(m - TP) * DM);
            rms_row_to_i8(xr, g_ffn1, (unsigned char*)H + (size_t)m * DM, RS1 + m, lane); }
    }
    SEAM(0);
    {
        PH_WS LANE_INIT
        LAS float* scr = (LAS float*)(lds + wave * 16640);
        constexpr int I_UP = (DM / 64) * (DFF / 64), I_DN8 = FP8_DOWN2 ? (DFF / 64) * (DM / 64) : 0;
        for (int it = gw; it < I_DN8; it += NGW) p0_transpose_item8(w2_down, DFF, DM, (unsigned char*)W2D, 0, scr, it, lane, nullptr, 1.f, CM + 4 * DFF);
        for (int it = gw; it < 4 * I_UP; it += NGW) { const int mat = it / I_UP, r = it % I_UP;
            p0_transpose_item_i8(mat == 0 ? w1_gate : mat == 1 ? w1_up : mat == 2 ? w2_gate : w2_up, DM, DFF, (unsigned char*)(mat < 2 ? W1U : W2U), 1 + (mat & 1), scr, r, lane, mat >= 2 ? g_ffn2 : nullptr, CM + mat * DFF); }
    }
    SEAM(20);
    if (IN(1)) { PH_WS pg8::EpiSwiGLU<false> E{ACT, DFF, RS1, CM, CM + DFF, 1.f / 127.f}; run_gemm<pg8::EpiSwiGLU<false>, 2>(lds, H, DM, W1U, DM, T, 2 * DFF, DM, E, wv); }
    SEAM(1);
    if (IN(2)) { PH_WS
        { pg8::EpiResid<true, false, 1, true, false, false, false> E{x_p, nullptr, DM, X1B, SS1, nullptr, nullptr, 1.f}; run_gemm(lds, ACT, DFF, W1D, DFF, TP, DM, DFF, E, wv); }
        { pg8::EpiResid<true, false, 1, true, false, false, false> E{x_s, nullptr, DM, X1B + (size_t)TP * DM, SS1 + TP, nullptr, nullptr, 1.f}; run_gemm(lds, ACT + (size_t)TP * DFF, DFF, W1D, DFF, TS, DM, DFF, E, wv); }
    }
    SEAM(2);
    const bool rebal = (G == 256);
    if (IN(3)) { PH_WS pg8::EpiZ E{Z, ZW, SS1, SSQ, SSKV, rope}; run_gemm(lds, X1B, DM, WIN, DM, T, ZW, DM, E, wv, -1, 0, rebal ? 8 : 0x7fffffff); }
    SEAM(3);
    if (IN(4)) { PH_WS
        const int c_ = (int)blockIdx.x;
        if (rebal && c_ < 32) { pg8::EpiZ E{Z, ZW, SS1, SSQ, SSKV, rope}; run_gemm(lds, X1B, DM, WIN, DM, T, ZW, DM, E, wv, 2048 + c_, 256, 1); }
        { pg8::EpiQRope E{Q, QW, rope, SSQ};
          if (!rebal) run_gemm(lds, Z, ZW, WQ, 512, T, QW, 512, E, wv);
          else if (c_ >= 32) run_gemm(lds, Z, ZW, WQ, 512, T, QW, 512, E, wv, c_ - 32, 224, 4);
          else run_gemm(lds, Z, ZW, WQ, 512, T, QW, 512, E, wv, 896 + c_, 32, 2); }
        { pg8::EpiBf16 E{KV, KVW, SSKV, 1.f / 512.f}; run_gemm(lds, Z + 512, ZW, WKV, 512, T, KVW, 512, E, wv); }
    }
    SEAM(4);
    if (IN(5)) { PH_WS
        const int c = blockIdx.x;
        for (int u = c; u < (T / 128) * 8; u += G) gmlp_unit(Z, WSP, b_s, g_v, H, SSG, u >> 3, u & 7, (char*)lds_raw, wv);
        for (int u = c; u < 256 + 1024; u += G) {
            int head, row0, krow0, seq;
            if (u < 256) { head = u & 7; row0 = (u >> 3) * 256; krow0 = 0; seq = TP; }
            else { const int v = u - 256; head = v & 7; const int idx = v >> 3; const int sq = idx >> 3, qb = idx & 7; krow0 = TP + sq * 2048; row0 = krow0 + qb * 256; seq = 2048; }
            __syncthreads();
            att::attn_dense_body(Q + (size_t)row0 * QW + head * 192, KV + (size_t)krow0 * KVW + head * 256, Z + (size_t)krow0 * ZW + Z_KR, KV + (size_t)krow0 * KVW + head * 256 + 128,
                                 H + (size_t)row0 * DM + head * 128, SSA + row0, seq, (char*)lds_raw, wv);
        }
    }
    SEAM(5);
    if (IN(7)) { PH_WS pg8::EpiMix E{X1B, X2B, DM, SSA, SSG}; run_gemm<pg8::EpiMix, 0, true>(lds, H, DM, WOUT, DM, T, DM, DM, E, wv); }
    SEAM(7);
    { PH_WS LANE_INIT for (int m = gw; m < T; m += NGW) bf16_row_to_i8(X2B + (size_t)m * DM, (unsigned char*)H + (size_t)m * DM, RS2 + m, lane); }
    SEAM(7);
    if (IN(8)) { PH_WS pg8::EpiSwiGLU<FP8_DOWN2 != 0> E{ACT, DFF, RS2, CM + 2 * DFF, CM + 3 * DFF, 1.f / 127.f}; run_gemm<pg8::EpiSwiGLU<FP8_DOWN2 != 0>, 2>(lds, H, DM, W2U, DM, T, 2 * DFF, DM, E, wv); }
    SEAM(8);
    if (IN(9)) { PH_WS pg8::EpiResid<true, false, 1, true, FP8_DOWN2 != 0, true, false> E{X2B, nullptr, DM, H2, SS3, nullptr, CM + 4 * DFF, 1.f / (W8MAX * ACT8SCALE)}; run_gemm<pg8::EpiResid<true, false, 1, true, FP8_DOWN2 != 0, true, false>, FP8_DOWN2 ? 1 : 0>(lds, ACT, DFF, W2D, DFF, T, DM, DFF, E, wv); }
    SEAM(9);
    if (IN(10)) {
        PH_WS LANE_INIT
        for (int m = gw; m < T; m += NGW) { const u32x4* hr = (const u32x4*)(H2 + (size_t)m * DM) + lane; f32x4* xr = (f32x4*)(X + (size_t)m * DM); const float rs = __builtin_amdgcn_rsqf(pg8::ss_get(SS3 + m) * (1.f / DM) + EPS);
            u32x4 w[4];
#pragma unroll
            for (int j = 0; j < 4; ++j) w[j] = hr[64 * j];
#pragma unroll
            for (int j = 0; j < 4; ++j) { float f[8]; unpack8(w[j], f); const int c8 = (lane + 64 * j) * 2; const f32x4 g0 = ((const f32x4*)g_final)[c8], g1 = ((const f32x4*)g_final)[c8 + 1];
                xr[c8] = (f32x4){f[0] * rs * g0.x, f[1] * rs * g0.y, f[2] * rs * g0.z, f[3] * rs * g0.w}; xr[c8 + 1] = (f32x4){f[4] * rs * g1.x, f[5] * rs * g1.y, f[6] * rs * g1.z, f[7] * rs * g1.w}; } }
    }
#undef IN
#undef SEAM
}

extern "C" void kernel_launch(void* const* d_in, const int* in_sizes, int n_in, void* d_out, int out_size, void* d_ws, size_t ws_size, hipStream_t stream) {
    static int grid = 0;
    if (grid == 0) {
        if (n_in != 23 || out_size != T * DM || ws_size < WS_END) { fprintf(stderr, "kernel_launch: unexpected shapes: n_in %d out %d ws %zu\n", n_in, out_size, ws_size); grid = -1; return; }
        int dev = 0, cus = 0, per_cu = 0;
        if (hipGetDevice(&dev) != hipSuccess || hipDeviceGetAttribute(&cus, hipDeviceAttributeMultiprocessorCount, dev) != hipSuccess) { grid = -1; return; }
        if (hipFuncSetAttribute((const void*)mk_fwd, hipFuncAttributeMaxDynamicSharedMemorySize, LDS_BYTES) != hipSuccess) { fprintf(stderr, "kernel_launch: hipFuncSetAttribute failed\n"); grid = -1; return; }
        if (hipOccupancyMaxActiveBlocksPerMultiprocessor(&per_cu, (const void*)mk_fwd, 512, LDS_BYTES) != hipSuccess || per_cu < 1) { fprintf(stderr, "kernel_launch: occupancy query says %d\n", per_cu); per_cu = 1; }
        (void)hipGetLastError();
        grid = cus * per_cu;
    }
    if (grid < 0) return;
    if (hipMemsetAsync((char*)d_ws + WS_CM, 0, CM_BYTES, stream) != hipSuccess) { fprintf(stderr, "kernel_launch: hipMemsetAsync failed\n"); return; }
    Args a{};
    for (int i = 0; i < 23; ++i) a.in[i] = (const float*)d_in[i];
    a.out = (float*)d_out; a.ws = (unsigned char*)d_ws;
    a.ph_lo = 0; a.ph_hi = NPHASE;
    void* kargs[] = {&a};
    hipError_t e = hipLaunchCooperativeKernel((const void*)mk_fwd, dim3(grid), dim3(512), kargs, LDS_BYTES, stream);
    if (e != hipSuccess) fprintf(stderr, "cooperative launch failed: %s (grid %d)\n", hipGetErrorString(e), grid);
}
```

```cpp
#include <hip/hip_runtime.h>
#include <hip/hip_cooperative_groups.h>
#include <cstdio>
#include <cstdint>
namespace cg = cooperative_groups;

#ifndef FP8_FFN1
#define FP8_FFN1 0
#endif
#ifndef FP8_FFN2
#define FP8_FFN2 1
#endif
constexpr float W8SCALE = 32.f;
#ifndef FP8_DOWN2
#define FP8_DOWN2 1
#endif
constexpr float ACT8SCALE = 8.f, W8MAX = 256.f;
#ifndef MK_ONE_LAUNCH
#define MK_ONE_LAUNCH 1
#endif

__device__ __forceinline__ int tid_of(int wv) { int l; asm volatile("v_mbcnt_lo_u32_b32 %0, -1, 0\n\tv_mbcnt_hi_u32_b32 %0, -1, %0" : "=v"(l)); return wv * 64 + l; }
template <int MASK> __device__ __forceinline__ float xor_get(float v) { return __int_as_float(__builtin_amdgcn_ds_swizzle(__float_as_int(v), 0x1F | (MASK << 10))); }
__device__ __forceinline__ float xor32_sum(float v) { auto rr = __builtin_amdgcn_permlane32_swap(__float_as_uint(v), __float_as_uint(v), false, false); return __uint_as_float(rr[0]) + __uint_as_float(rr[1]); }
namespace pg8 {
#define PG8_LAS __attribute__((address_space(3)))
typedef unsigned short bf16_t;
typedef short bf16x8 __attribute__((ext_vector_type(8)));
typedef float f32x4 __attribute__((ext_vector_type(4)));
typedef unsigned u32x4 __attribute__((ext_vector_type(4)));
constexpr int BM = 256, BK = 64, HALF = 128, HTB = HALF * BK * 2, STAGE_BYTES = 8 * HTB, NXCD = 8, WGM = 4;

__host__ __device__ __forceinline__ int lds_byte(int r, int c) { const int st = (r >> 4) * 2 + (c >> 5), rr = r & 15, cc = c & 31, ob = rr * 64 + cc * 2; return st * 1024 + (ob ^ (((ob >> 9) & 1) << 5)); }
__host__ __device__ __forceinline__ void stage_rc(int b, int& R, int& C) { const int st = b / 1024, sb = b % 1024, swz = sb ^ (((sb >> 9) & 1) << 5); R = (st >> 1) * 16 + swz / 64; C = (st & 1) * 32 + (swz % 64) / 2; }
__host__ __device__ __forceinline__ int perm32(int rho) { const int n = rho >> 4, i = rho & 15; return 8 * (i >> 2) + 4 * n + (i & 3); }

typedef unsigned long long u64;
constexpr float SSFIX = 1048576.f;
__device__ __forceinline__ float ss_get(const u64* p) { return (float)(*p) * (1.f / SSFIX); }
__device__ __forceinline__ void ss_add(u64* p, float v) { atomicAdd(p, (u64)(v * SSFIX)); }
struct Unit { int pm, pn; };
struct Gemm { const void* A; const void* Bt; int M, N, K, lda, ldb; };
typedef int i32x4 __attribute__((ext_vector_type(4)));
typedef int i32x8 __attribute__((ext_vector_type(8)));
__device__ __forceinline__ i32x8 cat8(bf16x8 lo, bf16x8 hi) { return __builtin_shufflevector(__builtin_bit_cast(i32x4, lo), __builtin_bit_cast(i32x4, hi), 0, 1, 2, 3, 4, 5, 6, 7); }

struct StaticOrder {
    int nM, nN, nwg, G, c, base, stride, cnt;
    __host__ __device__ void init(int M, int N, int G_, int c_) { nM = M / BM; nN = N / BM; nwg = nM * nN; G = G_; c = c_; base = c_; stride = G_; cnt = 0x7fffffff; }
    __host__ __device__ bool next(int i, Unit& u) const {
        if (i >= cnt) return false;
        const long L = (long)i * stride + base; if (L >= nwg) return false;
        int wgid = (int)L; { const int q = nwg / NXCD, r = nwg % NXCD, xcd = wgid % NXCD, off = wgid / NXCD; wgid = (xcd < r ? xcd * (q + 1) : r * (q + 1) + (xcd - r) * q) + off; }
        const int nig = WGM * nN, gid = wgid / nig, fm = gid * WGM, gsz = (nM - fm) < WGM ? (nM - fm) : WGM;
        u.pm = fm + ((wgid % nig) % gsz); u.pn = (wgid % nig) / gsz; return true;
    }
    __device__ __forceinline__ void a_ready(const Unit&) const {}
    __device__ __forceinline__ void done(const Unit&) const {}
};

__device__ __forceinline__ unsigned cvt_pk_bf16(float lo, float hi) { unsigned r; asm volatile("v_cvt_pk_bf16_f32 %0, %1, %2" : "=v"(r) : "v"(lo), "v"(hi)); return r; }

struct EpiBf16 {
    static constexpr bool PERM = true, AFTER_DRAIN = false;
    bf16_t* O; int ldc; const u64* ss; float inv_n;
    __device__ __forceinline__ void operator()(const f32x4 (&acc)[2][2][4][2], const Unit& u, int wr, int wc, int fr, int fq) const {
        const int row0 = u.pm * BM + wr * 64 + fr; const int col0 = u.pn * BM + wc * 32 + 8 * fq;
#pragma unroll
        for (int ai = 0; ai < 2; ++ai)
#pragma unroll
            for (int m = 0; m < 4; ++m) { const int row = row0 + ai * HALF + m * 16; bf16_t* rowp = O + (size_t)row * ldc + col0;
                const float rs = ss ? __builtin_amdgcn_rsqf(ss_get(ss + row) * inv_n + 1e-6f) : 1.f;
#pragma unroll
                for (int bj = 0; bj < 2; ++bj) { const f32x4 v0 = acc[ai][bj][m][0] * rs, v1 = acc[ai][bj][m][1] * rs;
                    u32x4 w; w.x = cvt_pk_bf16(v0[0], v0[1]); w.y = cvt_pk_bf16(v0[2], v0[3]); w.z = cvt_pk_bf16(v1[0], v1[1]); w.w = cvt_pk_bf16(v1[2], v1[3]);
                    *(u32x4*)(rowp + bj * HALF) = w; } }
    }
};
__device__ __forceinline__ float gelu_t(float x) { const float t = -2.302208198f * (x + 0.044715f * x * x * x); return x * __builtin_amdgcn_rcpf(1.0f + __builtin_amdgcn_exp2f(t)); }
__device__ __forceinline__ void rope8(f32x4& v0, f32x4& v1, const float* rp, int i0) {
    const f32x4 cs = *(const f32x4*)(rp + i0), sn = *(const f32x4*)(rp + 32 + i0);
    f32x4 a, b; a[0] = v0[0] * cs[0] - v0[1] * sn[0]; a[1] = v0[0] * sn[0] + v0[1] * cs[0]; a[2] = v0[2] * cs[1] - v0[3] * sn[1]; a[3] = v0[2] * sn[1] + v0[3] * cs[1];
    b[0] = v1[0] * cs[2] - v1[1] * sn[2]; b[1] = v1[0] * sn[2] + v1[1] * cs[2]; b[2] = v1[2] * cs[3] - v1[3] * sn[3]; b[3] = v1[2] * sn[3] + v1[3] * cs[3]; v0 = a; v1 = b;
}
struct EpiZ {
    static constexpr bool PERM = true, AFTER_DRAIN = false;
    bf16_t* O; int ldc; const u64* ssx; u64* ssq; u64* sskv; const float* rope;
    __device__ __forceinline__ void operator()(const f32x4 (&acc)[2][2][4][2], const Unit& u, int wr, int wc, int fr, int fq) const {
        const int row0 = u.pm * BM + wr * 64 + fr; const int col0 = u.pn * BM + wc * 32 + 8 * fq; const int pn = u.pn;
#pragma unroll
        for (int ai = 0; ai < 2; ++ai)
#pragma unroll
            for (int m = 0; m < 4; ++m) { const int row = row0 + ai * HALF + m * 16; bf16_t* rowp = O + (size_t)row * ldc + col0;
                const float rs = __builtin_amdgcn_rsqf(ss_get(ssx + row) * (1.f / 2048.f) + 1e-6f); float sq = 0.f;
#pragma unroll
                for (int bj = 0; bj < 2; ++bj) { f32x4 v0 = acc[ai][bj][m][0] * rs, v1 = acc[ai][bj][m][1] * rs;
                    if (pn < 4) { sq += (v0[0] * v0[0] + v0[1] * v0[1]) + (v0[2] * v0[2] + v0[3] * v0[3]) + (v1[0] * v1[0] + v1[1] * v1[1]) + (v1[2] * v1[2] + v1[3] * v1[3]); }
                    else if (pn == 4) { if (bj == 0 && wc < 2) { const int pos = row < 8192 ? row : (row & 2047); rope8(v0, v1, rope + (size_t)pos * 64, (wc * 32 + 8 * fq) >> 1); } }
                    else {
#pragma unroll
                        for (int e = 0; e < 4; ++e) { v0[e] = gelu_t(v0[e]); v1[e] = gelu_t(v1[e]); } }
                    u32x4 w; w.x = cvt_pk_bf16(v0[0], v0[1]); w.y = cvt_pk_bf16(v0[2], v0[3]); w.z = cvt_pk_bf16(v1[0], v1[1]); w.w = cvt_pk_bf16(v1[2], v1[3]);
                    *(u32x4*)(rowp + bj * HALF) = w; }
                if (pn < 4) { sq += xor_get<16>(sq); sq = xor32_sum(sq); if (fq == 0) ss_add((pn < 2 ? ssq : sskv) + row, sq); } }
    }
};
struct EpiQRope {
    static constexpr bool PERM = true, AFTER_DRAIN = false;
    bf16_t* O; int ldc; const float* rope; const u64* ss;
    __device__ __forceinline__ void operator()(const f32x4 (&acc)[2][2][4][2], const Unit& u, int wr, int wc, int fr, int fq) const {
        const int row0 = u.pm * BM + wr * 64 + fr; const int col0 = u.pn * BM + wc * 32 + 8 * fq;
#pragma unroll
        for (int ai = 0; ai < 2; ++ai)
#pragma unroll
            for (int m = 0; m < 4; ++m) { const int row = row0 + ai * HALF + m * 16; bf16_t* rowp = O + (size_t)row * ldc + col0;
                const int pos = row < 8192 ? row : (row & 2047); const float rs = __builtin_amdgcn_rsqf(ss_get(ss + row) * (1.f / 512.f) + 1e-6f);
#pragma unroll
                for (int bj = 0; bj < 2; ++bj) { f32x4 v0 = acc[ai][bj][m][0] * rs, v1 = acc[ai][bj][m][1] * rs;
                    const int c = col0 + bj * HALF; const int d = c % 192;
                    if (d >= 128) rope8(v0, v1, rope + (size_t)pos * 64, (d - 128) >> 1);
                    u32x4 w; w.x = cvt_pk_bf16(v0[0], v0[1]); w.y = cvt_pk_bf16(v0[2], v0[3]); w.z = cvt_pk_bf16(v1[0], v1[1]); w.w = cvt_pk_bf16(v1[2], v1[3]);
                    *(u32x4*)(rowp + bj * HALF) = w; } }
    }
};
template <bool OUT8 = false> struct EpiSwiGLU {
    static constexpr bool PERM = true, AFTER_DRAIN = false;
    bf16_t* O; int ldc; const float* rsc; const float* cmg; const float* cmu; float cscale;
    __device__ __forceinline__ void operator()(const f32x4 (&acc)[2][2][4][2], const Unit& u, int wr, int wc, int fr, int fq) const {
        const int row0 = u.pm * BM + wr * 64 + fr; const int col0 = u.pn * HALF + wc * 32 + 8 * fq;
        f32x4 sg[2], su[2];
#pragma unroll
        for (int n = 0; n < 2; ++n) { sg[n] = cmg ? *(const f32x4*)(cmg + col0 + 4 * n) * cscale : (f32x4){1.f, 1.f, 1.f, 1.f}; su[n] = cmu ? *(const f32x4*)(cmu + col0 + 4 * n) * cscale : (f32x4){1.f, 1.f, 1.f, 1.f}; }
#pragma unroll
        for (int ai = 0; ai < 2; ++ai)
#pragma unroll
            for (int m = 0; m < 4; ++m) { const int row = row0 + ai * HALF + m * 16; bf16_t* rowp = O + (size_t)row * ldc + col0;
                const float rs = rsc ? rsc[row] : 1.f;
                f32x4 r[2];
#pragma unroll
                for (int n = 0; n < 2; ++n) { const f32x4 g = acc[ai][0][m][n] * sg[n] * rs, up = acc[ai][1][m][n] * su[n] * rs;
#pragma unroll
                    for (int e = 0; e < 4; ++e) { const float sgm = __builtin_amdgcn_rcpf(1.0f + __builtin_amdgcn_exp2f(-1.4426950408889634f * g[e])); r[n][e] = g[e] * sgm * up[e]; } }
                if constexpr (OUT8) { typedef unsigned u32x2v __attribute__((ext_vector_type(2))); _Pragma("unroll") for (int e = 0; e < 4; ++e) { r[0][e] = __builtin_amdgcn_fmed3f(r[0][e] * ACT8SCALE, -448.f, 448.f); r[1][e] = __builtin_amdgcn_fmed3f(r[1][e] * ACT8SCALE, -448.f, 448.f); }

                    int w0 = __builtin_amdgcn_cvt_pk_fp8_f32(r[0][0], r[0][1], 0, false); w0 = __builtin_amdgcn_cvt_pk_fp8_f32(r[0][2], r[0][3], w0, true);
                    int w1 = __builtin_amdgcn_cvt_pk_fp8_f32(r[1][0], r[1][1], 0, false); w1 = __builtin_amdgcn_cvt_pk_fp8_f32(r[1][2], r[1][3], w1, true);
                    *(u32x2v*)((unsigned char*)O + (size_t)row * ldc + col0) = (u32x2v){(unsigned)w0, (unsigned)w1}; }
                else { u32x4 w; w.x = cvt_pk_bf16(r[0][0], r[0][1]); w.y = cvt_pk_bf16(r[0][2], r[0][3]); w.z = cvt_pk_bf16(r[1][0], r[1][1]); w.w = cvt_pk_bf16(r[1][2], r[1][3]);
                    *(u32x4*)rowp = w; } }
    }
};
template <bool HAS_XB, bool HAS_X8, int ALPHA2, bool HAS_SS = true, bool HAS_CS = false, bool BASE16 = false, bool HAS_OUT = true> struct EpiResid {
    static constexpr bool PERM = true, AFTER_DRAIN = false; static constexpr float alpha = 0.5f * ALPHA2;
    const void* base; float* out; int ldc; bf16_t* xb; u64* ss; unsigned char* x8; const float* cs; float csmul;
    __device__ __forceinline__ void operator()(const f32x4 (&acc)[2][2][4][2], const Unit& u, int wr, int wc, int fr, int fq) const {
        const int row0 = u.pm * BM + wr * 64 + fr; const int col0 = u.pn * BM + wc * 32 + 8 * fq;
        f32x4 csv[2][2];
#pragma unroll
        for (int bj = 0; bj < 2; ++bj)
#pragma unroll
            for (int n = 0; n < 2; ++n) csv[bj][n] = HAS_CS ? *(const f32x4*)(cs + col0 + bj * HALF + 4 * n) * (csmul * alpha) : (f32x4){alpha, alpha, alpha, alpha};
#pragma unroll
        for (int ai = 0; ai < 2; ++ai)
#pragma unroll
            for (int m = 0; m < 4; ++m) { const int row = row0 + ai * HALF + m * 16; const size_t off = (size_t)row * ldc + col0; float sq = 0.f;
#pragma unroll
                for (int bj = 0; bj < 2; ++bj) { const size_t p = off + bj * HALF; f32x4 b0, b1;
                    if constexpr (BASE16) { const u32x4 wb = *(const u32x4*)((const bf16_t*)base + p);
                        b0 = (f32x4){__uint_as_float(wb.x << 16), __uint_as_float(wb.x & 0xffff0000u), __uint_as_float(wb.y << 16), __uint_as_float(wb.y & 0xffff0000u)};
                        b1 = (f32x4){__uint_as_float(wb.z << 16), __uint_as_float(wb.z & 0xffff0000u), __uint_as_float(wb.w << 16), __uint_as_float(wb.w & 0xffff0000u)}; }
                    else { b0 = *(const f32x4*)((const float*)base + p); b1 = *(const f32x4*)((const float*)base + p + 4); }
                    const f32x4 v0 = b0 + acc[ai][bj][m][0] * csv[bj][0], v1 = b1 + acc[ai][bj][m][1] * csv[bj][1];
                    if constexpr (HAS_OUT) { *(f32x4*)(out + p) = v0; *(f32x4*)(out + p + 4) = v1; }
                    if constexpr (HAS_XB) { u32x4 w; w.x = cvt_pk_bf16(v0[0], v0[1]); w.y = cvt_pk_bf16(v0[2], v0[3]); w.z = cvt_pk_bf16(v1[0], v1[1]); w.w = cvt_pk_bf16(v1[2], v1[3]); *(u32x4*)(xb + p) = w; }
                    sq += ((v0[0] * v0[0] + v0[1] * v0[1]) + (v0[2] * v0[2] + v0[3] * v0[3])) + ((v1[0] * v1[0] + v1[1] * v1[1]) + (v1[2] * v1[2] + v1[3] * v1[3])); }
                if constexpr (HAS_SS) { sq += xor_get<16>(sq); sq = xor32_sum(sq); if (fq == 0) ss_add(ss + row, sq); } }
    }
};

struct EpiMix {
    static constexpr bool PERM = true, AFTER_DRAIN = false;
    const bf16_t* base; bf16_t* xb; int ldc; const u64* ssa; const u64* ssg;
    __device__ __forceinline__ void mid(f32x4 (&acc)[2][2][4][2], const Unit& u, int wr, int fr) const {
        const int row0 = u.pm * BM + wr * 64 + fr;
#pragma unroll
        for (int ai = 0; ai < 2; ++ai)
#pragma unroll
            for (int m = 0; m < 4; ++m) { const int row = row0 + ai * HALF + m * 16;
                const float ra = __builtin_amdgcn_rsqf(ss_get(ssa + row) * (1.f / 1024.f) + 1e-6f), rg = __builtin_amdgcn_rsqf(ss_get(ssg + row) * (1.f / 1024.f) + 1e-6f);
                const float ratio = ra * __builtin_amdgcn_rcpf(rg);
#pragma unroll
                for (int bj = 0; bj < 2; ++bj)
#pragma unroll
                    for (int n = 0; n < 2; ++n) acc[ai][bj][m][n] = acc[ai][bj][m][n] * ratio; }
    }
    __device__ __forceinline__ void operator()(const f32x4 (&acc)[2][2][4][2], const Unit& u, int wr, int wc, int fr, int fq) const {
        const int row0 = u.pm * BM + wr * 64 + fr; const int col0 = u.pn * BM + wc * 32 + 8 * fq;
#pragma unroll
        for (int ai = 0; ai < 2; ++ai)
#pragma unroll
            for (int m = 0; m < 4; ++m) { const int row = row0 + ai * HALF + m * 16; const size_t off = (size_t)row * ldc + col0;
                const float rg = __builtin_amdgcn_rsqf(ss_get(ssg + row) * (1.f / 1024.f) + 1e-6f);
#pragma unroll
                for (int bj = 0; bj < 2; ++bj) { const size_t p = off + bj * HALF; const u32x4 wb = *(const u32x4*)(base + p);
                    const f32x4 b0 = {__uint_as_float(wb.x << 16), __uint_as_float(wb.x & 0xffff0000u), __uint_as_float(wb.y << 16), __uint_as_float(wb.y & 0xffff0000u)};
                    const f32x4 b1 = {__uint_as_float(wb.z << 16), __uint_as_float(wb.z & 0xffff0000u), __uint_as_float(wb.w << 16), __uint_as_float(wb.w & 0xffff0000u)};
                    const f32x4 v0 = b0 + acc[ai][bj][m][0] * rg, v1 = b1 + acc[ai][bj][m][1] * rg;
                    u32x4 w; w.x = cvt_pk_bf16(v0[0], v0[1]); w.y = cvt_pk_bf16(v0[2], v0[3]); w.z = cvt_pk_bf16(v1[0], v1[1]); w.w = cvt_pk_bf16(v1[2], v1[3]); *(u32x4*)(xb + p) = w; } }
    }
};

template <class Epi, class Sched, bool ALIGN_EPI = false, bool SP2 = false, int MODE = 0, bool MID = false>
__device__ __forceinline__ void gemm_phase(PG8_LAS unsigned char* lds, const Gemm g, const Sched S, const Epi E, const int wv) {
    const int tid = tid_of(wv), wid = __builtin_amdgcn_readfirstlane(tid >> 6), lane = tid & 63, wr = wid >> 2, wc = wid & 3, fr = lane & 15, fq = lane >> 4;
    constexpr bool FP8 = MODE == 1, BYTE_ELEMS = MODE != 0; constexpr int ES = BYTE_ELEMS ? 1 : 2;
    const int K = g.K, nt = K * ES / 128;
    unsigned voffA[2], voffB[2];
#pragma unroll
    for (int i = 0; i < 2; ++i) { int R, C; stage_rc(tid * 16 + i * 8192, R, C); const int Rb = Epi::PERM ? ((R & ~31) + perm32(R & 31)) : R;
        voffA[i] = (unsigned)(R * g.lda * ES + C * 2); voffB[i] = (unsigned)(Rb * g.ldb * ES + C * 2); }
    const size_t roffA = (size_t)64 * g.lda * ES, roffB = (size_t)64 * g.ldb * ES;
    const size_t kstep = (size_t)(BK * 2);
    const size_t hstepA = (size_t)HALF * g.lda * ES, hstepB = (size_t)HALF * g.ldb * ES;
    const size_t tstepA = 2 * hstepA, tstepB = 2 * hstepB;
    const unsigned ldsw = (unsigned)wid * 1024u;
    const int aoff = lds_byte(wr * 64 + fr, fq * 8), boff = lds_byte(wc * 32 + fr, fq * 8);
#define PG8_SA(b, h) (((b) * 2 + (h)) * HTB)
#define PG8_SB(b, h) ((4 + (b) * 2 + (h)) * HTB)
#define PG8_STAGE(bufoff, gbase, voff) do { _Pragma("unroll") for (int _i = 0; _i < 2; ++_i) \
        __builtin_amdgcn_global_load_lds((const unsigned*)((const char*)(gbase) + (BYTE_ELEMS ? _i * r##voff + (v##voff)[0] : (v##voff)[_i])), (PG8_LAS unsigned*)(lds + (bufoff) + ldsw + _i * 8192), 16, 0, 0); } while (0)
#define PG8_LDA(dst, b, h) do { _Pragma("unroll") for (int m = 0; m < 4; ++m) _Pragma("unroll") for (int k = 0; k < 2; ++k) dst[m][k] = *(const PG8_LAS bf16x8*)(lds + PG8_SA(b, h) + aoff + m * 2048 + k * 1024); } while (0)
#define PG8_LDB(dst, b, h) do { _Pragma("unroll") for (int n = 0; n < 2; ++n) _Pragma("unroll") for (int k = 0; k < 2; ++k) dst[n][k] = *(const PG8_LAS bf16x8*)(lds + PG8_SB(b, h) + boff + n * 2048 + k * 1024); } while (0)
#define PG8_MMA(ai, bj, At, Bt) do { __builtin_amdgcn_s_setprio(1); if constexpr (FP8) { _Pragma("unroll") for (int m = 0; m < 4; ++m) _Pragma("unroll") for (int n = 0; n < 2; ++n) \
        acc[ai][bj][m][n] = __builtin_amdgcn_mfma_scale_f32_16x16x128_f8f6f4(cat8(Bt[n][0], Bt[n][1]), cat8(At[m][0], At[m][1]), acc[ai][bj][m][n], 0, 0, 0, 0, 0, 0); } \
      else if constexpr (MODE == 2) { _Pragma("unroll") for (int m = 0; m < 4; ++m) _Pragma("unroll") for (int n = 0; n < 2; ++n) _Pragma("unroll") for (int k = 0; k < 2; ++k) \
        acc[ai][bj][m][n] = __builtin_bit_cast(f32x4, __builtin_amdgcn_mfma_i32_16x16x64_i8(__builtin_bit_cast(i32x4, Bt[n][k]), __builtin_bit_cast(i32x4, At[m][k]), __builtin_bit_cast(i32x4, acc[ai][bj][m][n]), 0, 0, 0)); } \
      else { _Pragma("unroll") for (int m = 0; m < 4; ++m) _Pragma("unroll") for (int n = 0; n < 2; ++n) _Pragma("unroll") for (int k = 0; k < 2; ++k) \
        acc[ai][bj][m][n] = __builtin_amdgcn_mfma_f32_16x16x32_bf16(Bt[n][k], At[m][k], acc[ai][bj][m][n], 0, 0, 0); } __builtin_amdgcn_s_setprio(0); } while (0)
#define PG8_WAIT_V(n) asm volatile("s_waitcnt vmcnt(" #n ")" ::: "memory")
#define PG8_WAIT_L(n) asm volatile("s_waitcnt lgkmcnt(" #n ")" ::: "memory")
#define PG8_BAR __builtin_amdgcn_s_barrier()
#define PG8_SCHED __builtin_amdgcn_sched_barrier(0)
    Unit cur, nxt; int ui = 0;
    if (!S.next(0, cur)) return;
    f32x4 acc[2][2][4][2];
#pragma unroll
    for (int a = 0; a < 2; ++a)
#pragma unroll
        for (int b = 0; b < 2; ++b)
#pragma unroll
            for (int m = 0; m < 4; ++m)
#pragma unroll
                for (int n = 0; n < 2; ++n) acc[a][b][m][n] = (f32x4){0.f, 0.f, 0.f, 0.f};
    bf16x8 At[4][2], B0[2][2], B1[2][2];
    const char* cA = (const char*)g.A + (size_t)cur.pm * tstepA; const char* cB = (const char*)g.Bt + (size_t)cur.pn * tstepB;
    S.a_ready(cur);
    if constexpr (SP2) {
        PG8_STAGE(PG8_SB(0, 0), cB, offB); PG8_STAGE(PG8_SB(0, 1), cB + hstepB, offB); PG8_STAGE(PG8_SA(0, 0), cA, offA); PG8_STAGE(PG8_SA(0, 1), cA + hstepA, offA);
        if (wr == 1) PG8_BAR;
        PG8_WAIT_V(2); PG8_BAR;
        PG8_STAGE(PG8_SB(1, 0), cB + kstep, offB); PG8_STAGE(PG8_SA(1, 0), cA + kstep, offA); PG8_STAGE(PG8_SB(1, 1), cB + hstepB + kstep, offB);
        PG8_WAIT_V(6); PG8_BAR;
    } else {
        PG8_STAGE(PG8_SB(0, 0), cB, offB); PG8_STAGE(PG8_SA(0, 0), cA, offA); PG8_STAGE(PG8_SB(0, 1), cB + hstepB, offB); PG8_STAGE(PG8_SA(0, 1), cA + hstepA, offA);
        if (wr == 1) PG8_BAR;
        PG8_WAIT_V(4); PG8_BAR;
        PG8_STAGE(PG8_SB(1, 0), cB + kstep, offB); PG8_STAGE(PG8_SA(1, 0), cA + kstep, offA); PG8_STAGE(PG8_SB(1, 1), cB + hstepB + kstep, offB);
        PG8_WAIT_V(6); PG8_BAR;
    }
    for (;;) {
        const bool has_next = S.next(ui + 1, nxt);
        const char* nA = has_next ? (const char*)g.A + (size_t)nxt.pm * tstepA : cA; const char* nB = has_next ? (const char*)g.Bt + (size_t)nxt.pn * tstepB : cB;
        for (int t = 0; t < nt; t += 2) {
            const bool last = (t == nt - 2);
            const char* a1 = cA + (size_t)(t + 1) * kstep;
            const char* a2 = last ? nA : cA + (size_t)(t + 2) * kstep; const char* b2 = last ? nB : cB + (size_t)(t + 2) * kstep;
            const char* a3 = a2 + kstep; const char* b3 = b2 + kstep;
            if (last && has_next) S.a_ready(nxt);
            if constexpr (MID) { if (t == nt / 2) { const int t3 = tid_of(wv); E.mid(acc, cur, wid >> 2, t3 & 15); } }
            if constexpr (SP2) {
            PG8_LDB(B0, 0, 0); PG8_LDB(B1, 0, 1); PG8_SCHED; PG8_LDA(At, 0, 0); PG8_STAGE(PG8_SA(1, 1), a1 + hstepA, offA);
            PG8_WAIT_V(8); PG8_WAIT_L(0); PG8_BAR; PG8_MMA(0, 0, At, B0); PG8_MMA(0, 1, At, B1); PG8_BAR; PG8_SCHED;
            PG8_LDA(At, 0, 1); PG8_STAGE(PG8_SB(0, 0), b2, offB); PG8_STAGE(PG8_SB(0, 1), b2 + hstepB, offB); PG8_STAGE(PG8_SA(0, 0), a2, offA);
            PG8_WAIT_V(8); PG8_WAIT_L(0); PG8_BAR; PG8_MMA(1, 0, At, B0); PG8_MMA(1, 1, At, B1); PG8_BAR; PG8_SCHED;
            PG8_LDB(B0, 1, 0); PG8_LDB(B1, 1, 1); PG8_SCHED; PG8_LDA(At, 1, 0); PG8_STAGE(PG8_SA(0, 1), a2 + hstepA, offA);
            PG8_WAIT_V(8); PG8_WAIT_L(0); PG8_BAR; PG8_MMA(0, 0, At, B0); PG8_MMA(0, 1, At, B1); PG8_BAR; PG8_SCHED;
            PG8_LDA(At, 1, 1); PG8_STAGE(PG8_SB(1, 0), b3, offB); PG8_STAGE(PG8_SB(1, 1), b3 + hstepB, offB); PG8_STAGE(PG8_SA(1, 0), a3, offA);
            PG8_WAIT_V(8); PG8_WAIT_L(0); PG8_BAR; PG8_MMA(1, 0, At, B0); PG8_MMA(1, 1, At, B1); PG8_BAR; PG8_SCHED;
            } else {
            PG8_LDB(B0, 0, 0); PG8_SCHED; PG8_LDA(At, 0, 0); PG8_STAGE(PG8_SA(1, 1), a1 + hstepA, offA);
            PG8_WAIT_L(8); PG8_BAR; PG8_WAIT_L(0); PG8_MMA(0, 0, At, B0); PG8_BAR; PG8_SCHED;
            PG8_LDB(B1, 0, 1); PG8_STAGE(PG8_SB(0, 0), b2, offB);
            PG8_BAR; PG8_WAIT_L(0); PG8_MMA(0, 1, At, B1); PG8_BAR;
            PG8_LDA(At, 0, 1); PG8_STAGE(PG8_SA(0, 0), a2, offA);
            PG8_BAR; PG8_WAIT_L(0); PG8_MMA(1, 0, At, B0); PG8_BAR; PG8_SCHED;
            PG8_STAGE(PG8_SB(0, 1), b2 + hstepB, offB);
            PG8_WAIT_V(6); PG8_BAR; PG8_MMA(1, 1, At, B1); PG8_BAR;
            PG8_LDB(B0, 1, 0); PG8_SCHED; PG8_LDA(At, 1, 0); PG8_STAGE(PG8_SA(0, 1), a2 + hstepA, offA);
            PG8_WAIT_L(8); PG8_BAR; PG8_WAIT_L(0); PG8_MMA(0, 0, At, B0); PG8_BAR; PG8_SCHED;
            PG8_LDB(B1, 1, 1); PG8_STAGE(PG8_SB(1, 0), b3, offB);
            PG8_BAR; PG8_WAIT_L(0); PG8_MMA(0, 1, At, B1); PG8_BAR;
            PG8_LDA(At, 1, 1); PG8_STAGE(PG8_SA(1, 0), a3, offA);
            PG8_BAR; PG8_WAIT_L(0); PG8_MMA(1, 0, At, B0); PG8_BAR; PG8_SCHED;
            PG8_STAGE(PG8_SB(1, 1), b3 + hstepB, offB);
            PG8_WAIT_V(6); PG8_BAR; PG8_MMA(1, 1, At, B1); PG8_BAR;
            }
        }
        if constexpr (ALIGN_EPI) { if (wr == 0) PG8_BAR; }
        if constexpr (MODE == 2) {
#pragma unroll
            for (int a = 0; a < 2; ++a)
#pragma unroll
                for (int b = 0; b < 2; ++b)
#pragma unroll
                    for (int m = 0; m < 4; ++m)
#pragma unroll
                        for (int n = 0; n < 2; ++n) { const i32x4 iv = __builtin_bit_cast(i32x4, acc[a][b][m][n]); acc[a][b][m][n] = (f32x4){(float)iv[0], (float)iv[1], (float)iv[2], (float)iv[3]}; } }
        if constexpr (!Epi::AFTER_DRAIN) { const int t2 = tid_of(wv), l2 = t2 & 63; E(acc, cur, wid >> 2, wid & 3, l2 & 15, l2 >> 4); S.done(cur); }
        if (!has_next) break;
#pragma unroll
        for (int a = 0; a < 2; ++a)
#pragma unroll
            for (int b = 0; b < 2; ++b)
#pragma unroll
                for (int m = 0; m < 4; ++m)
#pragma unroll
                    for (int n = 0; n < 2; ++n) acc[a][b][m][n] = (f32x4){0.f, 0.f, 0.f, 0.f};
        cur = nxt; cA = nA; cB = nB; ++ui;
        if constexpr (ALIGN_EPI) { if (wr == 1) PG8_BAR; }
    }
    PG8_WAIT_V(0);
    if constexpr (!ALIGN_EPI) { if (wr == 0) PG8_BAR; }
    PG8_BAR;
#undef PG8_SA
#undef PG8_SB
#undef PG8_STAGE
#undef PG8_LDA
#undef PG8_LDB
#undef PG8_MMA
#undef PG8_WAIT_V
#undef PG8_WAIT_L
#undef PG8_BAR
#undef PG8_SCHED
}
}

typedef unsigned short bf16;
typedef float f32x4 __attribute__((ext_vector_type(4)));
typedef unsigned u32x4 __attribute__((ext_vector_type(4)));
typedef unsigned u32x2 __attribute__((ext_vector_type(2)));
typedef short bf16x8 __attribute__((ext_vector_type(8)));
typedef short s16x4 __attribute__((ext_vector_type(4)));
typedef float f32x16 __attribute__((ext_vector_type(16)));
#define LAS __attribute__((address_space(3)))

constexpr int DM = 2048, DFF = 5632, TP = 8192, TS = 16 * 2048, T = TP + TS;
constexpr int ZW = 3328;
constexpr int Z_KR = 1024, Z_U = 1280, Z_V = 2304;
constexpr int QW = 1536, KVW = 2048;
constexpr float EPS = 1e-6f;
constexpr size_t MiB = 1u << 20;
constexpr size_t WS_ROPE = 1 * MiB;
constexpr size_t WS_W1U = 4 * MiB, WS_W1D = WS_W1U + 44 * MiB, WS_W2U = WS_W1D + 22 * MiB, WS_W2D = WS_W2U + 44 * MiB, WS_WIN = WS_W2D + 22 * MiB;
constexpr size_t WS_WQ = WS_WIN + 13 * MiB, WS_WKV = WS_WQ + 2 * MiB, WS_WOUT = WS_WKV + 2 * MiB, WS_WSP = WS_WOUT + 8 * MiB;
constexpr size_t WS_H = 162 * MiB;
constexpr size_t WS_ACT = 322 * MiB;
constexpr size_t WS_Z = 322 * MiB, WS_Q = 582 * MiB, WS_KV = 702 * MiB;
constexpr size_t WS_H2 = 762 * MiB, WS_SS = 922 * MiB, WS_END = 924 * MiB;
constexpr size_t WS_CM = 64 * 1024, CM_BYTES = (4 * 5632 + 2048) * 4;
constexpr size_t WS_RS = 256 * 1024;
static_assert(WS_WSP + 262144 <= WS_H, "weights fit");
constexpr int LDS_BYTES = 147456;
constexpr int NPHASE = 13;

__device__ __forceinline__ float bf_lo(unsigned w) { return __uint_as_float(w << 16); }
__device__ __forceinline__ float bf_hi(unsigned w) { return __uint_as_float(w & 0xffff0000u); }
__device__ __forceinline__ unsigned pk2(float lo, float hi) { return pg8::cvt_pk_bf16(lo, hi); }
__device__ __forceinline__ void unpack8(const u32x4 w, float (&f)[8]) { f[0] = bf_lo(w.x); f[1] = bf_hi(w.x); f[2] = bf_lo(w.y); f[3] = bf_hi(w.y); f[4] = bf_lo(w.z); f[5] = bf_hi(w.z); f[6] = bf_lo(w.w); f[7] = bf_hi(w.w); }
__device__ __forceinline__ u32x4 pack8(const float (&f)[8]) { u32x4 w; w.x = pk2(f[0], f[1]); w.y = pk2(f[2], f[3]); w.z = pk2(f[4], f[5]); w.w = pk2(f[6], f[7]); return w; }
__device__ __forceinline__ float wave_sum(float v) { v += xor_get<1>(v); v += xor_get<2>(v); v += xor_get<4>(v); v += xor_get<8>(v); v += xor_get<16>(v); return xor32_sum(v); }
__device__ __forceinline__ float gelu_tanh(float x) {
    const float t = -2.302208198f * (x + 0.044715f * x * x * x);
    return x * __builtin_amdgcn_rcpf(1.0f + __builtin_amdgcn_exp2f(t));
}

__constant__ double c_inv_rev[32] = {0.15915494309189535, 0.11934937021124886, 0.08949940160889101, 0.06711508300522726, 0.050329212104487035, 0.03774158471741977, 0.0283021958306234, 0.02122365276477766, 0.015915494309189534, 0.011934937021124886, 0.008949940160889102, 0.006711508300522725, 0.005032921210448704, 0.003774158471741977, 0.00283021958306234, 0.0021223652764777662, 0.0015915494309189536, 0.0011934937021124885, 0.0008949940160889102, 0.0006711508300522726, 0.0005032921210448703, 0.00037741584717419774, 0.00028302195830623395, 0.0002122365276477766, 0.00015915494309189535, 0.00011934937021124886, 8.949940160889102e-05, 6.711508300522725e-05, 5.0329212104487035e-05, 3.774158471741978e-05, 2.8302195830623396e-05, 2.122365276477766e-05};

__device__ __forceinline__ int dst_row(int mode, int n) {
    if (mode == 1) return ((n >> 7) << 8) + (n & 127);
    if (mode == 2) return ((n >> 7) << 8) + 128 + (n & 127);
    if (mode == 3) { if (n < 1024) return n; if (n < 1088) { const int j = n - 1024; return 1024 + (j < 32 ? 2 * j : 2 * (j - 32) + 1); } return n + 192; }
    if (mode == 4) { const int h = n / 192, d = n - h * 192; if (d < 128) return n; const int j = d - 128; return h * 192 + 128 + (j < 32 ? 2 * j : 2 * (j - 32) + 1); }
    return n;
}
__device__ __forceinline__ void p0_transpose_item(const float* W, int K, int N, bf16* WT, int mode, LAS float* scr, int item, int lane, const float* gk = nullptr) {
    const int nblk = N / 64, kb = item / nblk, nb = item % nblk, k0 = 64 * kb, n0 = 64 * nb;
    const int lr = lane >> 4, lc = (lane & 15) * 4;
#pragma unroll 4
    for (int i = 0; i < 16; ++i) { const int kk = 4 * i + lr; f32x4 v = *(const f32x4*)(W + (size_t)(k0 + kk) * N + n0 + lc); if (gk) v = v * gk[k0 + kk];
        LAS float* d = scr + kk * 65 + lc; d[0] = v.x; d[1] = v.y; d[2] = v.z; d[3] = v.w; }
    asm volatile("s_waitcnt lgkmcnt(0)" ::: "memory");
    const int c = lane & 7;
#pragma unroll
    for (int j = 0; j < 8; ++j) { const int n = (lane >> 3) + 8 * j; const LAS float* sp = scr + (8 * c) * 65 + n;
        u32x4 o; o.x = pk2(sp[0 * 65], sp[1 * 65]); o.y = pk2(sp[2 * 65], sp[3 * 65]); o.z = pk2(sp[4 * 65], sp[5 * 65]); o.w = pk2(sp[6 * 65], sp[7 * 65]);
        *(u32x4*)(WT + (size_t)dst_row(mode, n0 + n) * K + k0 + 8 * c) = o; }
    asm volatile("s_waitcnt lgkmcnt(0)" ::: "memory");
}

__device__ __forceinline__ void p0_transpose_item8(const float* W, int K, int N, unsigned char* WT, int mode, LAS float* scr, int item, int lane, const float* gk, float wscale, const float* cm = nullptr) {
    const int nblk = N / 64, kb = item / nblk, nb = item % nblk, k0 = 64 * kb, n0 = 64 * nb;
    const int lr = lane >> 4, lc = (lane & 15) * 4;
#pragma unroll 4
    for (int i = 0; i < 16; ++i) { const int kk = 4 * i + lr; f32x4 v = *(const f32x4*)(W + (size_t)(k0 + kk) * N + n0 + lc); v = v * (wscale * (gk ? gk[k0 + kk] : 1.f));
        LAS float* d = scr + kk * 65 + lc; d[0] = v.x; d[1] = v.y; d[2] = v.z; d[3] = v.w; }
    asm volatile("s_waitcnt lgkmcnt(0)" ::: "memory");
    unsigned char* orow = WT + (size_t)dst_row(mode, n0 + lane) * K + k0; const float ls = cm ? W8MAX / fmaxf(cm[n0 + lane], 1e-30f) : 1.f;
#pragma unroll
    for (int ch = 0; ch < 4; ++ch) { const LAS float* sp = scr + (16 * ch) * 65 + lane; int w[4];
#pragma unroll
        for (int q = 0; q < 4; ++q) { int t = __builtin_amdgcn_cvt_pk_fp8_f32(sp[(4 * q) * 65] * ls, sp[(4 * q + 1) * 65] * ls, 0, false); w[q] = __builtin_amdgcn_cvt_pk_fp8_f32(sp[(4 * q + 2) * 65] * ls, sp[(4 * q + 3) * 65] * ls, t, true); }
        *(u32x4*)(orow + 16 * ch) = (u32x4){(unsigned)w[0], (unsigned)w[1], (unsigned)w[2], (unsigned)w[3]}; }
    asm volatile("s_waitcnt lgkmcnt(0)" ::: "memory");
}
__device__ __forceinline__ void rms_row_to_fp8(const float* xrow, const float* g, unsigned char* orow, int lane) {
    const f32x4* xr = (const f32x4*)xrow + lane;
    f32x4 v[8]; float s = 0.f;
#pragma unroll
    for (int j = 0; j < 8; ++j) { v[j] = xr[64 * j]; s += (v[j].x * v[j].x + v[j].y * v[j].y) + (v[j].z * v[j].z + v[j].w * v[j].w); }
    const float rstd = __builtin_amdgcn_rsqf(wave_sum(s) * (1.f / DM) + EPS);
    int* o4 = (int*)orow + lane;
#pragma unroll
    for (int j = 0; j < 8; ++j) { const f32x4 gg = ((const f32x4*)g)[lane + 64 * j]; int w = __builtin_amdgcn_cvt_pk_fp8_f32(v[j].x * rstd * gg.x, v[j].y * rstd * gg.y, 0, false);
        w = __builtin_amdgcn_cvt_pk_fp8_f32(v[j].z * rstd * gg.z, v[j].w * rstd * gg.w, w, true); o4[64 * j] = w; }
}
__device__ __forceinline__ float wave_max(float v) {
    v = fmaxf(v, xor_get<1>(v)); v = fmaxf(v, xor_get<2>(v)); v = fmaxf(v, xor_get<4>(v)); v = fmaxf(v, xor_get<8>(v)); v = fmaxf(v, xor_get<16>(v));
    auto rr = __builtin_amdgcn_permlane32_swap(__float_as_uint(v), __float_as_uint(v), false, false); return fmaxf(__uint_as_float(rr[0]), __uint_as_float(rr[1]));
}
__device__ __forceinline__ unsigned q8(float v) { int q = (int)__builtin_rintf(v); q = q < -127 ? -127 : (q > 127 ? 127 : q); return (unsigned)q & 0xffu; }
__device__ __forceinline__ unsigned q8x4(float a, float b, float c, float d) { return q8(a) | (q8(b) << 8) | (q8(c) << 16) | (q8(d) << 24); }
__device__ __forceinline__ void p0_colmax_item(const float* W, int K, int N, float* cm, int item, int lane, const float* gk) {
    const int nblk = N / 64, kq = item / nblk, nb = item % nblk, n0 = 64 * nb, kbeg = kq * (K / 4);
    const int lr = lane >> 4, lc = (lane & 15) * 4; f32x4 mx = {0.f, 0.f, 0.f, 0.f};
#pragma unroll 8
    for (int i = 0; i < K / 16; ++i) { const int k = kbeg + 4 * i + lr; f32x4 v = *(const f32x4*)(W + (size_t)k * N + n0 + lc); if (gk) v = v * gk[k];
        mx.x = fmaxf(mx.x, fabsf(v.x)); mx.y = fmaxf(mx.y, fabsf(v.y)); mx.z = fmaxf(mx.z, fabsf(v.z)); mx.w = fmaxf(mx.w, fabsf(v.w)); }
#pragma unroll
    for (int e = 0; e < 4; ++e) { float m = mx[e]; m = fmaxf(m, xor_get<16>(m)); auto rr = __builtin_amdgcn_permlane32_swap(__float_as_uint(m), __float_as_uint(m), false, false); m = fmaxf(__uint_as_float(rr[0]), __uint_as_float(rr[1])); mx[e] = m; }
    if (lane < 16) {
#pragma unroll
        for (int e = 0; e < 4; ++e) atomicMax((unsigned*)cm + n0 + lc + e, __float_as_uint(mx[e])); }
}
__device__ __forceinline__ void p0_transpose_item_i8(const float* W, int K, int N, unsigned char* WT, int mode, LAS float* scr, int item, int lane, const float* gk, const float* cm) {
    const int nblk = N / 64, kb = item / nblk, nb = item % nblk, k0 = 64 * kb, n0 = 64 * nb;
    const int lr = lane >> 4, lc = (lane & 15) * 4;
#pragma unroll 4
    for (int i = 0; i < 16; ++i) { const int kk = 4 * i + lr; f32x4 v = *(const f32x4*)(W + (size_t)(k0 + kk) * N + n0 + lc); if (gk) v = v * gk[k0 + kk];
        LAS float* d = scr + kk * 65 + lc; d[0] = v.x; d[1] = v.y; d[2] = v.z; d[3] = v.w; }
    asm volatile("s_waitcnt lgkmcnt(0)" ::: "memory");
    const float inv = 127.f / fmaxf(cm[n0 + lane], 1e-30f);
    unsigned char* orow = WT + (size_t)dst_row(mode, n0 + lane) * K + k0;
#pragma unroll
    for (int ch = 0; ch < 4; ++ch) { const LAS float* sp = scr + (16 * ch) * 65 + lane; unsigned w[4];
#pragma unroll
        for (int q = 0; q < 4; ++q) w[q] = q8x4(sp[(4 * q) * 65] * inv, sp[(4 * q + 1) * 65] * inv, sp[(4 * q + 2) * 65] * inv, sp[(4 * q + 3) * 65] * inv);
        *(u32x4*)(orow + 16 * ch) = (u32x4){w[0], w[1], w[2], w[3]}; }
    asm volatile("s_waitcnt lgkmcnt(0)" ::: "memory");
}
__device__ __forceinline__ void rms_row_to_i8(const float* xrow, const float* g, unsigned char* orow, float* rsc, int lane) {
    const f32x4* xr = (const f32x4*)xrow + lane;
    f32x4 v[8]; float s = 0.f;
#pragma unroll
    for (int j = 0; j < 8; ++j) { v[j] = xr[64 * j]; s += (v[j].x * v[j].x + v[j].y * v[j].y) + (v[j].z * v[j].z + v[j].w * v[j].w); }
    const float rstd = __builtin_amdgcn_rsqf(wave_sum(s) * (1.f / DM) + EPS); float mx = 0.f;
#pragma unroll
    for (int j = 0; j < 8; ++j) { const f32x4 gg = ((const f32x4*)g)[lane + 64 * j]; v[j] = v[j] * rstd * gg; mx = fmaxf(fmaxf(mx, fmaxf(fabsf(v[j].x), fabsf(v[j].y))), fmaxf(fabsf(v[j].z), fabsf(v[j].w))); }
    mx = fmaxf(wave_max(mx), 1e-30f); const float inv = 127.f / mx;
    unsigned* o4 = (unsigned*)orow + lane;
#pragma unroll
    for (int j = 0; j < 8; ++j) o4[64 * j] = q8x4(v[j].x * inv, v[j].y * inv, v[j].z * inv, v[j].w * inv);
    if (lane == 0) *rsc = mx * (1.f / 127.f);
}
__device__ __forceinline__ void bf16_row_to_i8(const bf16* xrow, unsigned char* orow, float* rsc, int lane) {
    const u32x4* xr = (const u32x4*)xrow + lane; float f[4][8]; float s = 0.f, mx = 0.f;
#pragma unroll
    for (int j = 0; j < 4; ++j) { unpack8(xr[64 * j], f[j]);
#pragma unroll
        for (int e = 0; e < 8; ++e) { s += f[j][e] * f[j][e]; mx = fmaxf(mx, fabsf(f[j][e])); } }
    const float rstd = __builtin_amdgcn_rsqf(wave_sum(s) * (1.f / DM) + EPS); mx = fmaxf(wave_max(mx), 1e-30f); const float inv = 127.f / mx;
    u32x2* o8 = (u32x2*)orow + lane;
#pragma unroll
    for (int j = 0; j < 4; ++j) { u32x2 w; w.x = q8x4(f[j][0] * inv, f[j][1] * inv, f[j][2] * inv, f[j][3] * inv); w.y = q8x4(f[j][4] * inv, f[j][5] * inv, f[j][6] * inv, f[j][7] * inv); o8[64 * j] = w; }
    if (lane == 0) *rsc = mx * (1.f / 127.f) * rstd;
}
__device__ __forceinline__ void rms_row_to_bf16(const float* xrow, const float* g, bf16* orow, int lane) {
    const f32x4* xr = (const f32x4*)xrow + lane;
    f32x4 v[8]; float s = 0.f;
#pragma unroll
    for (int j = 0; j < 8; ++j) { v[j] = xr[64 * j]; s += (v[j].x * v[j].x + v[j].y * v[j].y) + (v[j].z * v[j].z + v[j].w * v[j].w); }
    const float rstd = __builtin_amdgcn_rsqf(wave_sum(s) * (1.f / DM) + EPS);
    u32x2* o8 = (u32x2*)orow + lane;
#pragma unroll
    for (int j = 0; j < 8; ++j) { const f32x4 gg = ((const f32x4*)g)[lane + 64 * j]; u32x2 w; w.x = pk2(v[j].x * rstd * gg.x, v[j].y * rstd * gg.y); w.y = pk2(v[j].z * rstd * gg.z, v[j].w * rstd * gg.w); o8[64 * j] = w; }
}
__device__ __forceinline__ void rms_row_inplace_f32(float* xrow, const float* g, int lane) {
    f32x4* xr = (f32x4*)xrow + lane;
    f32x4 v[8]; float s = 0.f;
#pragma unroll
    for (int j = 0; j < 8; ++j) { v[j] = xr[64 * j]; s += (v[j].x * v[j].x + v[j].y * v[j].y) + (v[j].z * v[j].z + v[j].w * v[j].w); }
    const float rstd = __builtin_amdgcn_rsqf(wave_sum(s) * (1.f / DM) + EPS);
#pragma unroll
    for (int j = 0; j < 8; ++j) { const f32x4 gg = ((const f32x4*)g)[lane + 64 * j]; xr[64 * j] = v[j] * rstd * gg; }
}


__device__ __forceinline__ void onorm_row(bf16* o, const float* g_a, const float* g_g, int lane) {
#pragma unroll
    for (int half = 0; half < 2; ++half) {
        u32x4* p = (u32x4*)(o + half * 1024) + lane; float f0[8], f1[8]; unpack8(p[0], f0); unpack8(p[64], f1); float s = 0.f;
#pragma unroll
        for (int e = 0; e < 8; ++e) s += f0[e] * f0[e] + f1[e] * f1[e];
        const float rstd = __builtin_amdgcn_rsqf(wave_sum(s) * (1.f / 1024.f) + EPS);
        const float* g = (half ? g_g : g_a) + 8 * lane;
#pragma unroll
        for (int e = 0; e < 8; ++e) { f0[e] *= rstd * g[e]; f1[e] *= rstd * g[512 + e]; }
        p[0] = pack8(f0); p[64] = pack8(f1);
    }
}

namespace att {
constexpr int NW = 8, QBLK = 32, KVBLK = 64;
constexpr int LDQ = QW, LDKV = KVW, LDKR = ZW, LDO = DM;
constexpr float SCALE = 0.07216878364870322f;
constexpr float THR = 8.f;
#ifndef ATT_SDEPTH
#define ATT_SDEPTH 1
#endif
constexpr int SDEPTH = ATT_SDEPTH;
constexpr int SHM_V = KVBLK * 128 * 2, SHM_K = KVBLK * 128 * 2, SHM_KR = KVBLK * 64 * 2;
#ifndef ATT_NQL
#define ATT_NQL 0
#endif
constexpr int NQL = ATT_NQL, NQR = 12 - NQL;
constexpr int OFF_V = 0, OFF_K = 2 * SHM_V, OFF_KR = OFF_K + 2 * SHM_K, OFF_WS = OFF_KR + 2 * SHM_KR, OFF_QL = OFF_WS + NW * 64 * 4, ATT_LDS = OFF_QL + NW * NQL * 1024;
static_assert(ATT_LDS <= 147456, "attention LDS");
#define KSWZ(row, colB) ((row) * 256 + ((colB) ^ (((row) & 7) << 4)))
#define KRSWZ(row, colB) ((row) * 128 + ((colB) ^ ((((row) >> 1) & 7) << 4)))
#define SBAR() __builtin_amdgcn_sched_barrier(0)
__device__ __forceinline__ int crow(int r, int hi) { return (r & 3) + 8 * (r >> 2) + 4 * hi; }
__device__ __forceinline__ unsigned cvtpk(float lo, float hi) { unsigned r; asm volatile("v_cvt_pk_bf16_f32 %0, %1, %2" : "=v"(r) : "v"(lo), "v"(hi)); return r; }

__device__ __forceinline__ void partialSM(f32x16& p0, f32x16& p1, float& m_reg, float& mn, float& alpha) {
  constexpr float C = SCALE * 1.4426950408889634f;
  float pmax = p0[0];
#pragma unroll
  for (int r = 1; r < 16; ++r) pmax = fmaxf(pmax, p0[r]);
#pragma unroll
  for (int r = 0; r < 16; ++r) pmax = fmaxf(pmax, p1[r]);
  { auto rr = __builtin_amdgcn_permlane32_swap(__float_as_uint(pmax), __float_as_uint(pmax), false, false);
    pmax = fmaxf(__uint_as_float(rr[0]), __uint_as_float(rr[1])); }
  if (__builtin_expect(__all(pmax - m_reg <= THR / SCALE), 1)) { mn = m_reg; alpha = 1.f; }
  else { mn = fmaxf(m_reg, pmax); alpha = __builtin_amdgcn_exp2f((m_reg - mn) * C); m_reg = mn; }
  float mnC = -mn * C;
#pragma unroll
  for (int r = 0; r < 16; ++r) p0[r] = fmaf(p0[r], C, mnC);
#pragma unroll
  for (int r = 0; r < 16; ++r) p1[r] = fmaf(p1[r], C, mnC);
#pragma unroll
  for (int r = 0; r < 16; ++r) p0[r] = __builtin_amdgcn_exp2f(p0[r]);
}
__device__ __forceinline__ void finishSM(f32x16& p0, f32x16& p1, float alpha, float& l_reg, bf16x8& pa0, bf16x8& pa1, bf16x8& pa2, bf16x8& pa3) {
#pragma unroll
  for (int r = 0; r < 16; ++r) p1[r] = __builtin_amdgcn_exp2f(p1[r]);
  float ps = 0;
#pragma unroll
  for (int r = 0; r < 16; ++r) ps += p0[r];
#pragma unroll
  for (int r = 0; r < 16; ++r) ps += p1[r];
  { auto rr = __builtin_amdgcn_permlane32_swap(__float_as_uint(ps), __float_as_uint(ps), false, false);
    ps = __uint_as_float(rr[0]) + __uint_as_float(rr[1]); }
  l_reg = l_reg * alpha + ps;
#define PK4(P, BASE, OUT) do { unsigned a0 = cvtpk(P[BASE + 0], P[BASE + 1]), a1 = cvtpk(P[BASE + 2], P[BASE + 3]);   \
    unsigned b0 = cvtpk(P[BASE + 4], P[BASE + 5]), b1 = cvtpk(P[BASE + 6], P[BASE + 7]);                              \
    auto r0 = __builtin_amdgcn_permlane32_swap(a0, b0, false, false); auto r1 = __builtin_amdgcn_permlane32_swap(a1, b1, false, false); \
    u32x4 w = {r0[0], r1[0], r0[1], r1[1]}; OUT = *reinterpret_cast<bf16x8*>(&w); } while (0)
  PK4(p0, 0, pa0); PK4(p0, 8, pa1); PK4(p1, 0, pa2); PK4(p1, 8, pa3);
#undef PK4
}
#define QF(d) ((d) < NQR ? qr[(d) < NQR ? (d) : 0] : *reinterpret_cast<const bf16x8*>(ql + ((d) - NQR) * 1024))
__device__ __forceinline__ void qkt(f32x16& p0, f32x16& p1, const char* Ks, const char* Krs, const bf16x8* qr, const char* ql, int r32, int hi) {
  p0 = f32x16{}; p1 = f32x16{};
#pragma unroll
  for (int d0 = 0; d0 < 8; ++d0) { int cb = (d0 * 16 + hi * 8) * 2;
    bf16x8 b0 = *reinterpret_cast<const bf16x8*>(Ks + KSWZ(r32, cb));
    bf16x8 b1 = *reinterpret_cast<const bf16x8*>(Ks + KSWZ(32 + r32, cb));
    const bf16x8 qf = QF(d0);
    p0 = __builtin_amdgcn_mfma_f32_32x32x16_bf16(b0, qf, p0, 0, 0, 0);
    p1 = __builtin_amdgcn_mfma_f32_32x32x16_bf16(b1, qf, p1, 0, 0, 0); }
#pragma unroll
  for (int d0 = 0; d0 < 4; ++d0) { int cb = (d0 * 16 + hi * 8) * 2;
    bf16x8 b0 = *reinterpret_cast<const bf16x8*>(Krs + KRSWZ(r32, cb));
    bf16x8 b1 = *reinterpret_cast<const bf16x8*>(Krs + KRSWZ(32 + r32, cb));
    const bf16x8 qf = QF(8 + d0);
    p0 = __builtin_amdgcn_mfma_f32_32x32x16_bf16(b0, qf, p0, 0, 0, 0);
    p1 = __builtin_amdgcn_mfma_f32_32x32x16_bf16(b1, qf, p1, 0, 0, 0); }
}
__device__ __forceinline__ int v_st(int k, int c) { const int kk = (k & ~0xC) | ((k & 4) << 1) | ((k & 8) >> 1); return ((kk >> 3) * 4 + (c >> 5)) * 512 + ((kk & 7) * 32 + (c & 31)) * 2; }
__device__ __forceinline__ int v_rd_base(int lane) { return ((lane & 3) << 3) | (((lane >> 2) & 3) << 6) | (((lane >> 4) & 1) << 5) | (((lane >> 5) & 1) << 8); }
constexpr int v_rd_off(int d0, int ks, int half) { return d0 * 512 + ks * 4096 + half * 2048; }
template <int OFF> __device__ __forceinline__ s16x4 tr_read(int vb) {
  s16x4 r; asm volatile("ds_read_b64_tr_b16 %0, %1 offset:%2" : "=&v"(r) : "v"(vb), "i"(OFF) : "memory"); return r;
}
template <int D0> __device__ __forceinline__ void pv_one(f32x16& od, int vb, bf16x8 pa0, bf16x8 pa1, bf16x8 pa2, bf16x8 pa3) {
  const s16x4 l0 = tr_read<v_rd_off(D0, 0, 0)>(vb), h0 = tr_read<v_rd_off(D0, 0, 1)>(vb), l1 = tr_read<v_rd_off(D0, 1, 0)>(vb), h1 = tr_read<v_rd_off(D0, 1, 1)>(vb);
  const s16x4 l2 = tr_read<v_rd_off(D0, 2, 0)>(vb), h2 = tr_read<v_rd_off(D0, 2, 1)>(vb), l3 = tr_read<v_rd_off(D0, 3, 0)>(vb), h3 = tr_read<v_rd_off(D0, 3, 1)>(vb);
  asm volatile("s_waitcnt lgkmcnt(0)" ::: "memory"); SBAR();
#define PK(L, H) (bf16x8){L[0], L[1], L[2], L[3], H[0], H[1], H[2], H[3]}
  od = __builtin_amdgcn_mfma_f32_32x32x16_bf16(pa0, PK(l0, h0), od, 0, 0, 0);
  od = __builtin_amdgcn_mfma_f32_32x32x16_bf16(pa1, PK(l1, h1), od, 0, 0, 0);
  od = __builtin_amdgcn_mfma_f32_32x32x16_bf16(pa2, PK(l2, h2), od, 0, 0, 0);
  od = __builtin_amdgcn_mfma_f32_32x32x16_bf16(pa3, PK(l3, h3), od, 0, 0, 0);
#undef PK
}
__device__ __forceinline__ void pv_d0(f32x16* o, int vb, bf16x8 pa0, bf16x8 pa1, bf16x8 pa2, bf16x8 pa3) {
  pv_one<0>(o[0], vb, pa0, pa1, pa2, pa3); pv_one<1>(o[1], vb, pa0, pa1, pa2, pa3); pv_one<2>(o[2], vb, pa0, pa1, pa2, pa3); pv_one<3>(o[3], vb, pa0, pa1, pa2, pa3);
}

__device__ __forceinline__ void attn_dense_body(const bf16* __restrict__ Qb, const bf16* __restrict__ Kn, const bf16* __restrict__ Kr, const bf16* __restrict__ Vh,
                                                bf16* __restrict__ Ob, pg8::u64* ssa, int seq, char* lds, const int wv) {
  const int tid = tid_of(wv), wid = tid >> 6, lane = tid & 63, r32 = lane & 31, hi = lane >> 5;
  char* V_lds = lds + OFF_V; char* K_lds = lds + OFF_K; char* KR_lds = lds + OFF_KR;
  float* ws = (float*)(lds + OFF_WS) + wid * 64; float* li_l = ws; float* al_l = ws + 32;
  float m_reg = -1e30f, l_reg = 0; f32x16 o[4] = {}; bf16x8 qr[NQR]; char* ql = lds + OFF_QL + wid * (NQL * 1024) + lane * 16;
  const bf16* Qw = Qb + (long)(wid * QBLK + r32) * LDQ + hi * 8;
#pragma unroll
  for (int d0 = 0; d0 < 12; ++d0) { const bf16x8 t = *reinterpret_cast<const bf16x8*>(Qw + d0 * 16); if (d0 < NQR) qr[d0 < NQR ? d0 : 0] = t; else *reinterpret_cast<bf16x8*>(ql + (d0 - NQR) * 1024) = t; }
  const int sr = tid >> 4, sc = (tid & 15) * 8, vst0 = v_st(sr, sc), vst1 = v_st(32 + sr, sc);
  const int krr = tid >> 3, krc = (tid & 7) * 8;
  const int vb0 = (int)(uintptr_t)V_lds + v_rd_base(lane);
  struct { bf16x8 vs0, vs1, ks0, ks1, kr; } sr_[SDEPTH];
const unsigned offV0 = (unsigned)(sr * LDKV + sc) * 2u, offV1 = (unsigned)((32 + sr) * LDKV + sc) * 2u, offKR = (unsigned)(krr * LDKR + krc) * 2u;
#define SLOAD(i, k0) do { const char* vt_ = (const char*)Vh + (size_t)(k0) * (LDKV * 2); const char* kt_ = (const char*)Kn + (size_t)(k0) * (LDKV * 2); const char* rt_ = (const char*)Kr + (size_t)(k0) * (LDKR * 2); \
    sr_[i].vs0 = *reinterpret_cast<const bf16x8*>(vt_ + offV0); sr_[i].vs1 = *reinterpret_cast<const bf16x8*>(vt_ + offV1); \
    sr_[i].ks0 = *reinterpret_cast<const bf16x8*>(kt_ + offV0); sr_[i].ks1 = *reinterpret_cast<const bf16x8*>(kt_ + offV1); \
    sr_[i].kr = *reinterpret_cast<const bf16x8*>(rt_ + offKR); } while (0)
#define SWRITE(b, i) do { *(bf16x8*)(V_lds + (b) * SHM_V + vst0) = sr_[i].vs0;          \
    *(bf16x8*)(V_lds + (b) * SHM_V + vst1) = sr_[i].vs1; int kc = sc * 2;               \
    *(bf16x8*)(K_lds + (b) * SHM_K + KSWZ(sr, kc)) = sr_[i].ks0;                       \
    *(bf16x8*)(K_lds + (b) * SHM_K + KSWZ(32 + sr, kc)) = sr_[i].ks1;                  \
    *(bf16x8*)(KR_lds + (b) * SHM_KR + KRSWZ(krr, krc * 2)) = sr_[i].kr; } while (0)
#define SWAIT() do { if constexpr (SDEPTH == 2) asm volatile("s_waitcnt vmcnt(5)" ::: "memory"); else asm volatile("s_waitcnt vmcnt(0)" ::: "memory"); } while (0)
#define RESC(a) do { if (__any((a) < 1.f)) { if (hi == 0) al_l[r32] = (a); asm volatile("s_waitcnt lgkmcnt(0)" ::: "memory"); \
    _Pragma("unroll") for (int d = 0; d < 4; ++d) _Pragma("unroll") for (int r = 0; r < 16; ++r) o[d][r] *= al_l[crow(r, hi)]; } } while (0)
  f32x16 pA0, pA1, pB0, pB1; float mnA, mnB, alA, alB; bf16x8 pa0, pa1, pa2, pa3; const int NT = seq / KVBLK;
  constexpr int SE = 0, SO = SDEPTH - 1;
  SLOAD(SE, 0); asm volatile("s_waitcnt vmcnt(0)" ::: "memory"); SWRITE(0, SE); __syncthreads();
  qkt(pA0, pA1, K_lds, KR_lds, qr, ql, r32, hi); partialSM(pA0, pA1, m_reg, mnA, alA);
  SLOAD(SO, KVBLK); if constexpr (SDEPTH == 2) { if (2 < NT) SLOAD(SE, 2 * KVBLK); }
  SWAIT(); SWRITE(1, SO); __syncthreads();
  for (int j = 1; j + 1 < NT; j += 2) {
    SBAR(); qkt(pB0, pB1, K_lds + SHM_K, KR_lds + SHM_KR, qr, ql, r32, hi);
    finishSM(pA0, pA1, alA, l_reg, pa0, pa1, pa2, pa3); SBAR();
    SLOAD(SO, (j + SDEPTH) * KVBLK); SBAR();
    pv_d0(o, vb0, pa0, pa1, pa2, pa3); partialSM(pB0, pB1, m_reg, mnB, alB);
    __syncthreads(); SWAIT(); SWRITE(0, SE);
    RESC(alB); __syncthreads();
    SBAR(); qkt(pA0, pA1, K_lds, KR_lds, qr, ql, r32, hi);
    finishSM(pB0, pB1, alB, l_reg, pa0, pa1, pa2, pa3); SBAR();
    if (SDEPTH == 1 || j + 3 < NT) SLOAD(SE, (j + 1 + SDEPTH) * KVBLK); SBAR();
    pv_d0(o, vb0 + SHM_V, pa0, pa1, pa2, pa3); partialSM(pA0, pA1, m_reg, mnA, alA);
    __syncthreads(); SWAIT(); SWRITE(1, SO);
    RESC(alA); __syncthreads();
  }
  SBAR(); qkt(pB0, pB1, K_lds + SHM_K, KR_lds + SHM_KR, qr, ql, r32, hi);
  finishSM(pA0, pA1, alA, l_reg, pa0, pa1, pa2, pa3); SBAR();
  pv_d0(o, vb0, pa0, pa1, pa2, pa3); partialSM(pB0, pB1, m_reg, mnB, alB);
  __syncthreads(); RESC(alB);
  finishSM(pB0, pB1, alB, l_reg, pa0, pa1, pa2, pa3); SBAR();
  pv_d0(o, vb0 + SHM_V, pa0, pa1, pa2, pa3);
  if (hi == 0) li_l[r32] = l_reg; asm volatile("s_waitcnt lgkmcnt(0)" ::: "memory");
  float rli[16];
#pragma unroll
  for (int r = 0; r < 16; ++r) rli[r] = __builtin_amdgcn_rcpf(li_l[crow(r, hi)]);
  bf16* Ow = Ob + (long)(wid * QBLK) * LDO;
#pragma unroll
  for (int r = 0; r < 16; ++r) { int orow = crow(r, hi);
    float sq = 0.f;
#pragma unroll
    for (int d0 = 0; d0 < 4; ++d0) { const float v = o[d0][r] * rli[r]; sq += v * v; Ow[(long)orow * LDO + d0 * 32 + r32] = (bf16)(cvtpk(v, 0.f) & 0xffffu); }
    sq += xor_get<1>(sq); sq += xor_get<2>(sq); sq += xor_get<4>(sq); sq += xor_get<8>(sq); sq += xor_get<16>(sq);
    if (r32 == 0) pg8::ss_add(ssa + wid * QBLK + orow, sq); }
#undef SLOAD
#undef SWRITE
#undef SWAIT
#undef RESC
}
}

__device__ __forceinline__ void gmlp_unit(const bf16* Z, const bf16* Wsp, const float* b_s, const float* g_v, bf16* O, pg8::u64* ssg, int chunk, int g, char* lds, const int wv) {
  const int tid = tid_of(wv), wid = tid >> 6, lane = tid & 63, r32 = lane & 31, hi = lane >> 5;
  constexpr int PITCH = 136;
  bf16* VT = (bf16*)lds;
  const bf16* Zc = Z + (size_t)chunk * 128 * ZW;
  bf16x8 af[8];
  { const bf16* Ar = Wsp + (size_t)g * 16384 + (size_t)((wid & 3) * 32 + r32) * 128 + hi * 8;
#pragma unroll
    for (int k = 0; k < 8; ++k) af[k] = *reinterpret_cast<const bf16x8*>(Ar + k * 16); }
  __syncthreads();
  {
    const int j = tid >> 2, cg = tid & 3; u32x4 w[4]; float sq = 0.f;
    const bf16* zr = Zc + (size_t)j * ZW + Z_V + g * 128 + cg * 8;
#pragma unroll
    for (int i = 0; i < 4; ++i) w[i] = *(const u32x4*)(zr + 32 * i);
#pragma unroll
    for (int i = 0; i < 4; ++i) { float f[8]; unpack8(w[i], f);
#pragma unroll
      for (int e = 0; e < 8; ++e) sq += f[e] * f[e]; }
    sq += xor_get<1>(sq); sq += xor_get<2>(sq);
    const float rs = __builtin_amdgcn_rsqf(sq * (1.f / 128.f) + EPS);
#pragma unroll
    for (int i = 0; i < 4; ++i) { const int c0 = (cg + 4 * i) * 8; float f[8]; unpack8(w[i], f);
      const float* gp = g_v + g * 128 + c0; const f32x4 g0 = *(const f32x4*)gp, g1 = *(const f32x4*)(gp + 4);
      unsigned p0 = pk2(f[0] * rs * g0.x, f[1] * rs * g0.y), p1 = pk2(f[2] * rs * g0.z, f[3] * rs * g0.w), p2 = pk2(f[4] * rs * g1.x, f[5] * rs * g1.y), p3 = pk2(f[6] * rs * g1.z, f[7] * rs * g1.w);
      if (cg & 1) { const unsigned t = p0; p0 = p1; p1 = p2; p2 = p3; p3 = t; }
      if (cg & 2) { unsigned t = p0; p0 = p2; p2 = t; t = p1; p1 = p3; p3 = t; }
      const unsigned q[4] = {p0, p1, p2, p3};
#pragma unroll
      for (int d = 0; d < 4; ++d) { const int dd = (d + cg) & 3; VT[(c0 + 2 * dd) * PITCH + j] = (bf16)(q[d] & 0xffff); VT[(c0 + 2 * dd + 1) * PITCH + j] = (bf16)(q[d] >> 16); } }
  }
  __syncthreads();
  const int ib = (wid & 3) * 32, cb = (wid >> 2) * 64;
  f32x16 a0 = {}, a1 = {};
#pragma unroll
  for (int k = 0; k < 8; ++k) {
    const bf16x8 b0 = *reinterpret_cast<const bf16x8*>(VT + (cb + r32) * PITCH + k * 16 + hi * 8);
    const bf16x8 b1 = *reinterpret_cast<const bf16x8*>(VT + (cb + 32 + r32) * PITCH + k * 16 + hi * 8);
    a0 = __builtin_amdgcn_mfma_f32_32x32x16_bf16(b0, af[k], a0, 0, 0, 0);
    a1 = __builtin_amdgcn_mfma_f32_32x32x16_bf16(b1, af[k], a1, 0, 0, 0);
  }
  { const int i = ib + r32; const float bb = b_s[g * 128 + i]; const size_t row = (size_t)chunk * 128 + i;
    const bf16* up = Z + row * ZW + Z_U + g * 128 + cb + 4 * hi; bf16* op = O + row * DM + 1024 + g * 128 + cb + 4 * hi;
    float sq = 0.f;
#pragma unroll
    for (int q = 0; q < 4; ++q) {
      const u32x2 w0 = *(const u32x2*)(up + 8 * q), w1 = *(const u32x2*)(up + 32 + 8 * q);
      u32x2 o0, o1;
      { const float uu[8] = {bf_lo(w0.x), bf_hi(w0.x), bf_lo(w0.y), bf_hi(w0.y), bf_lo(w1.x), bf_hi(w1.x), bf_lo(w1.y), bf_hi(w1.y)};
#pragma unroll
        for (int e = 0; e < 4; ++e) { const float v0 = uu[e] * (a0[4 * q + e] + bb), v1 = uu[4 + e] * (a1[4 * q + e] + bb); sq += v0 * v0 + v1 * v1; } }
      o0.x = pk2(bf_lo(w0.x) * (a0[4 * q + 0] + bb), bf_hi(w0.x) * (a0[4 * q + 1] + bb)); o0.y = pk2(bf_lo(w0.y) * (a0[4 * q + 2] + bb), bf_hi(w0.y) * (a0[4 * q + 3] + bb));
      o1.x = pk2(bf_lo(w1.x) * (a1[4 * q + 0] + bb), bf_hi(w1.x) * (a1[4 * q + 1] + bb)); o1.y = pk2(bf_lo(w1.y) * (a1[4 * q + 2] + bb), bf_hi(w1.y) * (a1[4 * q + 3] + bb));
      *(u32x2*)(op + 8 * q) = o0; *(u32x2*)(op + 32 + 8 * q) = o1; }
    sq = xor32_sum(sq);
    if (hi == 0) pg8::ss_add(ssg + row, sq); }
}

#define XB_TMO      128
#define XB_XCNT(j)  (256  + 64 * (j))
#define XB_XSUB(j)  (1280 + 64 * (j))
#define XB_XGEN(j)  (2304 + 64 * (j))
#define XB_TOP      3328
#define XB_TOPGEN   3392
#define XCD_BAR_WORDS 3456
#define XB_SPIN_CAP (1u << 18)
__device__ __forceinline__ unsigned xb_ld(unsigned* p)              { return __hip_atomic_load(p, __ATOMIC_RELAXED, __HIP_MEMORY_SCOPE_AGENT); }
__device__ __forceinline__ unsigned xb_add(unsigned* p, unsigned v) { return __hip_atomic_fetch_add(p, v, __ATOMIC_RELAXED, __HIP_MEMORY_SCOPE_AGENT); }
__device__ __forceinline__ unsigned xb_xcc_id() { return (unsigned)__builtin_amdgcn_s_getreg((3 << 11) | 20) & 0xFu; }
#define XB_SPIN(cond, bar) do { unsigned _sp = 0; while (cond) { __builtin_amdgcn_s_sleep(1); \
    if ((++_sp & 255u) == 0u) { if (xb_ld(&(bar)[XB_TMO])) break; if (_sp > XB_SPIN_CAP) { atomicAdd(&(bar)[XB_TMO], 1u); break; } } } } while (0)
struct XcdBarrier { unsigned* bar; unsigned x; volatile LAS unsigned* st; };
__device__ __forceinline__ XcdBarrier xcd_barrier_post(unsigned* bar, volatile LAS unsigned* st) {
    XcdBarrier b; b.bar = bar; b.x = xb_xcc_id(); b.st = st;
    if (threadIdx.x == 0) (void)xb_add(&bar[XB_XCNT(b.x)], 1u);
    return b;
}
__device__ __forceinline__ void xcd_barrier_complete(unsigned* bar, unsigned x, unsigned& nloc, unsigned& nx) {
    const unsigned G = gridDim.x * gridDim.y * gridDim.z;
    unsigned sum, cnt, mine, sp = 0u;
    for (;;) {
        sum = 0u; cnt = 0u; mine = 0u;
#pragma unroll
        for (unsigned j = 0; j < 16; ++j) { const unsigned c = xb_ld(&bar[XB_XCNT(j)]); sum += c; cnt += (c > 0u) ? 1u : 0u; mine = (j == x) ? c : mine; }
        if (sum == G) break;
        __builtin_amdgcn_s_sleep(1);
        if ((++sp & 255u) == 0u) { if (xb_ld(&bar[XB_TMO])) break; if (sp > XB_SPIN_CAP) { atomicAdd(&bar[XB_TMO], 1u); break; } }
    }
    nloc = mine > 0u ? mine : 1u; nx = cnt > 0u ? cnt : 1u;
}
__device__ __forceinline__ void xcd_barrier(const XcdBarrier& b, const int wv) {
    asm volatile("s_waitcnt vmcnt(0)" ::: "memory");
    __syncthreads();
    if (tid_of(wv) == 0) {
        unsigned* bar = b.bar;
        __builtin_amdgcn_s_waitcnt(0);
        unsigned nloc = b.st[0], nx = b.st[1];
        if (nloc == 0u) { xcd_barrier_complete(bar, b.x, nloc, nx); b.st[0] = nloc; b.st[1] = nx; }
        const unsigned old = xb_add(&bar[XB_XSUB(b.x)], 1u);
        const unsigned gen = old / nloc;
        if (old + 1u == (gen + 1u) * nloc) {
            __builtin_amdgcn_fence(__ATOMIC_RELEASE, "agent");
            asm volatile("s_waitcnt vmcnt(0)" ::: "memory");
            const unsigned og = xb_add(&bar[XB_TOP], 1u);
            const unsigned tg = og / nx;
            if (og + 1u == (tg + 1u) * nx) xb_add(&bar[XB_TOPGEN], 1u);
            else XB_SPIN(xb_ld(&bar[XB_TOPGEN]) == tg, bar);
            __builtin_amdgcn_fence(__ATOMIC_ACQUIRE, "agent");
            xb_add(&bar[XB_XGEN(b.x)], 1u);
            asm volatile("s_waitcnt vmcnt(0)" ::: "memory");
        } else {
            XB_SPIN(xb_ld(&bar[XB_XGEN(b.x)]) == gen, bar);
            __builtin_amdgcn_fence(__ATOMIC_ACQUIRE, "agent");
            asm volatile("s_waitcnt vmcnt(0)" ::: "memory");
        }
    }
    __syncthreads();
}

struct Args { const float* in[23]; float* out; unsigned char* ws; int ph_lo, ph_hi; };

template <class Epi, int MODE = 0, bool MID = false>
__device__ __forceinline__ void run_gemm(LAS unsigned char* lds, const void* A, int lda, const void* Bt, int ldb, int M, int N, int K, const Epi E, const int wv, int base = -1, int stride = 0, int cnt = 0x7fffffff) {
    pg8::Gemm g{A, Bt, M, N, K, lda, ldb}; pg8::StaticOrder S; S.init(M, N, (int)gridDim.x, (int)blockIdx.x);
    if (base >= 0) { S.base = base; S.stride = stride; } S.cnt = cnt;
    pg8::gemm_phase<Epi, pg8::StaticOrder, true, true, MODE, MID>(lds, g, S, E, wv);
}

__global__ void __launch_bounds__(512) mk_fwd(Args args) {
    extern __shared__ __attribute__((aligned(16))) unsigned char lds_raw[];
    LAS unsigned char* lds = (LAS unsigned char*)lds_raw;
    const int G = gridDim.x;
    const int wv = __builtin_amdgcn_readfirstlane(threadIdx.x >> 6);
    volatile LAS unsigned* bar_st = (volatile LAS unsigned*)(lds + (LDS_BYTES - 64));
    if (threadIdx.x < 2) bar_st[threadIdx.x] = 0u;
    __syncthreads();
    unsigned* barw = (unsigned*)(args.ws);
    XcdBarrier xbar; xbar.bar = barw; xbar.x = 0; xbar.st = bar_st;
#define LANE_INIT const int tid = tid_of(wv), lane = tid & 63, wave = wv, gw = blockIdx.x * 8 + wave, NGW = G * 8; (void)tid; (void)lane; (void)gw; (void)NGW;
#define PH_WS unsigned char* ws = args.ws; float* X = args.out; (void)X; (void)ws;
#define x_p (args.in[0])
#define x_s (args.in[1])
#define g_ffn1 (args.in[2])
#define w1_gate (args.in[3])
#define w1_up (args.in[4])
#define w1_down (args.in[5])
#define g_mix (args.in[6])
#define w_in (args.in[7])
#define g_q (args.in[8])
#define w_q_b (args.in[9])
#define g_kv (args.in[10])
#define w_kv_b (args.in[11])
#define g_v (args.in[12])
#define w_s (args.in[13])
#define b_s (args.in[14])
#define g_out_attn (args.in[15])
#define g_out_gmlp (args.in[16])
#define w_out (args.in[17])
#define g_ffn2 (args.in[18])
#define w2_gate (args.in[19])
#define w2_up (args.in[20])
#define w2_down (args.in[21])
#define g_final (args.in[22])
#define rope ((float*)(ws + WS_ROPE))
#define W1U ((bf16*)(ws + WS_W1U))
#define W1D ((bf16*)(ws + WS_W1D))
#define W2U ((bf16*)(ws + WS_W2U))
#define W2D ((bf16*)(ws + WS_W2D))
#define WIN ((bf16*)(ws + WS_WIN))
#define WQ ((bf16*)(ws + WS_WQ))
#define WKV ((bf16*)(ws + WS_WKV))
#define WOUT ((bf16*)(ws + WS_WOUT))
#define WSP ((bf16*)(ws + WS_WSP))
#define H ((bf16*)(ws + WS_H))
#define ACT ((bf16*)(ws + WS_ACT))
#define Z ((bf16*)(ws + WS_Z))
#define Q ((bf16*)(ws + WS_Q))
#define KV ((bf16*)(ws + WS_KV))
#define H2 ((bf16*)(ws + WS_H2))
#define X1B ((bf16*)X)
#define X2B ((bf16*)X + (size_t)T * DM)
#define CM ((float*)(ws + WS_CM))
#define RS1 ((float*)(ws + WS_RS))
#define RS2 ((float*)(ws + WS_RS) + T)
#define SS ((pg8::u64*)(ws + WS_SS))
#define SS1 (SS)
#define SS3 (SS + T)
#define SSQ (SS + 2 * T)
#define SSKV (SS + 3 * T)
#define SSA (SS + 4 * T)
#define SSG (SS + 5 * T)
#define IN(k) true
#define SEAM(k) do { if ((k) == 0) { cg::this_grid().sync(); xbar = xcd_barrier_post(barw, bar_st); } else xcd_barrier(xbar, wv); } while (0)

    if (IN(0)) {
        PH_WS LANE_INIT
        LAS float* scr = (LAS float*)(lds + wave * 16640);
        constexpr int I_UP = (DM / 64) * (DFF / 64), I_DN = (DFF / 64) * (DM / 64), I_IN = (DM / 64) * (3136 / 64), I_Q = (512 / 64) * (QW / 64), I_KV = (512 / 64) * (KVW / 64), I_OUT = (DM / 64) * (DM / 64);
        constexpr int I_CM = 4 * (DFF / 64), I_CMD = 4 * (DM / 64); constexpr int NITEMS = 4 * I_CM + I_CMD + 2 * I_DN + I_IN + I_Q + I_KV + I_OUT;
        for (int it = gw; it < NITEMS; it += NGW) {
            int r = it;
            if (r < 4 * I_CM) {
                const int mat = r / I_CM, it2 = r % I_CM;
                p0_colmax_item(mat == 0 ? w1_gate : mat == 1 ? w1_up : mat == 2 ? w2_gate : w2_up, DM, DFF, CM + mat * DFF, it2, lane, mat >= 2 ? g_ffn2 : nullptr); continue; } r -= 4 * I_CM;
            if (r < I_CMD) { p0_colmax_item(w2_down, DFF, DM, CM + 4 * DFF, r, lane, nullptr); continue; } r -= I_CMD;
            if (r < I_DN) { p0_transpose_item(w1_down, DFF, DM, W1D, 0, scr, r, lane); continue; } r -= I_DN;
            if (r < I_DN) { if (!FP8_DOWN2) p0_transpose_item(w2_down, DFF, DM, W2D, 0, scr, r, lane); continue; } r -= I_DN;
            if (r < I_IN) { p0_transpose_item(w_in, DM, 3136, WIN, 3, scr, r, lane, g_mix); continue; } r -= I_IN;
            if (r < I_Q) { p0_transpose_item(w_q_b, 512, QW, WQ, 4, scr, r, lane, g_q); continue; } r -= I_Q;
            if (r < I_KV) { p0_transpose_item(w_kv_b, 512, KVW, WKV, 0, scr, r, lane, g_kv); continue; } r -= I_KV;
            p0_transpose_item(w_out, DM, DM, WOUT, 0, scr, r, lane, (r / (DM / 64)) < 16 ? g_out_attn : g_out_gmlp - 1024);
        }
        const int gt = blockIdx.x * 512 + tid, NGT = G * 512;
        if (blockIdx.x == 0) for (int i = tid; i < XCD_BAR_WORDS; i += 512) barw[i] = 0u;
        for (int i = gt; i < 192 * DM / 8; i += NGT) ((u32x4*)(WIN + (size_t)1088 * DM))[i] = (u32x4){0u, 0u, 0u, 0u};
        for (int i = gt; i < 6 * T / 2; i += NGT) ((u32x4*)SS)[i] = (u32x4){0u, 0u, 0u, 0u};
        for (int i = gt; i < 8 * 128 * 128 / 2; i += NGT) ((unsigned*)WSP)[i] = pk2(w_s[2 * i], w_s[2 * i + 1]);
        for (int i = gt; i < 8192 * 32; i += NGT) { const int pos = i >> 5, k = i & 31; const double a = (double)pos * c_inv_rev[k]; const float fr = (float)(a - floor(a));
            rope[(size_t)pos * 64 + k] = __builtin_amdgcn_cosf(fr); rope[(size_t)pos * 64 + 32 + k] = __builtin_amdgcn_sinf(fr); }
        for (int m = gw; m < T; m += NGW) { const float* xr = (m < TP ? x_p + (size_t)m * DM : x_s + (size_t)(m - TP) * DM);
            rms_row_to_i8(xr, g_ffn1, (unsigned char*)H + (size_t)m * DM, RS1 + m, lane); }
    }
    SEAM(0);
    {
        PH_WS LANE_INIT
        LAS float* scr = (LAS float*)(lds + wave * 16640);
        constexpr int I_UP = (DM / 64) * (DFF / 64), I_DN8 = FP8_DOWN2 ? (DFF / 64) * (DM / 64) : 0;
        for (int it = gw; it < I_DN8; it += NGW) p0_transpose_item8(w2_down, DFF, DM, (unsigned char*)W2D, 0, scr, it, lane, nullptr, 1.f, CM + 4 * DFF);
        for (int it = gw; it < 4 * I_UP; it += NGW) { const int mat = it / I_UP, r = it % I_UP;
            p0_transpose_item_i8(mat == 0 ? w1_gate : mat == 1 ? w1_up : mat == 2 ? w2_gate : w2_up, DM, DFF, (unsigned char*)(mat < 2 ? W1U : W2U), 1 + (mat & 1), scr, r, lane, mat >= 2 ? g_ffn2 : nullptr, CM + mat * DFF); }
    }
    SEAM(20);
    if (IN(1)) { PH_WS pg8::EpiSwiGLU<false> E{ACT, DFF, RS1, CM, CM + DFF, 1.f / 127.f}; run_gemm<pg8::EpiSwiGLU<false>, 2>(lds, H, DM, W1U, DM, T, 2 * DFF, DM, E, wv); }
    SEAM(1);
    if (IN(2)) { PH_WS
        { pg8::EpiResid<true, false, 1, true, false, false, false> E{x_p, nullptr, DM, X1B, SS1, nullptr, nullptr, 1.f}; run_gemm(lds, ACT, DFF, W1D, DFF, TP, DM, DFF, E, wv); }
        { pg8::EpiResid<true, false, 1, true, false, false, false> E{x_s, nullptr, DM, X1B + (size_t)TP * DM, SS1 + TP, nullptr, nullptr, 1.f}; run_gemm(lds, ACT + (size_t)TP * DFF, DFF, W1D, DFF, TS, DM, DFF, E, wv); }
    }
    SEAM(2);
    const bool rebal = (G == 256);
    if (IN(3)) { PH_WS pg8::EpiZ E{Z, ZW, SS1, SSQ, SSKV, rope}; run_gemm(lds, X1B, DM, WIN, DM, T, ZW, DM, E, wv, -1, 0, rebal ? 8 : 0x7fffffff); }
    SEAM(3);
    if (IN(4)) { PH_WS
        const int c_ = (int)blockIdx.x;
        if (rebal && c_ < 32) { pg8::EpiZ E{Z, ZW, SS1, SSQ, SSKV, rope}; run_gemm(lds, X1B, DM, WIN, DM, T, ZW, DM, E, wv, 2048 + c_, 256, 1); }
        { pg8::EpiQRope E{Q, QW, rope, SSQ};
          if (!rebal) run_gemm(lds, Z, ZW, WQ, 512, T, QW, 512, E, wv);
          else if (c_ >= 32) run_gemm(lds, Z, ZW, WQ, 512, T, QW, 512, E, wv, c_ - 32, 224, 4);
          else run_gemm(lds, Z, ZW, WQ, 512, T, QW, 512, E, wv, 896 + c_, 32, 2); }
        { pg8::EpiBf16 E{KV, KVW, SSKV, 1.f / 512.f}; run_gemm(lds, Z + 512, ZW, WKV, 512, T, KVW, 512, E, wv); }
    }
    SEAM(4);
    if (IN(5)) { PH_WS
        const int c = blockIdx.x;
        for (int u = c; u < (T / 128) * 8; u += G) gmlp_unit(Z, WSP, b_s, g_v, H, SSG, u >> 3, u & 7, (char*)lds_raw, wv);
        for (int u = c; u < 256 + 1024; u += G) {
            int head, row0, krow0, seq;
            if (u < 256) { head = u & 7; row0 = (u >> 3) * 256; krow0 = 0; seq = TP; }
            else { const int v = u - 256; head = v & 7; const int idx = v >> 3; const int sq = idx >> 3, qb = idx & 7; krow0 = TP + sq * 2048; row0 = krow0 + qb * 256; seq = 2048; }
            __syncthreads();
            att::attn_dense_body(Q + (size_t)row0 * QW + head * 192, KV + (size_t)krow0 * KVW + head * 256, Z + (size_t)krow0 * ZW + Z_KR, KV + (size_t)krow0 * KVW + head * 256 + 128,
                                 H + (size_t)row0 * DM + head * 128, SSA + row0, seq, (char*)lds_raw, wv);
        }
    }
    SEAM(5);
    if (IN(7)) { PH_WS pg8::EpiMix E{X1B, X2B, DM, SSA, SSG}; run_gemm<pg8::EpiMix, 0, true>(lds, H, DM, WOUT, DM, T, DM, DM, E, wv); }
    SEAM(7);
    { PH_WS LANE_INIT for (int m = gw; m < T; m += NGW) bf16_row_to_i8(X2B + (size_t)m * DM, (unsigned char*)H + (size_t)m * DM, RS2 + m, lane); }
    SEAM(7);
    if (IN(8)) { PH_WS pg8::EpiSwiGLU<FP8_DOWN2 != 0> E{ACT, DFF, RS2, CM + 2 * DFF, CM + 3 * DFF, 1.f / 127.f}; run_gemm<pg8::EpiSwiGLU<FP8_DOWN2 != 0>, 2>(lds, H, DM, W2U, DM, T, 2 * DFF, DM, E, wv); }
    SEAM(8);
    if (IN(9)) { PH_WS pg8::EpiResid<true, false, 1, true, FP8_DOWN2 != 0, true, false> E{X2B, nullptr, DM, H2, SS3, nullptr, CM + 4 * DFF, 1.f / (W8MAX * ACT8SCALE)}; run_gemm<pg8::EpiResid<true, false, 1, true, FP8_DOWN2 != 0, true, false>, FP8_DOWN2 ? 1 : 0>(lds, ACT, DFF, W2D, DFF, T, DM, DFF, E, wv); }
    SEAM(9);
    if (IN(10)) {
        PH_WS LANE_INIT
        for (int m = gw; m < T; m += NGW) { const u32x4* hr = (const u32x4*)(H2 + (size_t)m * DM) + lane; f32x4* xr = (f32x4*)(X + (size_t)m * DM); const float rs = __builtin_amdgcn_rsqf(pg8::ss_get(SS3 + m) * (1.f / DM) + EPS);
            u32x4 w[4];
#pragma unroll
            for (int j = 0; j < 4; ++j) w[j] = hr[64 * j];
#pragma unroll
            for (int j = 0; j < 4; ++j) { float f[8]; unpack8(w[j], f); const int c8 = (lane + 64 * j) * 2; const f32x4 g0 = ((const f32x4*)g_final)[c8], g1 = ((const f32x4*)g_final)[c8 + 1];
                xr[c8] = (f32x4){f[0] * rs * g0.x, f[1] * rs * g0.y, f[2] * rs * g0.z, f[3] * rs * g0.w}; xr[c8 + 1] = (f32x4){f[4] * rs * g1.x, f[5] * rs * g1.y, f[6] * rs * g1.z, f[7] * rs * g1.w}; } }
    }
#undef IN
#undef SEAM
}

extern "C" void kernel_launch(void* const* d_in, const int* in_sizes, int n_in, void* d_out, int out_size, void* d_ws, size_t ws_size, hipStream_t stream) {
    static int grid = 0;
    if (grid == 0) {
        if (n_in != 23 || out_size != T * DM || ws_size < WS_END) { fprintf(stderr, "kernel_launch: unexpected shapes: n_in %d out %d ws %zu\n", n_in, out_size, ws_size); grid = -1; return; }
        int dev = 0, cus = 0, per_cu = 0;
        if (hipGetDevice(&dev) != hipSuccess || hipDeviceGetAttribute(&cus, hipDeviceAttributeMultiprocessorCount, dev) != hipSuccess) { grid = -1; return; }
        if (hipFuncSetAttribute((const void*)mk_fwd, hipFuncAttributeMaxDynamicSharedMemorySize, LDS_BYTES) != hipSuccess) { fprintf(stderr, "kernel_launch: hipFuncSetAttribute failed\n"); grid = -1; return; }
        if (hipOccupancyMaxActiveBlocksPerMultiprocessor(&per_cu, (const void*)mk_fwd, 512, LDS_BYTES) != hipSuccess || per_cu < 1) { fprintf(stderr, "kernel_launch: occupancy query says %d\n", per_cu); per_cu = 1; }
        (void)hipGetLastError();
        grid = cus * per_cu;
    }
    if (grid < 0) return;
    if (hipMemsetAsync((char*)d_ws + WS_CM, 0, CM_BYTES, stream) != hipSuccess) { fprintf(stderr, "kernel_launch: hipMemsetAsync failed\n"); return; }
    Args a{};
    for (int i = 0; i < 23; ++i) a.in[i] = (const float*)d_in[i];
    a.out = (float*)d_out; a.ws = (unsigned char*)d_ws;
    a.ph_lo = 0; a.ph_hi = NPHASE;
    void* kargs[] = {&a};
    hipError_t e = hipLaunchCooperativeKernel((const void*)mk_fwd, dim3(grid), dim3(512), kargs, LDS_BYTES, stream);
    if (e != hipSuccess) fprintf(stderr, "cooperative launch failed: %s (grid %d)\n", hipGetErrorString(e), grid);
}
```

```cpp
#include <hip/hip_runtime.h>
#include <hip/hip_cooperative_groups.h>
#include <cstdio>
#include <cstdint>
namespace cg = cooperative_groups;

#ifndef FP8_FFN1
#define FP8_FFN1 0
#endif
#ifndef FP8_FFN2
#define FP8_FFN2 1
#endif
constexpr float W8SCALE = 32.f;
#ifndef FP8_DOWN2
#define FP8_DOWN2 1
#endif
constexpr float ACT8SCALE = 8.f, W8MAX = 256.f;
#ifndef MK_ONE_LAUNCH
#define MK_ONE_LAUNCH 1
#endif

__device__ __forceinline__ int tid_of(int wv) { int l; asm volatile("v_mbcnt_lo_u32_b32 %0, -1, 0\n\tv_mbcnt_hi_u32_b32 %0, -1, %0" : "=v"(l)); return wv * 64 + l; }
template <int MASK> __device__ __forceinline__ float xor_get(float v) { return __int_as_float(__builtin_amdgcn_ds_swizzle(__float_as_int(v), 0x1F | (MASK << 10))); }
__device__ __forceinline__ float xor32_sum(float v) { auto rr = __builtin_amdgcn_permlane32_swap(__float_as_uint(v), __float_as_uint(v), false, false); return __uint_as_float(rr[0]) + __uint_as_float(rr[1]); }
namespace pg8 {
#define PG8_LAS __attribute__((address_space(3)))
typedef unsigned short bf16_t;
typedef short bf16x8 __attribute__((ext_vector_type(8)));
typedef float f32x4 __attribute__((ext_vector_type(4)));
typedef unsigned u32x4 __attribute__((ext_vector_type(4)));
constexpr int BM = 256, BK = 64, HALF = 128, HTB = HALF * BK * 2, STAGE_BYTES = 8 * HTB, NXCD = 8, WGM = 4;

__host__ __device__ __forceinline__ int lds_byte(int r, int c) { const int st = (r >> 4) * 2 + (c >> 5), rr = r & 15, cc = c & 31, ob = rr * 64 + cc * 2; return st * 1024 + (ob ^ (((ob >> 9) & 1) << 5)); }
__host__ __device__ __forceinline__ void stage_rc(int b, int& R, int& C) { const int st = b / 1024, sb = b % 1024, swz = sb ^ (((sb >> 9) & 1) << 5); R = (st >> 1) * 16 + swz / 64; C = (st & 1) * 32 + (swz % 64) / 2; }
__host__ __device__ __forceinline__ int perm32(int rho) { const int n = rho >> 4, i = rho & 15; return 8 * (i >> 2) + 4 * n + (i & 3); }

typedef unsigned long long u64;
constexpr float SSFIX = 1048576.f;
__device__ __forceinline__ float ss_get(const u64* p) { return (float)(*p) * (1.f / SSFIX); }
__device__ __forceinline__ void ss_add(u64* p, float v) { atomicAdd(p, (u64)(v * SSFIX)); }
struct Unit { int pm, pn; };
struct Gemm { const void* A; const void* Bt; int M, N, K, lda, ldb; };
typedef int i32x4 __attribute__((ext_vector_type(4)));
typedef int i32x8 __attribute__((ext_vector_type(8)));
__device__ __forceinline__ i32x8 cat8(bf16x8 lo, bf16x8 hi) { return __builtin_shufflevector(__builtin_bit_cast(i32x4, lo), __builtin_bit_cast(i32x4, hi), 0, 1, 2, 3, 4, 5, 6, 7); }

struct StaticOrder {
    int nM, nN, nwg, G, c, base, stride, cnt;
    __host__ __device__ void init(int M, int N, int G_, int c_) { nM = M / BM; nN = N / BM; nwg = nM * nN; G = G_; c = c_; base = c_; stride = G_; cnt = 0x7fffffff; }
    __host__ __device__ bool next(int i, Unit& u) const {
        if (i >= cnt) return false;
        const long L = (long)i * stride + base; if (L >= nwg) return false;
        int wgid = (int)L; { const int q = nwg / NXCD, r = nwg % NXCD, xcd = wgid % NXCD, off = wgid / NXCD; wgid = (xcd < r ? xcd * (q + 1) : r * (q + 1) + (xcd - r) * q) + off; }
        const int nig = WGM * nN, gid = wgid / nig, fm = gid * WGM, gsz = (nM - fm) < WGM ? (nM - fm) : WGM;
        u.pm = fm + ((wgid % nig) % gsz); u.pn = (wgid % nig) / gsz; return true;
    }
    __device__ __forceinline__ void a_ready(const Unit&) const {}
    __device__ __forceinline__ void done(const Unit&) const {}
};

__device__ __forceinline__ unsigned cvt_pk_bf16(float lo, float hi) { unsigned r; asm volatile("v_cvt_pk_bf16_f32 %0, %1, %2" : "=v"(r) : "v"(lo), "v"(hi)); return r; }

struct EpiBf16 {
    static constexpr bool PERM = true, AFTER_DRAIN = false;
    bf16_t* O; int ldc; const u64* ss; float inv_n;
    __device__ __forceinline__ void operator()(const f32x4 (&acc)[2][2][4][2], const Unit& u, int wr, int wc, int fr, int fq) const {
        const int row0 = u.pm * BM + wr * 64 + fr; const int col0 = u.pn * BM + wc * 32 + 8 * fq;
#pragma unroll
        for (int ai = 0; ai < 2; ++ai)
#pragma unroll
            for (int m = 0; m < 4; ++m) { const int row = row0 + ai * HALF + m * 16; bf16_t* rowp = O + (size_t)row * ldc + col0;
                const float rs = ss ? __builtin_amdgcn_rsqf(ss_get(ss + row) * inv_n + 1e-6f) : 1.f;
#pragma unroll
                for (int bj = 0; bj < 2; ++bj) { const f32x4 v0 = acc[ai][bj][m][0] * rs, v1 = acc[ai][bj][m][1] * rs;
                    u32x4 w; w.x = cvt_pk_bf16(v0[0], v0[1]); w.y = cvt_pk_bf16(v0[2], v0[3]); w.z = cvt_pk_bf16(v1[0], v1[1]); w.w = cvt_pk_bf16(v1[2], v1[3]);
                    *(u32x4*)(rowp + bj * HALF) = w; } }
    }
};
__device__ __forceinline__ float gelu_t(float x) { const float t = -2.302208198f * (x + 0.044715f * x * x * x); return x * __builtin_amdgcn_rcpf(1.0f + __builtin_amdgcn_exp2f(t)); }
__device__ __forceinline__ void rope8(f32x4& v0, f32x4& v1, const float* rp, int i0) {
    const f32x4 cs = *(const f32x4*)(rp + i0), sn = *(const f32x4*)(rp + 32 + i0);
    f32x4 a, b; a[0] = v0[0] * cs[0] - v0[1] * sn[0]; a[1] = v0[0] * sn[0] + v0[1] * cs[0]; a[2] = v0[2] * cs[1] - v0[3] * sn[1]; a[3] = v0[2] * sn[1] + v0[3] * cs[1];
    b[0] = v1[0] * cs[2] - v1[1] * sn[2]; b[1] = v1[0] * sn[2] + v1[1] * cs[2]; b[2] = v1[2] * cs[3] - v1[3] * sn[3]; b[3] = v1[2] * sn[3] + v1[3] * cs[3]; v0 = a; v1 = b;
}
struct EpiZ {
    static constexpr bool PERM = true, AFTER_DRAIN = false;
    bf16_t* O; int ldc; const u64* ssx; u64* ssq; u64* sskv; const float* rope;
    __device__ __forceinline__ void operator()(const f32x4 (&acc)[2][2][4][2], const Unit& u, int wr, int wc, int fr, int fq) const {
        const int row0 = u.pm * BM + wr * 64 + fr; const int col0 = u.pn * BM + wc * 32 + 8 * fq; const int pn = u.pn;
#pragma unroll
        for (int ai = 0; ai < 2; ++ai)
#pragma unroll
            for (int m = 0; m < 4; ++m) { const int row = row0 + ai * HALF + m * 16; bf16_t* rowp = O + (size_t)row * ldc + col0;
                const float rs = __builtin_amdgcn_rsqf(ss_get(ssx + row) * (1.f / 2048.f) + 1e-6f); float sq = 0.f;
#pragma unroll
                for (int bj = 0; bj < 2; ++bj) { f32x4 v0 = acc[ai][bj][m][0] * rs, v1 = acc[ai][bj][m][1] * rs;
                    if (pn < 4) { sq += (v0[0] * v0[0] + v0[1] * v0[1]) + (v0[2] * v0[2] + v0[3] * v0[3]) + (v1[0] * v1[0] + v1[1] * v1[1]) + (v1[2] * v1[2] + v1[3] * v1[3]); }
                    else if (pn == 4) { if (bj == 0 && wc < 2) { const int pos = row < 8192 ? row : (row & 2047); rope8(v0, v1, rope + (size_t)pos * 64, (wc * 32 + 8 * fq) >> 1); } }
                    else {
#pragma unroll
                        for (int e = 0; e < 4; ++e) { v0[e] = gelu_t(v0[e]); v1[e] = gelu_t(v1[e]); } }
                    u32x4 w; w.x = cvt_pk_bf16(v0[0], v0[1]); w.y = cvt_pk_bf16(v0[2], v0[3]); w.z = cvt_pk_bf16(v1[0], v1[1]); w.w = cvt_pk_bf16(v1[2], v1[3]);
                    *(u32x4*)(rowp + bj * HALF) = w; }
                if (pn < 4) { sq += xor_get<16>(sq); sq = xor32_sum(sq); if (fq == 0) ss_add((pn < 2 ? ssq : sskv) + row, sq); } }
    }
};
struct EpiQRope {
    static constexpr bool PERM = true, AFTER_DRAIN = false;
    bf16_t* O; int ldc; const float* rope; const u64* ss;
    __device__ __forceinline__ void operator()(const f32x4 (&acc)[2][2][4][2], const Unit& u, int wr, int wc, int fr, int fq) const {
        const int row0 = u.pm * BM + wr * 64 + fr; const int col0 = u.pn * BM + wc * 32 + 8 * fq;
#pragma unroll
        for (int ai = 0; ai < 2; ++ai)
#pragma unroll
            for (int m = 0; m < 4; ++m) { const int row = row0 + ai * HALF + m * 16; bf16_t* rowp = O + (size_t)row * ldc + col0;
                const int pos = row < 8192 ? row : (row & 2047); const float rs = __builtin_amdgcn_rsqf(ss_get(ss + row) * (1.f / 512.f) + 1e-6f);
#pragma unroll
                for (int bj = 0; bj < 2; ++bj) { f32x4 v0 = acc[ai][bj][m][0] * rs, v1 = acc[ai][bj][m][1] * rs;
                    const int c = col0 + bj * HALF; const int d = c % 192;
                    if (d >= 128) rope8(v0, v1, rope + (size_t)pos * 64, (d - 128) >> 1);
                    u32x4 w; w.x = cvt_pk_bf16(v0[0], v0[1]); w.y = cvt_pk_bf16(v0[2], v0[3]); w.z = cvt_pk_bf16(v1[0], v1[1]); w.w = cvt_pk_bf16(v1[2], v1[3]);
                    *(u32x4*)(rowp + bj * HALF) = w; } }
    }
};
template <bool OUT8 = false> struct EpiSwiGLU {
    static constexpr bool PERM = true, AFTER_DRAIN = false;
    bf16_t* O; int ldc; const float* rsc; const float* cmg; const float* cmu; float cscale;
    __device__ __forceinline__ void operator()(const f32x4 (&acc)[2][2][4][2], const Unit& u, int wr, int wc, int fr, int fq) const {
        const int row0 = u.pm * BM + wr * 64 + fr; const int col0 = u.pn * HALF + wc * 32 + 8 * fq;
        f32x4 sg[2], su[2];
#pragma unroll
        for (int n = 0; n < 2; ++n) { sg[n] = cmg ? *(const f32x4*)(cmg + col0 + 4 * n) * cscale : (f32x4){1.f, 1.f, 1.f, 1.f}; su[n] = cmu ? *(const f32x4*)(cmu + col0 + 4 * n) * cscale : (f32x4){1.f, 1.f, 1.f, 1.f}; }
#pragma unroll
        for (int ai = 0; ai < 2; ++ai) { unsigned pw[4][2];
#pragma unroll
            for (int m = 0; m < 4; ++m) { const int row = row0 + ai * HALF + m * 16; bf16_t* rowp = O + (size_t)row * ldc + col0;
                const float rs = rsc ? rsc[row] : 1.f;
                f32x4 r[2];
#pragma unroll
                for (int n = 0; n < 2; ++n) { const f32x4 g = acc[ai][0][m][n] * sg[n] * rs, up = acc[ai][1][m][n] * su[n] * rs;
#pragma unroll
                    for (int e = 0; e < 4; ++e) { const float sgm = __builtin_amdgcn_rcpf(1.0f + __builtin_amdgcn_exp2f(-1.4426950408889634f * g[e])); r[n][e] = g[e] * sgm * up[e]; } }
                if constexpr (OUT8) { typedef unsigned u32x2v __attribute__((ext_vector_type(2))); _Pragma("unroll") for (int e = 0; e < 4; ++e) { r[0][e] = __builtin_amdgcn_fmed3f(r[0][e] * ACT8SCALE, -448.f, 448.f); r[1][e] = __builtin_amdgcn_fmed3f(r[1][e] * ACT8SCALE, -448.f, 448.f); }

                    int w0 = __builtin_amdgcn_cvt_pk_fp8_f32(r[0][0], r[0][1], 0, false); w0 = __builtin_amdgcn_cvt_pk_fp8_f32(r[0][2], r[0][3], w0, true);
                    int w1 = __builtin_amdgcn_cvt_pk_fp8_f32(r[1][0], r[1][1], 0, false); w1 = __builtin_amdgcn_cvt_pk_fp8_f32(r[1][2], r[1][3], w1, true);
                    pw[m][0] = (unsigned)w0; pw[m][1] = (unsigned)w1; (void)rowp; }
                else { u32x4 w; w.x = cvt_pk_bf16(r[0][0], r[0][1]); w.y = cvt_pk_bf16(r[0][2], r[0][3]); w.z = cvt_pk_bf16(r[1][0], r[1][1]); w.w = cvt_pk_bf16(r[1][2], r[1][3]);
                    *(u32x4*)rowp = w; } }
            if constexpr (OUT8) {
                const bool odd = (fq & 1) != 0;
#pragma unroll
                for (int k2 = 0; k2 < 2; ++k2) { const unsigned a0 = pw[2 * k2][0], a1 = pw[2 * k2][1], b0 = pw[2 * k2 + 1][0], b1 = pw[2 * k2 + 1][1];
                    const unsigned r0 = (unsigned)__builtin_amdgcn_ds_swizzle((int)(odd ? a0 : b0), 0x401F), r1 = (unsigned)__builtin_amdgcn_ds_swizzle((int)(odd ? a1 : b1), 0x401F);
                    const u32x4 w = odd ? (u32x4){r0, r1, b0, b1} : (u32x4){a0, a1, r0, r1};
                    const int row = row0 + ai * HALF + (2 * k2 + (odd ? 1 : 0)) * 16;
                    *(u32x4*)((unsigned char*)O + (size_t)row * ldc + (col0 - (odd ? 8 : 0))) = w; } } }
    }
};
template <bool HAS_XB, bool HAS_X8, int ALPHA2, bool HAS_SS = true, bool HAS_CS = false, bool BASE16 = false, bool HAS_OUT = true> struct EpiResid {
    static constexpr bool PERM = true, AFTER_DRAIN = false; static constexpr float alpha = 0.5f * ALPHA2;
    const void* base; float* out; int ldc; bf16_t* xb; u64* ss; unsigned char* x8; const float* cs; float csmul;
    __device__ __forceinline__ void operator()(const f32x4 (&acc)[2][2][4][2], const Unit& u, int wr, int wc, int fr, int fq) const {
        const int row0 = u.pm * BM + wr * 64 + fr; const int col0 = u.pn * BM + wc * 32 + 8 * fq;
        f32x4 csv[2][2];
#pragma unroll
        for (int bj = 0; bj < 2; ++bj)
#pragma unroll
            for (int n = 0; n < 2; ++n) csv[bj][n] = HAS_CS ? *(const f32x4*)(cs + col0 + bj * HALF + 4 * n) * (csmul * alpha) : (f32x4){alpha, alpha, alpha, alpha};
#pragma unroll
        for (int ai = 0; ai < 2; ++ai)
#pragma unroll
            for (int m = 0; m < 4; ++m) { const int row = row0 + ai * HALF + m * 16; const size_t off = (size_t)row * ldc + col0; float sq = 0.f;
#pragma unroll
                for (int bj = 0; bj < 2; ++bj) { const size_t p = off + bj * HALF; f32x4 b0, b1;
                    if constexpr (BASE16) { const u32x4 wb = *(const u32x4*)((const bf16_t*)base + p);
                        b0 = (f32x4){__uint_as_float(wb.x << 16), __uint_as_float(wb.x & 0xffff0000u), __uint_as_float(wb.y << 16), __uint_as_float(wb.y & 0xffff0000u)};
                        b1 = (f32x4){__uint_as_float(wb.z << 16), __uint_as_float(wb.z & 0xffff0000u), __uint_as_float(wb.w << 16), __uint_as_float(wb.w & 0xffff0000u)}; }
                    else { b0 = *(const f32x4*)((const float*)base + p); b1 = *(const f32x4*)((const float*)base + p + 4); }
                    const f32x4 v0 = b0 + acc[ai][bj][m][0] * csv[bj][0], v1 = b1 + acc[ai][bj][m][1] * csv[bj][1];
                    if constexpr (HAS_OUT) { *(f32x4*)(out + p) = v0; *(f32x4*)(out + p + 4) = v1; }
                    if constexpr (HAS_XB) { u32x4 w; w.x = cvt_pk_bf16(v0[0], v0[1]); w.y = cvt_pk_bf16(v0[2], v0[3]); w.z = cvt_pk_bf16(v1[0], v1[1]); w.w = cvt_pk_bf16(v1[2], v1[3]); *(u32x4*)(xb + p) = w; }
                    sq += ((v0[0] * v0[0] + v0[1] * v0[1]) + (v0[2] * v0[2] + v0[3] * v0[3])) + ((v1[0] * v1[0] + v1[1] * v1[1]) + (v1[2] * v1[2] + v1[3] * v1[3])); }
                if constexpr (HAS_SS) { sq += xor_get<16>(sq); sq = xor32_sum(sq); if (fq == 0) ss_add(ss + row, sq); } }
    }
};

struct EpiMix {
    static constexpr bool PERM = true, AFTER_DRAIN = false;
    const bf16_t* base; bf16_t* xb; int ldc; const u64* ssa; const u64* ssg;
    __device__ __forceinline__ void mid(f32x4 (&acc)[2][2][4][2], const Unit& u, int wr, int fr) const {
        const int row0 = u.pm * BM + wr * 64 + fr;
#pragma unroll
        for (int ai = 0; ai < 2; ++ai)
#pragma unroll
            for (int m = 0; m < 4; ++m) { const int row = row0 + ai * HALF + m * 16;
                const float ra = __builtin_amdgcn_rsqf(ss_get(ssa + row) * (1.f / 1024.f) + 1e-6f), rg = __builtin_amdgcn_rsqf(ss_get(ssg + row) * (1.f / 1024.f) + 1e-6f);
                const float ratio = ra * __builtin_amdgcn_rcpf(rg);
#pragma unroll
                for (int bj = 0; bj < 2; ++bj)
#pragma unroll
                    for (int n = 0; n < 2; ++n) acc[ai][bj][m][n] = acc[ai][bj][m][n] * ratio; }
    }
    __device__ __forceinline__ void operator()(const f32x4 (&acc)[2][2][4][2], const Unit& u, int wr, int wc, int fr, int fq) const {
        const int row0 = u.pm * BM + wr * 64 + fr; const int col0 = u.pn * BM + wc * 32 + 8 * fq;
#pragma unroll
        for (int ai = 0; ai < 2; ++ai)
#pragma unroll
            for (int m = 0; m < 4; ++m) { const int row = row0 + ai * HALF + m * 16; const size_t off = (size_t)row * ldc + col0;
                const float rg = __builtin_amdgcn_rsqf(ss_get(ssg + row) * (1.f / 1024.f) + 1e-6f);
#pragma unroll
                for (int bj = 0; bj < 2; ++bj) { const size_t p = off + bj * HALF; const u32x4 wb = *(const u32x4*)(base + p);
                    const f32x4 b0 = {__uint_as_float(wb.x << 16), __uint_as_float(wb.x & 0xffff0000u), __uint_as_float(wb.y << 16), __uint_as_float(wb.y & 0xffff0000u)};
                    const f32x4 b1 = {__uint_as_float(wb.z << 16), __uint_as_float(wb.z & 0xffff0000u), __uint_as_float(wb.w << 16), __uint_as_float(wb.w & 0xffff0000u)};
                    const f32x4 v0 = b0 + acc[ai][bj][m][0] * rg, v1 = b1 + acc[ai][bj][m][1] * rg;
                    u32x4 w; w.x = cvt_pk_bf16(v0[0], v0[1]); w.y = cvt_pk_bf16(v0[2], v0[3]); w.z = cvt_pk_bf16(v1[0], v1[1]); w.w = cvt_pk_bf16(v1[2], v1[3]); *(u32x4*)(xb + p) = w; } }
    }
};

template <class Epi, class Sched, bool ALIGN_EPI = false, bool SP2 = false, int MODE = 0, bool MID = false>
__device__ __forceinline__ void gemm_phase(PG8_LAS unsigned char* lds, const Gemm g, const Sched S, const Epi E, const int wv) {
    const int tid = tid_of(wv), wid = __builtin_amdgcn_readfirstlane(tid >> 6), lane = tid & 63, wr = wid >> 2, wc = wid & 3, fr = lane & 15, fq = lane >> 4;
    constexpr bool FP8 = MODE == 1, BYTE_ELEMS = MODE != 0; constexpr int ES = BYTE_ELEMS ? 1 : 2;
    const int K = g.K, nt = K * ES / 128;
    unsigned voffA[2], voffB[2];
#pragma unroll
    for (int i = 0; i < 2; ++i) { int R, C; stage_rc(tid * 16 + i * 8192, R, C); const int Rb = Epi::PERM ? ((R & ~31) + perm32(R & 31)) : R;
        voffA[i] = (unsigned)(R * g.lda * ES + C * 2); voffB[i] = (unsigned)(Rb * g.ldb * ES + C * 2); }
    const size_t roffA = (size_t)64 * g.lda * ES, roffB = (size_t)64 * g.ldb * ES;
    const size_t kstep = (size_t)(BK * 2);
    const size_t hstepA = (size_t)HALF * g.lda * ES, hstepB = (size_t)HALF * g.ldb * ES;
    const size_t tstepA = 2 * hstepA, tstepB = 2 * hstepB;
    const unsigned ldsw = (unsigned)wid * 1024u;
    const int aoff = lds_byte(wr * 64 + fr, fq * 8), boff = lds_byte(wc * 32 + fr, fq * 8);
#define PG8_SA(b, h) (((b) * 2 + (h)) * HTB)
#define PG8_SB(b, h) ((4 + (b) * 2 + (h)) * HTB)
#define PG8_STAGE(bufoff, gbase, voff) do { _Pragma("unroll") for (int _i = 0; _i < 2; ++_i) \
        __builtin_amdgcn_global_load_lds((const unsigned*)((const char*)(gbase) + (BYTE_ELEMS ? _i * r##voff + (v##voff)[0] : (v##voff)[_i])), (PG8_LAS unsigned*)(lds + (bufoff) + ldsw + _i * 8192), 16, 0, 0); } while (0)
#define PG8_LDA(dst, b, h) do { _Pragma("unroll") for (int m = 0; m < 4; ++m) _Pragma("unroll") for (int k = 0; k < 2; ++k) dst[m][k] = *(const PG8_LAS bf16x8*)(lds + PG8_SA(b, h) + aoff + m * 2048 + k * 1024); } while (0)
#define PG8_LDB(dst, b, h) do { _Pragma("unroll") for (int n = 0; n < 2; ++n) _Pragma("unroll") for (int k = 0; k < 2; ++k) dst[n][k] = *(const PG8_LAS bf16x8*)(lds + PG8_SB(b, h) + boff + n * 2048 + k * 1024); } while (0)
#define PG8_MMA(ai, bj, At, Bt) do { __builtin_amdgcn_s_setprio(1); if constexpr (FP8) { _Pragma("unroll") for (int m = 0; m < 4; ++m) _Pragma("unroll") for (int n = 0; n < 2; ++n) \
        acc[ai][bj][m][n] = __builtin_amdgcn_mfma_scale_f32_16x16x128_f8f6f4(cat8(Bt[n][0], Bt[n][1]), cat8(At[m][0], At[m][1]), acc[ai][bj][m][n], 0, 0, 0, 0, 0, 0); } \
      else if constexpr (MODE == 2) { _Pragma("unroll") for (int m = 0; m < 4; ++m) _Pragma("unroll") for (int n = 0; n < 2; ++n) _Pragma("unroll") for (int k = 0; k < 2; ++k) \
        acc[ai][bj][m][n] = __builtin_bit_cast(f32x4, __builtin_amdgcn_mfma_i32_16x16x64_i8(__builtin_bit_cast(i32x4, Bt[n][k]), __builtin_bit_cast(i32x4, At[m][k]), __builtin_bit_cast(i32x4, acc[ai][bj][m][n]), 0, 0, 0)); } \
      else { _Pragma("unroll") for (int m = 0; m < 4; ++m) _Pragma("unroll") for (int n = 0; n < 2; ++n) _Pragma("unroll") for (int k = 0; k < 2; ++k) \
        acc[ai][bj][m][n] = __builtin_amdgcn_mfma_f32_16x16x32_bf16(Bt[n][k], At[m][k], acc[ai][bj][m][n], 0, 0, 0); } __builtin_amdgcn_s_setprio(0); } while (0)
#define PG8_WAIT_V(n) asm volatile("s_waitcnt vmcnt(" #n ")" ::: "memory")
#define PG8_WAIT_L(n) asm volatile("s_waitcnt lgkmcnt(" #n ")" ::: "memory")
#define PG8_BAR __builtin_amdgcn_s_barrier()
#define PG8_SCHED __builtin_amdgcn_sched_barrier(0)
    Unit cur, nxt; int ui = 0;
    if (!S.next(0, cur)) return;
    f32x4 acc[2][2][4][2];
#pragma unroll
    for (int a = 0; a < 2; ++a)
#pragma unroll
        for (int b = 0; b < 2; ++b)
#pragma unroll
            for (int m = 0; m < 4; ++m)
#pragma unroll
                for (int n = 0; n < 2; ++n) acc[a][b][m][n] = (f32x4){0.f, 0.f, 0.f, 0.f};
    bf16x8 At[4][2], B0[2][2], B1[2][2];
    const char* cA = (const char*)g.A + (size_t)cur.pm * tstepA; const char* cB = (const char*)g.Bt + (size_t)cur.pn * tstepB;
    S.a_ready(cur);
    if constexpr (SP2) {
        PG8_STAGE(PG8_SB(0, 0), cB, offB); PG8_STAGE(PG8_SB(0, 1), cB + hstepB, offB); PG8_STAGE(PG8_SA(0, 0), cA, offA); PG8_STAGE(PG8_SA(0, 1), cA + hstepA, offA);
        if (wr == 1) PG8_BAR;
        PG8_WAIT_V(2); PG8_BAR;
        PG8_STAGE(PG8_SB(1, 0), cB + kstep, offB); PG8_STAGE(PG8_SA(1, 0), cA + kstep, offA); PG8_STAGE(PG8_SB(1, 1), cB + hstepB + kstep, offB);
        PG8_WAIT_V(6); PG8_BAR;
    } else {
        PG8_STAGE(PG8_SB(0, 0), cB, offB); PG8_STAGE(PG8_SA(0, 0), cA, offA); PG8_STAGE(PG8_SB(0, 1), cB + hstepB, offB); PG8_STAGE(PG8_SA(0, 1), cA + hstepA, offA);
        if (wr == 1) PG8_BAR;
        PG8_WAIT_V(4); PG8_BAR;
        PG8_STAGE(PG8_SB(1, 0), cB + kstep, offB); PG8_STAGE(PG8_SA(1, 0), cA + kstep, offA); PG8_STAGE(PG8_SB(1, 1), cB + hstepB + kstep, offB);
        PG8_WAIT_V(6); PG8_BAR;
    }
    for (;;) {
        const bool has_next = S.next(ui + 1, nxt);
        const char* nA = has_next ? (const char*)g.A + (size_t)nxt.pm * tstepA : cA; const char* nB = has_next ? (const char*)g.Bt + (size_t)nxt.pn * tstepB : cB;
        for (int t = 0; t < nt; t += 2) {
            const bool last = (t == nt - 2);
            const char* a1 = cA + (size_t)(t + 1) * kstep;
            const char* a2 = last ? nA : cA + (size_t)(t + 2) * kstep; const char* b2 = last ? nB : cB + (size_t)(t + 2) * kstep;
            const char* a3 = a2 + kstep; const char* b3 = b2 + kstep;
            if (last && has_next) S.a_ready(nxt);
            if constexpr (MID) { if (t == nt / 2) { const int t3 = tid_of(wv); E.mid(acc, cur, wid >> 2, t3 & 15); } }
            if constexpr (SP2) {
            PG8_LDB(B0, 0, 0); PG8_LDB(B1, 0, 1); PG8_SCHED; PG8_LDA(At, 0, 0); PG8_STAGE(PG8_SA(1, 1), a1 + hstepA, offA);
            PG8_WAIT_V(8); PG8_WAIT_L(0); PG8_BAR; PG8_MMA(0, 0, At, B0); PG8_MMA(0, 1, At, B1); PG8_BAR; PG8_SCHED;
            PG8_LDA(At, 0, 1); PG8_STAGE(PG8_SB(0, 0), b2, offB); PG8_STAGE(PG8_SB(0, 1), b2 + hstepB, offB); PG8_STAGE(PG8_SA(0, 0), a2, offA);
            PG8_WAIT_V(8); PG8_WAIT_L(0); PG8_BAR; PG8_MMA(1, 0, At, B0); PG8_MMA(1, 1, At, B1); PG8_BAR; PG8_SCHED;
            PG8_LDB(B0, 1, 0); PG8_LDB(B1, 1, 1); PG8_SCHED; PG8_LDA(At, 1, 0); PG8_STAGE(PG8_SA(0, 1), a2 + hstepA, offA);
            PG8_WAIT_V(8); PG8_WAIT_L(0); PG8_BAR; PG8_MMA(0, 0, At, B0); PG8_MMA(0, 1, At, B1); PG8_BAR; PG8_SCHED;
            PG8_LDA(At, 1, 1); PG8_STAGE(PG8_SB(1, 0), b3, offB); PG8_STAGE(PG8_SB(1, 1), b3 + hstepB, offB); PG8_STAGE(PG8_SA(1, 0), a3, offA);
            PG8_WAIT_V(8); PG8_WAIT_L(0); PG8_BAR; PG8_MMA(1, 0, At, B0); PG8_MMA(1, 1, At, B1); PG8_BAR; PG8_SCHED;
            } else {
            PG8_LDB(B0, 0, 0); PG8_SCHED; PG8_LDA(At, 0, 0); PG8_STAGE(PG8_SA(1, 1), a1 + hstepA, offA);
            PG8_WAIT_L(8); PG8_BAR; PG8_WAIT_L(0); PG8_MMA(0, 0, At, B0); PG8_BAR; PG8_SCHED;
            PG8_LDB(B1, 0, 1); PG8_STAGE(PG8_SB(0, 0), b2, offB);
            PG8_BAR; PG8_WAIT_L(0); PG8_MMA(0, 1, At, B1); PG8_BAR;
            PG8_LDA(At, 0, 1); PG8_STAGE(PG8_SA(0, 0), a2, offA);
            PG8_BAR; PG8_WAIT_L(0); PG8_MMA(1, 0, At, B0); PG8_BAR; PG8_SCHED;
            PG8_STAGE(PG8_SB(0, 1), b2 + hstepB, offB);
            PG8_WAIT_V(6); PG8_BAR; PG8_MMA(1, 1, At, B1); PG8_BAR;
            PG8_LDB(B0, 1, 0); PG8_SCHED; PG8_LDA(At, 1, 0); PG8_STAGE(PG8_SA(0, 1), a2 + hstepA, offA);
            PG8_WAIT_L(8); PG8_BAR; PG8_WAIT_L(0); PG8_MMA(0, 0, At, B0); PG8_BAR; PG8_SCHED;
            PG8_LDB(B1, 1, 1); PG8_STAGE(PG8_SB(1, 0), b3, offB);
            PG8_BAR; PG8_WAIT_L(0); PG8_MMA(0, 1, At, B1); PG8_BAR;
            PG8_LDA(At, 1, 1); PG8_STAGE(PG8_SA(1, 0), a3, offA);
            PG8_BAR; PG8_WAIT_L(0); PG8_MMA(1, 0, At, B0); PG8_BAR; PG8_SCHED;
            PG8_STAGE(PG8_SB(1, 1), b3 + hstepB, offB);
            PG8_WAIT_V(6); PG8_BAR; PG8_MMA(1, 1, At, B1); PG8_BAR;
            }
        }
        if constexpr (ALIGN_EPI) { if (wr == 0) PG8_BAR; }
        if constexpr (MODE == 2) {
#pragma unroll
            for (int a = 0; a < 2; ++a)
#pragma unroll
                for (int b = 0; b < 2; ++b)
#pragma unroll
                    for (int m = 0; m < 4; ++m)
#pragma unroll
                        for (int n = 0; n < 2; ++n) { const i32x4 iv = __builtin_bit_cast(i32x4, acc[a][b][m][n]); acc[a][b][m][n] = (f32x4){(float)iv[0], (float)iv[1], (float)iv[2], (float)iv[3]}; } }
        if constexpr (!Epi::AFTER_DRAIN) { const int t2 = tid_of(wv), l2 = t2 & 63; E(acc, cur, wid >> 2, wid & 3, l2 & 15, l2 >> 4); S.done(cur); }
        if (!has_next) break;
#pragma unroll
        for (int a = 0; a < 2; ++a)
#pragma unroll
            for (int b = 0; b < 2; ++b)
#pragma unroll
                for (int m = 0; m < 4; ++m)
#pragma unroll
                    for (int n = 0; n < 2; ++n) acc[a][b][m][n] = (f32x4){0.f, 0.f, 0.f, 0.f};
        cur = nxt; cA = nA; cB = nB; ++ui;
        if constexpr (ALIGN_EPI) { if (wr == 1) PG8_BAR; }
    }
    PG8_WAIT_V(0);
    if constexpr (!ALIGN_EPI) { if (wr == 0) PG8_BAR; }
    PG8_BAR;
#undef PG8_SA
#undef PG8_SB
#undef PG8_STAGE
#undef PG8_LDA
#undef PG8_LDB
#undef PG8_MMA
#undef PG8_WAIT_V
#undef PG8_WAIT_L
#undef PG8_BAR
#undef PG8_SCHED
}
}

typedef unsigned short bf16;
typedef float f32x4 __attribute__((ext_vector_type(4)));
typedef unsigned u32x4 __attribute__((ext_vector_type(4)));
typedef unsigned u32x2 __attribute__((ext_vector_type(2)));
typedef short bf16x8 __attribute__((ext_vector_type(8)));
typedef short s16x4 __attribute__((ext_vector_type(4)));
typedef float f32x16 __attribute__((ext_vector_type(16)));
#define LAS __attribute__((address_space(3)))

constexpr int DM = 2048, DFF = 5632, TP = 8192, TS = 16 * 2048, T = TP + TS;
constexpr int ZW = 3328;
constexpr int Z_KR = 1024, Z_U = 1280, Z_V = 2304;
constexpr int QW = 1536, KVW = 2048;
constexpr float EPS = 1e-6f;
constexpr size_t MiB = 1u << 20;
constexpr size_t WS_ROPE = 1 * MiB;
constexpr size_t WS_W1U = 4 * MiB, WS_W1D = WS_W1U + 44 * MiB, WS_W2U = WS_W1D + 22 * MiB, WS_W2D = WS_W2U + 44 * MiB, WS_WIN = WS_W2D + 22 * MiB;
constexpr size_t WS_WQ = WS_WIN + 13 * MiB, WS_WKV = WS_WQ + 2 * MiB, WS_WOUT = WS_WKV + 2 * MiB, WS_WSP = WS_WOUT + 8 * MiB;
constexpr size_t WS_H = 162 * MiB;
constexpr size_t WS_ACT = 322 * MiB;
constexpr size_t WS_Z = 322 * MiB, WS_Q = 582 * MiB, WS_KV = 702 * MiB;
constexpr size_t WS_H2 = 762 * MiB, WS_SS = 922 * MiB, WS_END = 924 * MiB;
constexpr size_t WS_CM = 64 * 1024, CM_BYTES = (4 * 5632 + 2048) * 4;
constexpr size_t WS_RS = 256 * 1024;
static_assert(WS_WSP + 262144 <= WS_H, "weights fit");
constexpr int LDS_BYTES = 147456;
constexpr int NPHASE = 13;

__device__ __forceinline__ float bf_lo(unsigned w) { return __uint_as_float(w << 16); }
__device__ __forceinline__ float bf_hi(unsigned w) { return __uint_as_float(w & 0xffff0000u); }
__device__ __forceinline__ unsigned pk2(float lo, float hi) { return pg8::cvt_pk_bf16(lo, hi); }
__device__ __forceinline__ void unpack8(const u32x4 w, float (&f)[8]) { f[0] = bf_lo(w.x); f[1] = bf_hi(w.x); f[2] = bf_lo(w.y); f[3] = bf_hi(w.y); f[4] = bf_lo(w.z); f[5] = bf_hi(w.z); f[6] = bf_lo(w.w); f[7] = bf_hi(w.w); }
__device__ __forceinline__ u32x4 pack8(const float (&f)[8]) { u32x4 w; w.x = pk2(f[0], f[1]); w.y = pk2(f[2], f[3]); w.z = pk2(f[4], f[5]); w.w = pk2(f[6], f[7]); return w; }
__device__ __forceinline__ float wave_sum(float v) { v += xor_get<1>(v); v += xor_get<2>(v); v += xor_get<4>(v); v += xor_get<8>(v); v += xor_get<16>(v); return xor32_sum(v); }
__device__ __forceinline__ float gelu_tanh(float x) {
    const float t = -2.302208198f * (x + 0.044715f * x * x * x);
    return x * __builtin_amdgcn_rcpf(1.0f + __builtin_amdgcn_exp2f(t));
}

__constant__ double c_inv_rev[32] = {0.15915494309189535, 0.11934937021124886, 0.08949940160889101, 0.06711508300522726, 0.050329212104487035, 0.03774158471741977, 0.0283021958306234, 0.02122365276477766, 0.015915494309189534, 0.011934937021124886, 0.008949940160889102, 0.006711508300522725, 0.005032921210448704, 0.003774158471741977, 0.00283021958306234, 0.0021223652764777662, 0.0015915494309189536, 0.0011934937021124885, 0.0008949940160889102, 0.0006711508300522726, 0.0005032921210448703, 0.00037741584717419774, 0.00028302195830623395, 0.0002122365276477766, 0.00015915494309189535, 0.00011934937021124886, 8.949940160889102e-05, 6.711508300522725e-05, 5.0329212104487035e-05, 3.774158471741978e-05, 2.8302195830623396e-05, 2.122365276477766e-05};

__device__ __forceinline__ int dst_row(int mode, int n) {
    if (mode == 1) return ((n >> 7) << 8) + (n & 127);
    if (mode == 2) return ((n >> 7) << 8) + 128 + (n & 127);
    if (mode == 3) { if (n < 1024) return n; if (n < 1088) { const int j = n - 1024; return 1024 + (j < 32 ? 2 * j : 2 * (j - 32) + 1); } return n + 192; }
    if (mode == 4) { const int h = n / 192, d = n - h * 192; if (d < 128) return n; const int j = d - 128; return h * 192 + 128 + (j < 32 ? 2 * j : 2 * (j - 32) + 1); }
    return n;
}
__device__ __forceinline__ void p0_transpose_item(const float* W, int K, int N, bf16* WT, int mode, LAS float* scr, int item, int lane, const float* gk = nullptr) {
    const int nblk = N / 64, kb = item / nblk, nb = item % nblk, k0 = 64 * kb, n0 = 64 * nb;
    const int lr = lane >> 4, lc = (lane & 15) * 4;
#pragma unroll 4
    for (int i = 0; i < 16; ++i) { const int kk = 4 * i + lr; f32x4 v = *(const f32x4*)(W + (size_t)(k0 + kk) * N + n0 + lc); if (gk) v = v * gk[k0 + kk];
        LAS float* d = scr + kk * 65 + lc; d[0] = v.x; d[1] = v.y; d[2] = v.z; d[3] = v.w; }
    asm volatile("s_waitcnt lgkmcnt(0)" ::: "memory");
    const int c = lane & 7;
#pragma unroll
    for (int j = 0; j < 8; ++j) { const int n = (lane >> 3) + 8 * j; const LAS float* sp = scr + (8 * c) * 65 + n;
        u32x4 o; o.x = pk2(sp[0 * 65], sp[1 * 65]); o.y = pk2(sp[2 * 65], sp[3 * 65]); o.z = pk2(sp[4 * 65], sp[5 * 65]); o.w = pk2(sp[6 * 65], sp[7 * 65]);
        *(u32x4*)(WT + (size_t)dst_row(mode, n0 + n) * K + k0 + 8 * c) = o; }
    asm volatile("s_waitcnt lgkmcnt(0)" ::: "memory");
}

__device__ __forceinline__ void p0_transpose_item8(const float* W, int K, int N, unsigned char* WT, int mode, LAS float* scr, int item, int lane, const float* gk, float wscale, const float* cm = nullptr) {
    const int nblk = N / 64, kb = item / nblk, nb = item % nblk, k0 = 64 * kb, n0 = 64 * nb;
    const int lr = lane >> 4, lc = (lane & 15) * 4;
#pragma unroll 4
    for (int i = 0; i < 16; ++i) { const int kk = 4 * i + lr; f32x4 v = *(const f32x4*)(W + (size_t)(k0 + kk) * N + n0 + lc); v = v * (wscale * (gk ? gk[k0 + kk] : 1.f));
        LAS float* d = scr + kk * 65 + lc; d[0] = v.x; d[1] = v.y; d[2] = v.z; d[3] = v.w; }
    asm volatile("s_waitcnt lgkmcnt(0)" ::: "memory");
    unsigned char* orow = WT + (size_t)dst_row(mode, n0 + lane) * K + k0; const float ls = cm ? W8MAX / fmaxf(cm[n0 + lane], 1e-30f) : 1.f;
#pragma unroll
    for (int ch = 0; ch < 4; ++ch) { const LAS float* sp = scr + (16 * ch) * 65 + lane; int w[4];
#pragma unroll
        for (int q = 0; q < 4; ++q) { int t = __builtin_amdgcn_cvt_pk_fp8_f32(sp[(4 * q) * 65] * ls, sp[(4 * q + 1) * 65] * ls, 0, false); w[q] = __builtin_amdgcn_cvt_pk_fp8_f32(sp[(4 * q + 2) * 65] * ls, sp[(4 * q + 3) * 65] * ls, t, true); }
        *(u32x4*)(orow + 16 * ch) = (u32x4){(unsigned)w[0], (unsigned)w[1], (unsigned)w[2], (unsigned)w[3]}; }
    asm volatile("s_waitcnt lgkmcnt(0)" ::: "memory");
}
__device__ __forceinline__ void rms_row_to_fp8(const float* xrow, const float* g, unsigned char* orow, int lane) {
    const f32x4* xr = (const f32x4*)xrow + lane;
    f32x4 v[8]; float s = 0.f;
#pragma unroll
    for (int j = 0; j < 8; ++j) { v[j] = xr[64 * j]; s += (v[j].x * v[j].x + v[j].y * v[j].y) + (v[j].z * v[j].z + v[j].w * v[j].w); }
    const float rstd = __builtin_amdgcn_rsqf(wave_sum(s) * (1.f / DM) + EPS);
    int* o4 = (int*)orow + lane;
#pragma unroll
    for (int j = 0; j < 8; ++j) { const f32x4 gg = ((const f32x4*)g)[lane + 64 * j]; int w = __builtin_amdgcn_cvt_pk_fp8_f32(v[j].x * rstd * gg.x, v[j].y * rstd * gg.y, 0, false);
        w = __builtin_amdgcn_cvt_pk_fp8_f32(v[j].z * rstd * gg.z, v[j].w * rstd * gg.w, w, true); o4[64 * j] = w; }
}
__device__ __forceinline__ float wave_max(float v) {
    v = fmaxf(v, xor_get<1>(v)); v = fmaxf(v, xor_get<2>(v)); v = fmaxf(v, xor_get<4>(v)); v = fmaxf(v, xor_get<8>(v)); v = fmaxf(v, xor_get<16>(v));
    auto rr = __builtin_amdgcn_permlane32_swap(__float_as_uint(v), __float_as_uint(v), false, false); return fmaxf(__uint_as_float(rr[0]), __uint_as_float(rr[1]));
}
__device__ __forceinline__ unsigned q8(float v) { int q = (int)__builtin_rintf(v); q = q < -127 ? -127 : (q > 127 ? 127 : q); return (unsigned)q & 0xffu; }
__device__ __forceinline__ unsigned q8x4(float a, float b, float c, float d) { return q8(a) | (q8(b) << 8) | (q8(c) << 16) | (q8(d) << 24); }
__device__ __forceinline__ void p0_colmax_item(const float* W, int K, int N, float* cm, int item, int lane, const float* gk) {
    const int nblk = N / 64, kq = item / nblk, nb = item % nblk, n0 = 64 * nb, kbeg = kq * (K / 4);
    const int lr = lane >> 4, lc = (lane & 15) * 4; f32x4 mx = {0.f, 0.f, 0.f, 0.f};
#pragma unroll 8
    for (int i = 0; i < K / 16; ++i) { const int k = kbeg + 4 * i + lr; f32x4 v = *(const f32x4*)(W + (size_t)k * N + n0 + lc); if (gk) v = v * gk[k];
        mx.x = fmaxf(mx.x, fabsf(v.x)); mx.y = fmaxf(mx.y, fabsf(v.y)); mx.z = fmaxf(mx.z, fabsf(v.z)); mx.w = fmaxf(mx.w, fabsf(v.w)); }
#pragma unroll
    for (int e = 0; e < 4; ++e) { float m = mx[e]; m = fmaxf(m, xor_get<16>(m)); auto rr = __builtin_amdgcn_permlane32_swap(__float_as_uint(m), __float_as_uint(m), false, false); m = fmaxf(__uint_as_float(rr[0]), __uint_as_float(rr[1])); mx[e] = m; }
    if (lane < 16) {
#pragma unroll
        for (int e = 0; e < 4; ++e) atomicMax((unsigned*)cm + n0 + lc + e, __float_as_uint(mx[e])); }
}
__device__ __forceinline__ void p0_transpose_item_i8(const float* W, int K, int N, unsigned char* WT, int mode, LAS float* scr, int item, int lane, const float* gk, const float* cm) {
    const int nblk = N / 64, kb = item / nblk, nb = item % nblk, k0 = 64 * kb, n0 = 64 * nb;
    const int lr = lane >> 4, lc = (lane & 15) * 4;
#pragma unroll 4
    for (int i = 0; i < 16; ++i) { const int kk = 4 * i + lr; f32x4 v = *(const f32x4*)(W + (size_t)(k0 + kk) * N + n0 + lc); if (gk) v = v * gk[k0 + kk];
        LAS float* d = scr + kk * 65 + lc; d[0] = v.x; d[1] = v.y; d[2] = v.z; d[3] = v.w; }
    asm volatile("s_waitcnt lgkmcnt(0)" ::: "memory");
    const float inv = 127.f / fmaxf(cm[n0 + lane], 1e-30f);
    unsigned char* orow = WT + (size_t)dst_row(mode, n0 + lane) * K + k0;
#pragma unroll
    for (int ch = 0; ch < 4; ++ch) { const LAS float* sp = scr + (16 * ch) * 65 + lane; unsigned w[4];
#pragma unroll
        for (int q = 0; q < 4; ++q) w[q] = q8x4(sp[(4 * q) * 65] * inv, sp[(4 * q + 1) * 65] * inv, sp[(4 * q + 2) * 65] * inv, sp[(4 * q + 3) * 65] * inv);
        *(u32x4*)(orow + 16 * ch) = (u32x4){w[0], w[1], w[2], w[3]}; }
    asm volatile("s_waitcnt lgkmcnt(0)" ::: "memory");
}
__device__ __forceinline__ void rms_row_to_i8(const float* xrow, const float* g, unsigned char* orow, float* rsc, int lane) {
    const f32x4* xr = (const f32x4*)xrow + lane;
    f32x4 v[8]; float s = 0.f;
#pragma unroll
    for (int j = 0; j < 8; ++j) { v[j] = xr[64 * j]; s += (v[j].x * v[j].x + v[j].y * v[j].y) + (v[j].z * v[j].z + v[j].w * v[j].w); }
    const float rstd = __builtin_amdgcn_rsqf(wave_sum(s) * (1.f / DM) + EPS); float mx = 0.f;
#pragma unroll
    for (int j = 0; j < 8; ++j) { const f32x4 gg = ((const f32x4*)g)[lane + 64 * j]; v[j] = v[j] * rstd * gg; mx = fmaxf(fmaxf(mx, fmaxf(fabsf(v[j].x), fabsf(v[j].y))), fmaxf(fabsf(v[j].z), fabsf(v[j].w))); }
    mx = fmaxf(wave_max(mx), 1e-30f); const float inv = 127.f / mx;
    unsigned* o4 = (unsigned*)orow + lane;
#pragma unroll
    for (int j = 0; j < 8; ++j) o4[64 * j] = q8x4(v[j].x * inv, v[j].y * inv, v[j].z * inv, v[j].w * inv);
    if (lane == 0) *rsc = mx * (1.f / 127.f);
}
__device__ __forceinline__ void bf16_row_to_i8(const bf16* xrow, unsigned char* orow, float* rsc, int lane) {
    const u32x4* xr = (const u32x4*)xrow + lane; float f[4][8]; float s = 0.f, mx = 0.f;
#pragma unroll
    for (int j = 0; j < 4; ++j) { unpack8(xr[64 * j], f[j]);
#pragma unroll
        for (int e = 0; e < 8; ++e) { s += f[j][e] * f[j][e]; mx = fmaxf(mx, fabsf(f[j][e])); } }
    const float rstd = __builtin_amdgcn_rsqf(wave_sum(s) * (1.f / DM) + EPS); mx = fmaxf(wave_max(mx), 1e-30f); const float inv = 127.f / mx;
    u32x2* o8 = (u32x2*)orow + lane;
#pragma unroll
    for (int j = 0; j < 4; ++j) { u32x2 w; w.x = q8x4(f[j][0] * inv, f[j][1] * inv, f[j][2] * inv, f[j][3] * inv); w.y = q8x4(f[j][4] * inv, f[j][5] * inv, f[j][6] * inv, f[j][7] * inv); o8[64 * j] = w; }
    if (lane == 0) *rsc = mx * (1.f / 127.f) * rstd;
}
__device__ __forceinline__ void rms_row_to_bf16(const float* xrow, const float* g, bf16* orow, int lane) {
    const f32x4* xr = (const f32x4*)xrow + lane;
    f32x4 v[8]; float s = 0.f;
#pragma unroll
    for (int j = 0; j < 8; ++j) { v[j] = xr[64 * j]; s += (v[j].x * v[j].x + v[j].y * v[j].y) + (v[j].z * v[j].z + v[j].w * v[j].w); }
    const float rstd = __builtin_amdgcn_rsqf(wave_sum(s) * (1.f / DM) + EPS);
    u32x2* o8 = (u32x2*)orow + lane;
#pragma unroll
    for (int j = 0; j < 8; ++j) { const f32x4 gg = ((const f32x4*)g)[lane + 64 * j]; u32x2 w; w.x = pk2(v[j].x * rstd * gg.x, v[j].y * rstd * gg.y); w.y = pk2(v[j].z * rstd * gg.z, v[j].w * rstd * gg.w); o8[64 * j] = w; }
}
__device__ __forceinline__ void rms_row_inplace_f32(float* xrow, const float* g, int lane) {
    f32x4* xr = (f32x4*)xrow + lane;
    f32x4 v[8]; float s = 0.f;
#pragma unroll
    for (int j = 0; j < 8; ++j) { v[j] = xr[64 * j]; s += (v[j].x * v[j].x + v[j].y * v[j].y) + (v[j].z * v[j].z + v[j].w * v[j].w); }
    const float rstd = __builtin_amdgcn_rsqf(wave_sum(s) * (1.f / DM) + EPS);
#pragma unroll
    for (int j = 0; j < 8; ++j) { const f32x4 gg = ((const f32x4*)g)[lane + 64 * j]; xr[64 * j] = v[j] * rstd * gg; }
}


__device__ __forceinline__ void onorm_row(bf16* o, const float* g_a, const float* g_g, int lane) {
#pragma unroll
    for (int half = 0; half < 2; ++half) {
        u32x4* p = (u32x4*)(o + half * 1024) + lane; float f0[8], f1[8]; unpack8(p[0], f0); unpack8(p[64], f1); float s = 0.f;
#pragma unroll
        for (int e = 0; e < 8; ++e) s += f0[e] * f0[e] + f1[e] * f1[e];
        const float rstd = __builtin_amdgcn_rsqf(wave_sum(s) * (1.f / 1024.f) + EPS);
        const float* g = (half ? g_g : g_a) + 8 * lane;
#pragma unroll
        for (int e = 0; e < 8; ++e) { f0[e] *= rstd * g[e]; f1[e] *= rstd * g[512 + e]; }
        p[0] = pack8(f0); p[64] = pack8(f1);
    }
}

namespace att {
constexpr int NW = 8, QBLK = 32, KVBLK = 64;
constexpr int LDQ = QW, LDKV = KVW, LDKR = ZW, LDO = DM;
constexpr float SCALE = 0.07216878364870322f;
constexpr float THR = 8.f;
#ifndef ATT_SDEPTH
#define ATT_SDEPTH 1
#endif
constexpr int SDEPTH = ATT_SDEPTH;
constexpr int SHM_V = KVBLK * 128 * 2, SHM_K = KVBLK * 128 * 2, SHM_KR = KVBLK * 64 * 2;
#ifndef ATT_NQL
#define ATT_NQL 0
#endif
constexpr int NQL = ATT_NQL, NQR = 12 - NQL;
constexpr int OFF_V = 0, OFF_K = 2 * SHM_V, OFF_KR = OFF_K + 2 * SHM_K, OFF_WS = OFF_KR + 2 * SHM_KR, OFF_QL = OFF_WS + NW * 64 * 4, ATT_LDS = OFF_QL + NW * NQL * 1024;
static_assert(ATT_LDS <= 147456, "attention LDS");
#define KSWZ(row, colB) ((row) * 256 + ((colB) ^ (((row) & 7) << 4)))
#define KRSWZ(row, colB) ((row) * 128 + ((colB) ^ ((((row) >> 1) & 7) << 4)))
#define SBAR() __builtin_amdgcn_sched_barrier(0)
__device__ __forceinline__ int crow(int r, int hi) { return (r & 3) + 8 * (r >> 2) + 4 * hi; }
__device__ __forceinline__ unsigned cvtpk(float lo, float hi) { unsigned r; asm volatile("v_cvt_pk_bf16_f32 %0, %1, %2" : "=v"(r) : "v"(lo), "v"(hi)); return r; }

__device__ __forceinline__ void partialSM(f32x16& p0, f32x16& p1, float& m_reg, float& mn, float& alpha) {
  constexpr float C = SCALE * 1.4426950408889634f;
  float pmax = p0[0];
#pragma unroll
  for (int r = 1; r < 16; ++r) pmax = fmaxf(pmax, p0[r]);
#pragma unroll
  for (int r = 0; r < 16; ++r) pmax = fmaxf(pmax, p1[r]);
  { auto rr = __builtin_amdgcn_permlane32_swap(__float_as_uint(pmax), __float_as_uint(pmax), false, false);
    pmax = fmaxf(__uint_as_float(rr[0]), __uint_as_float(rr[1])); }
  if (__builtin_expect(__all(pmax - m_reg <= THR / SCALE), 1)) { mn = m_reg; alpha = 1.f; }
  else { mn = fmaxf(m_reg, pmax); alpha = __builtin_amdgcn_exp2f((m_reg - mn) * C); m_reg = mn; }
  float mnC = -mn * C;
#pragma unroll
  for (int r = 0; r < 16; ++r) p0[r] = fmaf(p0[r], C, mnC);
#pragma unroll
  for (int r = 0; r < 16; ++r) p1[r] = fmaf(p1[r], C, mnC);
#pragma unroll
  for (int r = 0; r < 16; ++r) p0[r] = __builtin_amdgcn_exp2f(p0[r]);
}
__device__ __forceinline__ void finishSM(f32x16& p0, f32x16& p1, float alpha, float& l_reg, bf16x8& pa0, bf16x8& pa1, bf16x8& pa2, bf16x8& pa3) {
#pragma unroll
  for (int r = 0; r < 16; ++r) p1[r] = __builtin_amdgcn_exp2f(p1[r]);
  float ps = 0;
#pragma unroll
  for (int r = 0; r < 16; ++r) ps += p0[r];
#pragma unroll
  for (int r = 0; r < 16; ++r) ps += p1[r];
  { auto rr = __builtin_amdgcn_permlane32_swap(__float_as_uint(ps), __float_as_uint(ps), false, false);
    ps = __uint_as_float(rr[0]) + __uint_as_float(rr[1]); }
  l_reg = l_reg * alpha + ps;
#define PK4(P, BASE, OUT) do { unsigned a0 = cvtpk(P[BASE + 0], P[BASE + 1]), a1 = cvtpk(P[BASE + 2], P[BASE + 3]);   \
    unsigned b0 = cvtpk(P[BASE + 4], P[BASE + 5]), b1 = cvtpk(P[BASE + 6], P[BASE + 7]);                              \
    auto r0 = __builtin_amdgcn_permlane32_swap(a0, b0, false, false); auto r1 = __builtin_amdgcn_permlane32_swap(a1, b1, false, false); \
    u32x4 w = {r0[0], r1[0], r0[1], r1[1]}; OUT = *reinterpret_cast<bf16x8*>(&w); } while (0)
  PK4(p0, 0, pa0); PK4(p0, 8, pa1); PK4(p1, 0, pa2); PK4(p1, 8, pa3);
#undef PK4
}
#define QF(d) ((d) < NQR ? qr[(d) < NQR ? (d) : 0] : *reinterpret_cast<const bf16x8*>(ql + ((d) - NQR) * 1024))
__device__ __forceinline__ void qkt(f32x16& p0, f32x16& p1, const char* Ks, const char* Krs, const bf16x8* qr, const char* ql, int r32, int hi) {
  p0 = f32x16{}; p1 = f32x16{};
#pragma unroll
  for (int d0 = 0; d0 < 8; ++d0) { int cb = (d0 * 16 + hi * 8) * 2;
    bf16x8 b0 = *reinterpret_cast<const bf16x8*>(Ks + KSWZ(r32, cb));
    bf16x8 b1 = *reinterpret_cast<const bf16x8*>(Ks + KSWZ(32 + r32, cb));
    const bf16x8 qf = QF(d0);
    p0 = __builtin_amdgcn_mfma_f32_32x32x16_bf16(b0, qf, p0, 0, 0, 0);
    p1 = __builtin_amdgcn_mfma_f32_32x32x16_bf16(b1, qf, p1, 0, 0, 0); }
#pragma unroll
  for (int d0 = 0; d0 < 4; ++d0) { int cb = (d0 * 16 + hi * 8) * 2;
    bf16x8 b0 = *reinterpret_cast<const bf16x8*>(Krs + KRSWZ(r32, cb));
    bf16x8 b1 = *reinterpret_cast<const bf16x8*>(Krs + KRSWZ(32 + r32, cb));
    const bf16x8 qf = QF(8 + d0);
    p0 = __builtin_amdgcn_mfma_f32_32x32x16_bf16(b0, qf, p0, 0, 0, 0);
    p1 = __builtin_amdgcn_mfma_f32_32x32x16_bf16(b1, qf, p1, 0, 0, 0); }
}
__device__ __forceinline__ int v_st(int k, int c) { const int kk = (k & ~0xC) | ((k & 4) << 1) | ((k & 8) >> 1); return ((kk >> 3) * 4 + (c >> 5)) * 512 + ((kk & 7) * 32 + (c & 31)) * 2; }
__device__ __forceinline__ int v_rd_base(int lane) { return ((lane & 3) << 3) | (((lane >> 2) & 3) << 6) | (((lane >> 4) & 1) << 5) | (((lane >> 5) & 1) << 8); }
constexpr int v_rd_off(int d0, int ks, int half) { return d0 * 512 + ks * 4096 + half * 2048; }
template <int OFF> __device__ __forceinline__ s16x4 tr_read(int vb) {
  s16x4 r; asm volatile("ds_read_b64_tr_b16 %0, %1 offset:%2" : "=&v"(r) : "v"(vb), "i"(OFF) : "memory"); return r;
}
template <int D0> __device__ __forceinline__ void pv_one(f32x16& od, int vb, bf16x8 pa0, bf16x8 pa1, bf16x8 pa2, bf16x8 pa3) {
  const s16x4 l0 = tr_read<v_rd_off(D0, 0, 0)>(vb), h0 = tr_read<v_rd_off(D0, 0, 1)>(vb), l1 = tr_read<v_rd_off(D0, 1, 0)>(vb), h1 = tr_read<v_rd_off(D0, 1, 1)>(vb);
  const s16x4 l2 = tr_read<v_rd_off(D0, 2, 0)>(vb), h2 = tr_read<v_rd_off(D0, 2, 1)>(vb), l3 = tr_read<v_rd_off(D0, 3, 0)>(vb), h3 = tr_read<v_rd_off(D0, 3, 1)>(vb);
  asm volatile("s_waitcnt lgkmcnt(0)" ::: "memory"); SBAR();
#define PK(L, H) (bf16x8){L[0], L[1], L[2], L[3], H[0], H[1], H[2], H[3]}
  od = __builtin_amdgcn_mfma_f32_32x32x16_bf16(pa0, PK(l0, h0), od, 0, 0, 0);
  od = __builtin_amdgcn_mfma_f32_32x32x16_bf16(pa1, PK(l1, h1), od, 0, 0, 0);
  od = __builtin_amdgcn_mfma_f32_32x32x16_bf16(pa2, PK(l2, h2), od, 0, 0, 0);
  od = __builtin_amdgcn_mfma_f32_32x32x16_bf16(pa3, PK(l3, h3), od, 0, 0, 0);
#undef PK
}
__device__ __forceinline__ void pv_d0(f32x16* o, int vb, bf16x8 pa0, bf16x8 pa1, bf16x8 pa2, bf16x8 pa3) {
  pv_one<0>(o[0], vb, pa0, pa1, pa2, pa3); pv_one<1>(o[1], vb, pa0, pa1, pa2, pa3); pv_one<2>(o[2], vb, pa0, pa1, pa2, pa3); pv_one<3>(o[3], vb, pa0, pa1, pa2, pa3);
}

__device__ __forceinline__ void attn_dense_body(const bf16* __restrict__ Qb, const bf16* __restrict__ Kn, const bf16* __restrict__ Kr, const bf16* __restrict__ Vh,
                                                bf16* __restrict__ Ob, pg8::u64* ssa, int seq, char* lds, const int wv) {
  const int tid = tid_of(wv), wid = tid >> 6, lane = tid & 63, r32 = lane & 31, hi = lane >> 5;
  char* V_lds = lds + OFF_V; char* K_lds = lds + OFF_K; char* KR_lds = lds + OFF_KR;
  float* ws = (float*)(lds + OFF_WS) + wid * 64; float* li_l = ws; float* al_l = ws + 32;
  float m_reg = -1e30f, l_reg = 0; f32x16 o[4] = {}; bf16x8 qr[NQR]; char* ql = lds + OFF_QL + wid * (NQL * 1024) + lane * 16;
  const bf16* Qw = Qb + (long)(wid * QBLK + r32) * LDQ + hi * 8;
#pragma unroll
  for (int d0 = 0; d0 < 12; ++d0) { const bf16x8 t = *reinterpret_cast<const bf16x8*>(Qw + d0 * 16); if (d0 < NQR) qr[d0 < NQR ? d0 : 0] = t; else *reinterpret_cast<bf16x8*>(ql + (d0 - NQR) * 1024) = t; }
  const int sr = tid >> 4, sc = (tid & 15) * 8, vst0 = v_st(sr, sc), vst1 = v_st(32 + sr, sc);
  const int krr = tid >> 3, krc = (tid & 7) * 8;
  const int vb0 = (int)(uintptr_t)V_lds + v_rd_base(lane);
  struct { bf16x8 vs0, vs1, ks0, ks1, kr; } sr_[SDEPTH];
const unsigned offV0 = (unsigned)(sr * LDKV + sc) * 2u, offV1 = (unsigned)((32 + sr) * LDKV + sc) * 2u, offKR = (unsigned)(krr * LDKR + krc) * 2u;
#define SLOAD(i, k0) do { const char* vt_ = (const char*)Vh + (size_t)(k0) * (LDKV * 2); const char* kt_ = (const char*)Kn + (size_t)(k0) * (LDKV * 2); const char* rt_ = (const char*)Kr + (size_t)(k0) * (LDKR * 2); \
    sr_[i].vs0 = *reinterpret_cast<const bf16x8*>(vt_ + offV0); sr_[i].vs1 = *reinterpret_cast<const bf16x8*>(vt_ + offV1); \
    sr_[i].ks0 = *reinterpret_cast<const bf16x8*>(kt_ + offV0); sr_[i].ks1 = *reinterpret_cast<const bf16x8*>(kt_ + offV1); \
    sr_[i].kr = *reinterpret_cast<const bf16x8*>(rt_ + offKR); } while (0)
#define SWRITE(b, i) do { *(bf16x8*)(V_lds + (b) * SHM_V + vst0) = sr_[i].vs0;          \
    *(bf16x8*)(V_lds + (b) * SHM_V + vst1) = sr_[i].vs1; int kc = sc * 2;               \
    *(bf16x8*)(K_lds + (b) * SHM_K + KSWZ(sr, kc)) = sr_[i].ks0;                       \
    *(bf16x8*)(K_lds + (b) * SHM_K + KSWZ(32 + sr, kc)) = sr_[i].ks1;                  \
    *(bf16x8*)(KR_lds + (b) * SHM_KR + KRSWZ(krr, krc * 2)) = sr_[i].kr; } while (0)
#define SWAIT() do { if constexpr (SDEPTH == 2) asm volatile("s_waitcnt vmcnt(5)" ::: "memory"); else asm volatile("s_waitcnt vmcnt(0)" ::: "memory"); } while (0)
#define RESC(a) do { if (__any((a) < 1.f)) { if (hi == 0) al_l[r32] = (a); asm volatile("s_waitcnt lgkmcnt(0)" ::: "memory"); \
    _Pragma("unroll") for (int d = 0; d < 4; ++d) _Pragma("unroll") for (int r = 0; r < 16; ++r) o[d][r] *= al_l[crow(r, hi)]; } } while (0)
  f32x16 pA0, pA1, pB0, pB1; float mnA, mnB, alA, alB; bf16x8 pa0, pa1, pa2, pa3; const int NT = seq / KVBLK;
  constexpr int SE = 0, SO = SDEPTH - 1;
  SLOAD(SE, 0); asm volatile("s_waitcnt vmcnt(0)" ::: "memory"); SWRITE(0, SE); __syncthreads();
  qkt(pA0, pA1, K_lds, KR_lds, qr, ql, r32, hi); partialSM(pA0, pA1, m_reg, mnA, alA);
  SLOAD(SO, KVBLK); if constexpr (SDEPTH == 2) { if (2 < NT) SLOAD(SE, 2 * KVBLK); }
  SWAIT(); SWRITE(1, SO); __syncthreads();
  for (int j = 1; j + 1 < NT; j += 2) {
    SBAR(); qkt(pB0, pB1, K_lds + SHM_K, KR_lds + SHM_KR, qr, ql, r32, hi);
    finishSM(pA0, pA1, alA, l_reg, pa0, pa1, pa2, pa3); SBAR();
    SLOAD(SO, (j + SDEPTH) * KVBLK); SBAR();
    pv_d0(o, vb0, pa0, pa1, pa2, pa3); partialSM(pB0, pB1, m_reg, mnB, alB);
    __syncthreads(); SWAIT(); SWRITE(0, SE);
    RESC(alB); __syncthreads();
    SBAR(); qkt(pA0, pA1, K_lds, KR_lds, qr, ql, r32, hi);
    finishSM(pB0, pB1, alB, l_reg, pa0, pa1, pa2, pa3); SBAR();
    if (SDEPTH == 1 || j + 3 < NT) SLOAD(SE, (j + 1 + SDEPTH) * KVBLK); SBAR();
    pv_d0(o, vb0 + SHM_V, pa0, pa1, pa2, pa3); partialSM(pA0, pA1, m_reg, mnA, alA);
    __syncthreads(); SWAIT(); SWRITE(1, SO);
    RESC(alA); __syncthreads();
  }
  SBAR(); qkt(pB0, pB1, K_lds + SHM_K, KR_lds + SHM_KR, qr, ql, r32, hi);
  finishSM(pA0, pA1, alA, l_reg, pa0, pa1, pa2, pa3); SBAR();
  pv_d0(o, vb0, pa0, pa1, pa2, pa3); partialSM(pB0, pB1, m_reg, mnB, alB);
  __syncthreads(); RESC(alB);
  finishSM(pB0, pB1, alB, l_reg, pa0, pa1, pa2, pa3); SBAR();
  pv_d0(o, vb0 + SHM_V, pa0, pa1, pa2, pa3);
  if (hi == 0) li_l[r32] = l_reg; asm volatile("s_waitcnt lgkmcnt(0)" ::: "memory");
  float rli[16];
#pragma unroll
  for (int r = 0; r < 16; ++r) rli[r] = __builtin_amdgcn_rcpf(li_l[crow(r, hi)]);
  bf16* Ow = Ob + (long)(wid * QBLK) * LDO;
#pragma unroll
  for (int r = 0; r < 16; ++r) { int orow = crow(r, hi);
    float sq = 0.f;
#pragma unroll
    for (int d0 = 0; d0 < 4; ++d0) { const float v = o[d0][r] * rli[r]; sq += v * v; Ow[(long)orow * LDO + d0 * 32 + r32] = (bf16)(cvtpk(v, 0.f) & 0xffffu); }
    sq += xor_get<1>(sq); sq += xor_get<2>(sq); sq += xor_get<4>(sq); sq += xor_get<8>(sq); sq += xor_get<16>(sq);
    if (r32 == 0) pg8::ss_add(ssa + wid * QBLK + orow, sq); }
#undef SLOAD
#undef SWRITE
#undef SWAIT
#undef RESC
}
}

__device__ __forceinline__ void gmlp_unit(const bf16* Z, const bf16* Wsp, const float* b_s, const float* g_v, bf16* O, pg8::u64* ssg, int chunk, int g, char* lds, const int wv) {
  const int tid = tid_of(wv), wid = tid >> 6, lane = tid & 63, r32 = lane & 31, hi = lane >> 5;
  constexpr int PITCH = 136;
  bf16* VT = (bf16*)lds;
  const bf16* Zc = Z + (size_t)chunk * 128 * ZW;
  bf16x8 af[8];
  { const bf16* Ar = Wsp + (size_t)g * 16384 + (size_t)((wid & 3) * 32 + r32) * 128 + hi * 8;
#pragma unroll
    for (int k = 0; k < 8; ++k) af[k] = *reinterpret_cast<const bf16x8*>(Ar + k * 16); }
  __syncthreads();
  {
    const int j = tid >> 2, cg = tid & 3; u32x4 w[4]; float sq = 0.f;
    const bf16* zr = Zc + (size_t)j * ZW + Z_V + g * 128 + cg * 8;
#pragma unroll
    for (int i = 0; i < 4; ++i) w[i] = *(const u32x4*)(zr + 32 * i);
#pragma unroll
    for (int i = 0; i < 4; ++i) { float f[8]; unpack8(w[i], f);
#pragma unroll
      for (int e = 0; e < 8; ++e) sq += f[e] * f[e]; }
    sq += xor_get<1>(sq); sq += xor_get<2>(sq);
    const float rs = __builtin_amdgcn_rsqf(sq * (1.f / 128.f) + EPS);
#pragma unroll
    for (int i = 0; i < 4; ++i) { const int c0 = (cg + 4 * i) * 8; float f[8]; unpack8(w[i], f);
      const float* gp = g_v + g * 128 + c0; const f32x4 g0 = *(const f32x4*)gp, g1 = *(const f32x4*)(gp + 4);
      unsigned p0 = pk2(f[0] * rs * g0.x, f[1] * rs * g0.y), p1 = pk2(f[2] * rs * g0.z, f[3] * rs * g0.w), p2 = pk2(f[4] * rs * g1.x, f[5] * rs * g1.y), p3 = pk2(f[6] * rs * g1.z, f[7] * rs * g1.w);
      if (cg & 1) { const unsigned t = p0; p0 = p1; p1 = p2; p2 = p3; p3 = t; }
      if (cg & 2) { unsigned t = p0; p0 = p2; p2 = t; t = p1; p1 = p3; p3 = t; }
      const unsigned q[4] = {p0, p1, p2, p3};
#pragma unroll
      for (int d = 0; d < 4; ++d) { const int dd = (d + cg) & 3; VT[(c0 + 2 * dd) * PITCH + j] = (bf16)(q[d] & 0xffff); VT[(c0 + 2 * dd + 1) * PITCH + j] = (bf16)(q[d] >> 16); } }
  }
  __syncthreads();
  const int ib = (wid & 3) * 32, cb = (wid >> 2) * 64;
  f32x16 a0 = {}, a1 = {};
#pragma unroll
  for (int k = 0; k < 8; ++k) {
    const bf16x8 b0 = *reinterpret_cast<const bf16x8*>(VT + (cb + r32) * PITCH + k * 16 + hi * 8);
    const bf16x8 b1 = *reinterpret_cast<const bf16x8*>(VT + (cb + 32 + r32) * PITCH + k * 16 + hi * 8);
    a0 = __builtin_amdgcn_mfma_f32_32x32x16_bf16(b0, af[k], a0, 0, 0, 0);
    a1 = __builtin_amdgcn_mfma_f32_32x32x16_bf16(b1, af[k], a1, 0, 0, 0);
  }
  { const int i = ib + r32; const float bb = b_s[g * 128 + i]; const size_t row = (size_t)chunk * 128 + i;
    const bf16* up = Z + row * ZW + Z_U + g * 128 + cb + 4 * hi; bf16* op = O + row * DM + 1024 + g * 128 + cb + 4 * hi;
    float sq = 0.f;
#pragma unroll
    for (int q = 0; q < 4; ++q) {
      const u32x2 w0 = *(const u32x2*)(up + 8 * q), w1 = *(const u32x2*)(up + 32 + 8 * q);
      u32x2 o0, o1;
      { const float uu[8] = {bf_lo(w0.x), bf_hi(w0.x), bf_lo(w0.y), bf_hi(w0.y), bf_lo(w1.x), bf_hi(w1.x), bf_lo(w1.y), bf_hi(w1.y)};
#pragma unroll
        for (int e = 0; e < 4; ++e) { const float v0 = uu[e] * (a0[4 * q + e] + bb), v1 = uu[4 + e] * (a1[4 * q + e] + bb); sq += v0 * v0 + v1 * v1; } }
      o0.x = pk2(bf_lo(w0.x) * (a0[4 * q + 0] + bb), bf_hi(w0.x) * (a0[4 * q + 1] + bb)); o0.y = pk2(bf_lo(w0.y) * (a0[4 * q + 2] + bb), bf_hi(w0.y) * (a0[4 * q + 3] + bb));
      o1.x = pk2(bf_lo(w1.x) * (a1[4 * q + 0] + bb), bf_hi(w1.x) * (a1[4 * q + 1] + bb)); o1.y = pk2(bf_lo(w1.y) * (a1[4 * q + 2] + bb), bf_hi(w1.y) * (a1[4 * q + 3] + bb));
      *(u32x2*)(op + 8 * q) = o0; *(u32x2*)(op + 32 + 8 * q) = o1; }
    sq = xor32_sum(sq);
    if (hi == 0) pg8::ss_add(ssg + row, sq); }
}

#define XB_TMO      128
#define XB_XCNT(j)  (256  + 64 * (j))
#define XB_XSUB(j)  (1280 + 64 * (j))
#define XB_XGEN(j)  (2304 + 64 * (j))
#define XB_TOP      3328
#define XB_TOPGEN   3392
#define XCD_BAR_WORDS 3456
#define XB_SPIN_CAP (1u << 18)
__device__ __forceinline__ unsigned xb_ld(unsigned* p)              { return __hip_atomic_load(p, __ATOMIC_RELAXED, __HIP_MEMORY_SCOPE_AGENT); }
__device__ __forceinline__ unsigned xb_add(unsigned* p, unsigned v) { return __hip_atomic_fetch_add(p, v, __ATOMIC_RELAXED, __HIP_MEMORY_SCOPE_AGENT); }
__device__ __forceinline__ unsigned xb_xcc_id() { return (unsigned)__builtin_amdgcn_s_getreg((3 << 11) | 20) & 0xFu; }
#define XB_SPIN(cond, bar) do { unsigned _sp = 0; while (cond) { __builtin_amdgcn_s_sleep(1); \
    if ((++_sp & 255u) == 0u) { if (xb_ld(&(bar)[XB_TMO])) break; if (_sp > XB_SPIN_CAP) { atomicAdd(&(bar)[XB_TMO], 1u); break; } } } } while (0)
struct XcdBarrier { unsigned* bar; unsigned x; volatile LAS unsigned* st; };
__device__ __forceinline__ XcdBarrier xcd_barrier_post(unsigned* bar, volatile LAS unsigned* st) {
    XcdBarrier b; b.bar = bar; b.x = xb_xcc_id(); b.st = st;
    if (threadIdx.x == 0) (void)xb_add(&bar[XB_XCNT(b.x)], 1u);
    return b;
}
__device__ __forceinline__ void xcd_barrier_complete(unsigned* bar, unsigned x, unsigned& nloc, unsigned& nx) {
    const unsigned G = gridDim.x * gridDim.y * gridDim.z;
    unsigned sum, cnt, mine, sp = 0u;
    for (;;) {
        sum = 0u; cnt = 0u; mine = 0u;
#pragma unroll
        for (unsigned j = 0; j < 16; ++j) { const unsigned c = xb_ld(&bar[XB_XCNT(j)]); sum += c; cnt += (c > 0u) ? 1u : 0u; mine = (j == x) ? c : mine; }
        if (sum == G) break;
        __builtin_amdgcn_s_sleep(1);
        if ((++sp & 255u) == 0u) { if (xb_ld(&bar[XB_TMO])) break; if (sp > XB_SPIN_CAP) { atomicAdd(&bar[XB_TMO], 1u); break; } }
    }
    nloc = mine > 0u ? mine : 1u; nx = cnt > 0u ? cnt : 1u;
}
__device__ __forceinline__ void xcd_barrier(const XcdBarrier& b, const int wv) {
    asm volatile("s_waitcnt vmcnt(0)" ::: "memory");
    __syncthreads();
    if (tid_of(wv) == 0) {
        unsigned* bar = b.bar;
        __builtin_amdgcn_s_waitcnt(0);
        unsigned nloc = b.st[0], nx = b.st[1];
        if (nloc == 0u) { xcd_barrier_complete(bar, b.x, nloc, nx); b.st[0] = nloc; b.st[1] = nx; }
        const unsigned old = xb_add(&bar[XB_XSUB(b.x)], 1u);
        const unsigned gen = old / nloc;
        if (old + 1u == (gen + 1u) * nloc) {
            __builtin_amdgcn_fence(__ATOMIC_RELEASE, "agent");
            asm volatile("s_waitcnt vmcnt(0)" ::: "memory");
            const unsigned og = xb_add(&bar[XB_TOP], 1u);
            const unsigned tg = og / nx;
            if (og + 1u == (tg + 1u) * nx) xb_add(&bar[XB_TOPGEN], 1u);
            else XB_SPIN(xb_ld(&bar[XB_TOPGEN]) == tg, bar);
            __builtin_amdgcn_fence(__ATOMIC_ACQUIRE, "agent");
            xb_add(&bar[XB_XGEN(b.x)], 1u);
            asm volatile("s_waitcnt vmcnt(0)" ::: "memory");
        } else {
            XB_SPIN(xb_ld(&bar[XB_XGEN(b.x)]) == gen, bar);
            __builtin_amdgcn_fence(__ATOMIC_ACQUIRE, "agent");
            asm volatile("s_waitcnt vmcnt(0)" ::: "memory");
        }
    }
    __syncthreads();
}

struct Args { const float* in[23]; float* out; unsigned char* ws; int ph_lo, ph_hi; };

template <class Epi, int MODE = 0, bool MID = false>
__device__ __forceinline__ void run_gemm(LAS unsigned char* lds, const void* A, int lda, const void* Bt, int ldb, int M, int N, int K, const Epi E, const int wv, int base = -1, int stride = 0, int cnt = 0x7fffffff) {
    pg8::Gemm g{A, Bt, M, N, K, lda, ldb}; pg8::StaticOrder S; S.init(M, N, (int)gridDim.x, (int)blockIdx.x);
    if (base >= 0) { S.base = base; S.stride = stride; } S.cnt = cnt;
    pg8::gemm_phase<Epi, pg8::StaticOrder, true, true, MODE, MID>(lds, g, S, E, wv);
}

__global__ void __launch_bounds__(512) mk_fwd(Args args) {
    extern __shared__ __attribute__((aligned(16))) unsigned char lds_raw[];
    LAS unsigned char* lds = (LAS unsigned char*)lds_raw;
    const int G = gridDim.x;
    const int wv = __builtin_amdgcn_readfirstlane(threadIdx.x >> 6);
    volatile LAS unsigned* bar_st = (volatile LAS unsigned*)(lds + (LDS_BYTES - 64));
    if (threadIdx.x < 2) bar_st[threadIdx.x] = 0u;
    __syncthreads();
    unsigned* barw = (unsigned*)(args.ws);
    XcdBarrier xbar; xbar.bar = barw; xbar.x = 0; xbar.st = bar_st;
#define LANE_INIT const int tid = tid_of(wv), lane = tid & 63, wave = wv, gw = blockIdx.x * 8 + wave, NGW = G * 8; (void)tid; (void)lane; (void)gw; (void)NGW;
#define PH_WS unsigned char* ws = args.ws; float* X = args.out; (void)X; (void)ws;
#define x_p (args.in[0])
#define x_s (args.in[1])
#define g_ffn1 (args.in[2])
#define w1_gate (args.in[3])
#define w1_up (args.in[4])
#define w1_down (args.in[5])
#define g_mix (args.in[6])
#define w_in (args.in[7])
#define g_q (args.in[8])
#define w_q_b (args.in[9])
#define g_kv (args.in[10])
#define w_kv_b (args.in[11])
#define g_v (args.in[12])
#define w_s (args.in[13])
#define b_s (args.in[14])
#define g_out_attn (args.in[15])
#define g_out_gmlp (args.in[16])
#define w_out (args.in[17])
#define g_ffn2 (args.in[18])
#define w2_gate (args.in[19])
#define w2_up (args.in[20])
#define w2_down (args.in[21])
#define g_final (args.in[22])
#define rope ((float*)(ws + WS_ROPE))
#define W1U ((bf16*)(ws + WS_W1U))
#define W1D ((bf16*)(ws + WS_W1D))
#define W2U ((bf16*)(ws + WS_W2U))
#define W2D ((bf16*)(ws + WS_W2D))
#define WIN ((bf16*)(ws + WS_WIN))
#define WQ ((bf16*)(ws + WS_WQ))
#define WKV ((bf16*)(ws + WS_WKV))
#define WOUT ((bf16*)(ws + WS_WOUT))
#define WSP ((bf16*)(ws + WS_WSP))
#define H ((bf16*)(ws + WS_H))
#define ACT ((bf16*)(ws + WS_ACT))
#define Z ((bf16*)(ws + WS_Z))
#define Q ((bf16*)(ws + WS_Q))
#define KV ((bf16*)(ws + WS_KV))
#define H2 ((bf16*)(ws + WS_H2))
#define X1B ((bf16*)X)
#define X2B ((bf16*)X + (size_t)T * DM)
#define CM ((float*)(ws + WS_CM))
#define RS1 ((float*)(ws + WS_RS))
#define RS2 ((float*)(ws + WS_RS) + T)
#define SS ((pg8::u64*)(ws + WS_SS))
#define SS1 (SS)
#define SS3 (SS + T)
#define SSQ (SS + 2 * T)
#define SSKV (SS + 3 * T)
#define SSA (SS + 4 * T)
#define SSG (SS + 5 * T)
#define IN(k) true
#define SEAM(k) do { if ((k) == 0) { cg::this_grid().sync(); xbar = xcd_barrier_post(barw, bar_st); } else xcd_barrier(xbar, wv); } while (0)

    if (IN(0)) {
        PH_WS LANE_INIT
        LAS float* scr = (LAS float*)(lds + wave * 16640);
        constexpr int I_UP = (DM / 64) * (DFF / 64), I_DN = (DFF / 64) * (DM / 64), I_IN = (DM / 64) * (3136 / 64), I_Q = (512 / 64) * (QW / 64), I_KV = (512 / 64) * (KVW / 64), I_OUT = (DM / 64) * (DM / 64);
        constexpr int I_CM = 4 * (DFF / 64), I_CMD = 4 * (DM / 64); constexpr int NITEMS = 4 * I_CM + I_CMD + 2 * I_DN + I_IN + I_Q + I_KV + I_OUT;
        for (int it = gw; it < NITEMS; it += NGW) {
            int r = it;
            if (r < 4 * I_CM) {
                const int mat = r / I_CM, it2 = r % I_CM;
                p0_colmax_item(mat == 0 ? w1_gate : mat == 1 ? w1_up : mat == 2 ? w2_gate : w2_up, DM, DFF, CM + mat * DFF, it2, lane, mat >= 2 ? g_ffn2 : nullptr); continue; } r -= 4 * I_CM;
            if (r < I_CMD) { p0_colmax_item(w2_down, DFF, DM, CM + 4 * DFF, r, lane, nullptr); continue; } r -= I_CMD;
            if (r < I_DN) { p0_transpose_item(w1_down, DFF, DM, W1D, 0, scr, r, lane); continue; } r -= I_DN;
            if (r < I_DN) { if (!FP8_DOWN2) p0_transpose_item(w2_down, DFF, DM, W2D, 0, scr, r, lane); continue; } r -= I_DN;
            if (r < I_IN) { p0_transpose_item(w_in, DM, 3136, WIN, 3, scr, r, lane, g_mix); continue; } r -= I_IN;
            if (r < I_Q) { p0_transpose_item(w_q_b, 512, QW, WQ, 4, scr, r, lane, g_q); continue; } r -= I_Q;
            if (r < I_KV) { p0_transpose_item(w_kv_b, 512, KVW, WKV, 0, scr, r, lane, g_kv); continue; } r -= I_KV;
            p0_transpose_item(w_out, DM, DM, WOUT, 0, scr, r, lane, (r / (DM / 64)) < 16 ? g_out_attn : g_out_gmlp - 1024);
        }
        const int gt = blockIdx.x * 512 + tid, NGT = G * 512;
        if (blockIdx.x == 0) for (int i = tid; i < XCD_BAR_WORDS; i += 512) barw[i] = 0u;
        for (int i = gt; i < 192 * DM / 8; i += NGT) ((u32x4*)(WIN + (size_t)1088 * DM))[i] = (u32x4){0u, 0u, 0u, 0u};
        for (int i = gt; i < 6 * T / 2; i += NGT) ((u32x4*)SS)[i] = (u32x4){0u, 0u, 0u, 0u};
        for (int i = gt; i < 8 * 128 * 128 / 2; i += NGT) ((unsigned*)WSP)[i] = pk2(w_s[2 * i], w_s[2 * i + 1]);
        for (int i = gt; i < 8192 * 32; i += NGT) { const int pos = i >> 5, k = i & 31; const double a = (double)pos * c_inv_rev[k]; const float fr = (float)(a - floor(a));
            rope[(size_t)pos * 64 + k] = __builtin_amdgcn_cosf(fr); rope[(size_t)pos * 64 + 32 + k] = __builtin_amdgcn_sinf(fr); }
        for (int m = gw; m < T; m += NGW) { const float* xr = (m < TP ? x_p + (size_t)m * DM : x_s + (size_t)(m - TP) * DM);
            rms_row_to_i8(xr, g_ffn1, (unsigned char*)H + (size_t)m * DM, RS1 + m, lane); }
    }
    SEAM(0);
    {
        PH_WS LANE_INIT
        LAS float* scr = (LAS float*)(lds + wave * 16640);
        constexpr int I_UP = (DM / 64) * (DFF / 64), I_DN8 = FP8_DOWN2 ? (DFF / 64) * (DM / 64) : 0;
        for (int it = gw; it < I_DN8; it += NGW) p0_transpose_item8(w2_down, DFF, DM, (unsigned char*)W2D, 0, scr, it, lane, nullptr, 1.f, CM + 4 * DFF);
        for (int it = gw; it < 4 * I_UP; it += NGW) { const int mat = it / I_UP, r = it % I_UP;
            p0_transpose_item_i8(mat == 0 ? w1_gate : mat == 1 ? w1_up : mat == 2 ? w2_gate : w2_up, DM, DFF, (unsigned char*)(mat < 2 ? W1U : W2U), 1 + (mat & 1), scr, r, lane, mat >= 2 ? g_ffn2 : nullptr, CM + mat * DFF); }
    }
    SEAM(20);
    if (IN(1)) { PH_WS pg8::EpiSwiGLU<false> E{ACT, DFF, RS1, CM, CM + DFF, 1.f / 127.f}; run_gemm<pg8::EpiSwiGLU<false>, 2>(lds, H, DM, W1U, DM, T, 2 * DFF, DM, E, wv); }
    SEAM(1);
    if (IN(2)) { PH_WS
        { pg8::EpiResid<true, false, 1, true, false, false, false> E{x_p, nullptr, DM, X1B, SS1, nullptr, nullptr, 1.f}; run_gemm(lds, ACT, DFF, W1D, DFF, TP, DM, DFF, E, wv); }
        { pg8::EpiResid<true, false, 1, true, false, false, false> E{x_s, nullptr, DM, X1B + (size_t)TP * DM, SS1 + TP, nullptr, nullptr, 1.f}; run_gemm(lds, ACT + (size_t)TP * DFF, DFF, W1D, DFF, TS, DM, DFF, E, wv); }
    }
    SEAM(2);
    const bool rebal = (G == 256);
    if (IN(3)) { PH_WS pg8::EpiZ E{Z, ZW, SS1, SSQ, SSKV, rope}; run_gemm(lds, X1B, DM, WIN, DM, T, ZW, DM, E, wv, -1, 0, rebal ? 8 : 0x7fffffff); }
    SEAM(3);
    if (IN(4)) { PH_WS
        const int c_ = (int)blockIdx.x;
        if (rebal && c_ < 32) { pg8::EpiZ E{Z, ZW, SS1, SSQ, SSKV, rope}; run_gemm(lds, X1B, DM, WIN, DM, T, ZW, DM, E, wv, 2048 + c_, 256, 1); }
        { pg8::EpiQRope E{Q, QW, rope, SSQ};
          if (!rebal) run_gemm(lds, Z, ZW, WQ, 512, T, QW, 512, E, wv);
          else if (c_ >= 32) run_gemm(lds, Z, ZW, WQ, 512, T, QW, 512, E, wv, c_ - 32, 224, 4);
          else run_gemm(lds, Z, ZW, WQ, 512, T, QW, 512, E, wv, 896 + c_, 32, 2); }
        { pg8::EpiBf16 E{KV, KVW, SSKV, 1.f / 512.f}; run_gemm(lds, Z + 512, ZW, WKV, 512, T, KVW, 512, E, wv); }
    }
    SEAM(4);
    if (IN(5)) { PH_WS
        const int c = blockIdx.x;
        for (int u = c; u < (T / 128) * 8; u += G) gmlp_unit(Z, WSP, b_s, g_v, H, SSG, u >> 3, u & 7, (char*)lds_raw, wv);
        for (int u = c; u < 256 + 1024; u += G) {
            int head, row0, krow0, seq;
            if (u < 256) { head = u & 7; row0 = (u >> 3) * 256; krow0 = 0; seq = TP; }
            else { const int v = u - 256; head = v & 7; const int idx = v >> 3; const int sq = idx >> 3, qb = idx & 7; krow0 = TP + sq * 2048; row0 = krow0 + qb * 256; seq = 2048; }
            __syncthreads();
            att::attn_dense_body(Q + (size_t)row0 * QW + head * 192, KV + (size_t)krow0 * KVW + head * 256, Z + (size_t)krow0 * ZW + Z_KR, KV + (size_t)krow0 * KVW + head * 256 + 128,
                                 H + (size_t)row0 * DM + head * 128, SSA + row0, seq, (char*)lds_raw, wv);
        }
    }
    SEAM(5);
    if (IN(7)) { PH_WS pg8::EpiMix E{X1B, X2B, DM, SSA, SSG}; run_gemm<pg8::EpiMix, 0, true>(lds, H, DM, WOUT, DM, T, DM, DM, E, wv); }
    SEAM(7);
    { PH_WS LANE_INIT for (int m = gw; m < T; m += NGW) bf16_row_to_i8(X2B + (size_t)m * DM, (unsigned char*)H + (size_t)m * DM, RS2 + m, lane); }
    SEAM(7);
    if (IN(8)) { PH_WS pg8::EpiSwiGLU<FP8_DOWN2 != 0> E{ACT, DFF, RS2, CM + 2 * DFF, CM + 3 * DFF, 1.f / 127.f}; run_gemm<pg8::EpiSwiGLU<FP8_DOWN2 != 0>, 2>(lds, H, DM, W2U, DM, T, 2 * DFF, DM, E, wv); }
    SEAM(8);
    if (IN(9)) { PH_WS pg8::EpiResid<true, false, 1, true, FP8_DOWN2 != 0, true, false> E{X2B, nullptr, DM, H2, SS3, nullptr, CM + 4 * DFF, 1.f / (W8MAX * ACT8SCALE)}; run_gemm<pg8::EpiResid<true, false, 1, true, FP8_DOWN2 != 0, true, false>, FP8_DOWN2 ? 1 : 0>(lds, ACT, DFF, W2D, DFF, T, DM, DFF, E, wv); }
    SEAM(9);
    if (IN(10)) {
        PH_WS LANE_INIT
        for (int m = gw; m < T; m += NGW) { const u32x4* hr = (const u32x4*)(H2 + (size_t)m * DM) + lane; f32x4* xr = (f32x4*)(X + (size_t)m * DM); const float rs = __builtin_amdgcn_rsqf(pg8::ss_get(SS3 + m) * (1.f / DM) + EPS);
            u32x4 w[4];
#pragma unroll
            for (int j = 0; j < 4; ++j) w[j] = hr[64 * j];
#pragma unroll
            for (int j = 0; j < 4; ++j) { float f[8]; unpack8(w[j], f); const int c8 = (lane + 64 * j) * 2; const f32x4 g0 = ((const f32x4*)g_final)[c8], g1 = ((const f32x4*)g_final)[c8 + 1];
                xr[c8] = (f32x4){f[0] * rs * g0.x, f[1] * rs * g0.y, f[2] * rs * g0.z, f[3] * rs * g0.w}; xr[c8 + 1] = (f32x4){f[4] * rs * g1.x, f[5] * rs * g1.y, f[6] * rs * g1.z, f[7] * rs * g1.w}; } }
    }
#undef IN
#undef SEAM
}

extern "C" void kernel_launch(void* const* d_in, const int* in_sizes, int n_in, void* d_out, int out_size, void* d_ws, size_t ws_size, hipStream_t stream) {
    static int grid = 0;
    if (grid == 0) {
        if (n_in != 23 || out_size != T * DM || ws_size < WS_END) { fprintf(stderr, "kernel_launch: unexpected shapes: n_in %d out %d ws %zu\n", n_in, out_size, ws_size); grid = -1; return; }
        int dev = 0, cus = 0, per_cu = 0;
        if (hipGetDevice(&dev) != hipSuccess || hipDeviceGetAttribute(&cus, hipDeviceAttributeMultiprocessorCount, dev) != hipSuccess) { grid = -1; return; }
        if (hipFuncSetAttribute((const void*)mk_fwd, hipFuncAttributeMaxDynamicSharedMemorySize, LDS_BYTES) != hipSuccess) { fprintf(stderr, "kernel_launch: hipFuncSetAttribute failed\n"); grid = -1; return; }
        if (hipOccupancyMaxActiveBlocksPerMultiprocessor(&per_cu, (const void*)mk_fwd, 512, LDS_BYTES) != hipSuccess || per_cu < 1) { fprintf(stderr, "kernel_launch: occupancy query says %d\n", per_cu); per_cu = 1; }
        (void)hipGetLastError();
        grid = cus * per_cu;
    }
    if (grid < 0) return;
    if (hipMemsetAsync((char*)d_ws + WS_CM, 0, CM_BYTES, stream) != hipSuccess) { fprintf(stderr, "kernel_launch: hipMemsetAsync failed\n"); return; }
    Args a{};
    for (int i = 0; i < 23; ++i) a.in[i] = (const float*)d_in[i];
    a.out = (float*)d_out; a.ws = (unsigned char*)d_ws;
    a.ph_lo = 0; a.ph_hi = NPHASE;
    void* kargs[] = {&a};
    hipError_t e = hipLaunchCooperativeKernel((const void*)mk_fwd, dim3(grid), dim3(512), kargs, LDS_BYTES, stream);
    if (e != hipSuccess) fprintf(stderr, "cooperative launch failed: %s (grid %d)\n", hipGetErrorString(e), grid);
}
```
